# Optimizing an MI355X kernel written in HIP

```python
import jax, jax.numpy as jnp
from jax import lax
import numpy as np

D_MODEL = 1024
BATCH = 1
SEQ = 16384
DEPTH = 4

GRID_W = 64
CTX_LEN = 256
N_MIXERS = 2
N_A = (DEPTH + N_MIXERS - 1) // N_MIXERS
N_B = DEPTH // N_MIXERS
LRU_WIDTH = D_MODEL
LRU_HEADS = 4
LRU_BLOCK = LRU_WIDTH // LRU_HEADS
LRU_C = 8.0
CONV_A_WIDTH = 4
CONV_A_PAD = 2
CONV_B_WIDTH = 3
FFN_CONV_WIDTH = 3
D_FF = 2816
N_MOD = 6
EPS = 1e-6

kernel_name = "hybrid_rglru_shortconv_dit_prefix"


def rms_norm(x, g):
    xf = x.astype(jnp.float32)
    y = xf * lax.rsqrt(jnp.mean(xf * xf, axis=-1, keepdims=True) + EPS) * g.astype(jnp.float32)
    return y.astype(x.dtype)


def modulate(h, shift, scale):
    return h * (1.0 + scale) + shift


def adaln(cvec, w, b):
    return jnp.split(jax.nn.silu(cvec) @ w + b, N_MOD, axis=-1)


def dwconv(x, w, b, pad_lo, axis):
    k_width = w.shape[0]
    n = x.shape[axis]
    pads = [(0, 0)] * x.ndim
    pads[axis] = (pad_lo, k_width - 1 - pad_lo)
    xp = jnp.pad(x, pads)
    out = b + w[0] * lax.slice_in_dim(xp, 0, n, axis=axis)
    for k in range(1, k_width):
        out = out + w[k] * lax.slice_in_dim(xp, k, k + n, axis=axis)
    return out


def seq_conv(x, w, b, pad_lo):
    return dwconv(x, w, b, pad_lo, axis=1)


def grid_conv(x, w, b, pad_lo, rows, grid_axis):
    bsz, n, ch = x.shape
    g = x.reshape(bsz, rows, GRID_W, ch)
    return dwconv(g, w, b, pad_lo, axis=grid_axis).reshape(bsz, n, ch)


def _lin_combine(e1, e2):
    a1, b1 = e1
    a2, b2 = e2
    return a1 * a2, a2 * b1 + b2


def linear_scan(a, b, h0, reverse):
    a_cum, b_cum = lax.associative_scan(_lin_combine, (a, b), reverse=reverse, axis=1)
    if h0 is None:
        return b_cum
    return b_cum + a_cum * h0[:, None, :]


def rglru_coeffs(u, w_r, b_r, w_i, b_i, lam):
    bsz, n, width = u.shape
    ub = u.reshape(bsz, n, LRU_HEADS, LRU_BLOCK)
    r = jax.nn.sigmoid(jnp.einsum('bnhi,hij->bnhj', ub, w_r) + b_r).reshape(bsz, n, width).astype(jnp.float32)
    i = jax.nn.sigmoid(jnp.einsum('bnhi,hij->bnhj', ub, w_i) + b_i).reshape(bsz, n, width).astype(jnp.float32)
    log_a = LRU_C * r * jax.nn.log_sigmoid(lam.astype(jnp.float32))
    a = jnp.exp(log_a)
    b = jnp.sqrt(-jnp.expm1(2.0 * log_a)) * (i * u.astype(jnp.float32))
    return a, b


def rglru_direction(ul, uc, w_r, b_r, w_i, b_i, lam, reverse):
    a_c, b_c = rglru_coeffs(uc, w_r, b_r, w_i, b_i, lam)
    h_c = linear_scan(a_c, b_c, None, reverse)
    h0 = h_c[:, 0] if reverse else h_c[:, -1]
    a_l, b_l = rglru_coeffs(ul, w_r, b_r, w_i, b_i, lam)
    h_l = linear_scan(a_l, b_l, h0, reverse)
    return h_l, h_c


def rglru_mixer(hl, hc, w_x, w_gate, conv_w, conv_b, w_r, b_r, w_i, b_i, lam, w_out, ctx_out):
    ul = seq_conv(hl @ w_x, conv_w, conv_b, CONV_A_PAD)
    uc = seq_conv(hc @ w_x, conv_w, conv_b, CONV_A_PAD)
    hl_f, hc_f = rglru_direction(ul, uc, w_r[0], b_r[0], w_i[0], b_i[0], lam[0], False)
    hl_b, hc_b = rglru_direction(ul, uc, w_r[1], b_r[1], w_i[1], b_i[1], lam[1], True)
    yl = (jax.nn.gelu(hl @ w_gate) * (hl_f + hl_b).astype(hl.dtype)) @ w_out
    yc = None
    if ctx_out:
        yc = (jax.nn.gelu(hc @ w_gate) * (hc_f + hc_b).astype(hc.dtype)) @ w_out
    return yl, yc


def shortconv_mixer(h, w_in, conv_w, conv_b, w_out, conv_fn):
    g_b, g_c, v = jnp.split(h @ w_in, 3, axis=-1)
    return (g_b * conv_fn(g_c * v, conv_w, conv_b)) @ w_out


def conv_ffn(h, w_up, conv_w, conv_b, w_down, conv_fn):
    g, v = jnp.split(h @ w_up, 2, axis=-1)
    return (jax.nn.silu(conv_fn(g, conv_w, conv_b)) * v) @ w_down


def setup_inputs(seed: int = 0) -> dict:
    key = jax.random.key(seed)
    ks = jax.random.split(key, 32)
    f32 = jnp.float32
    D = D_MODEL

    def nrm(k, shape, scale):
        return jax.random.normal(k, shape, f32) * scale

    lam_a = jax.random.uniform(ks[14], (N_A, 2, LRU_WIDTH), f32, 0.9, 0.999)
    s = lam_a ** (1.0 / LRU_C)
    a_lambda = jnp.log(s) - jnp.log1p(-s)
    return {
        "x": nrm(ks[0], (BATCH, SEQ, D), 1.0),
        "c": nrm(ks[1], (BATCH, D), 1.0),
        "ctx": nrm(ks[2], (BATCH, CTX_LEN, D), 1.0),
        "c_ctx": nrm(ks[3], (D,), 1.0),
        "ada_w": nrm(ks[4], (DEPTH, D, N_MOD * D), D ** -0.5),
        "ada_b": nrm(ks[5], (DEPTH, N_MOD * D), 0.02),
        "norm_mix_g": 1.0 + nrm(ks[6], (DEPTH, D), 0.02),
        "norm_ffn_g": 1.0 + nrm(ks[7], (DEPTH, D), 0.02),
        "a_w_x": nrm(ks[8], (N_A, D, LRU_WIDTH), D ** -0.5),
        "a_w_gate": nrm(ks[9], (N_A, D, LRU_WIDTH), D ** -0.5),
        "a_conv_w": nrm(ks[10], (N_A, CONV_A_WIDTH, LRU_WIDTH), CONV_A_WIDTH ** -0.5),
        "a_conv_b": nrm(ks[11], (N_A, LRU_WIDTH), 0.01),
        "a_w_r": nrm(ks[12], (N_A, 2, LRU_HEADS, LRU_BLOCK, LRU_BLOCK), LRU_BLOCK ** -0.5),
        "a_b_r": nrm(ks[13], (N_A, 2, LRU_HEADS, LRU_BLOCK), 0.01),
        "a_w_i": nrm(ks[15], (N_A, 2, LRU_HEADS, LRU_BLOCK, LRU_BLOCK), LRU_BLOCK ** -0.5),
        "a_b_i": nrm(ks[16], (N_A, 2, LRU_HEADS, LRU_BLOCK), 0.01),
        "a_lambda": a_lambda,
        "a_w_out": nrm(ks[17], (N_A, LRU_WIDTH, D), LRU_WIDTH ** -0.5),
        "b_w_in": nrm(ks[18], (N_B, D, 3 * D), D ** -0.5),
        "b_conv_w": nrm(ks[19], (N_B, CONV_B_WIDTH, D), CONV_B_WIDTH ** -0.5),
        "b_conv_b": nrm(ks[20], (N_B, D), 0.01),
        "b_w_out": nrm(ks[21], (N_B, D, D), D ** -0.5),
        "f_w_up": nrm(ks[22], (DEPTH, D, 2 * D_FF), D ** -0.5),
        "f_conv_w": nrm(ks[23], (DEPTH, FFN_CONV_WIDTH, D_FF), FFN_CONV_WIDTH ** -0.5),
        "f_conv_b": nrm(ks[24], (DEPTH, D_FF), 0.01),
        "f_w_down": nrm(ks[25], (DEPTH, D_FF, D), D_FF ** -0.5),
        "final_g": 1.0 + nrm(ks[26], (D,), 0.02),
    }


def reference(x, c, ctx, c_ctx, ada_w, ada_b, norm_mix_g, norm_ffn_g,
              a_w_x, a_w_gate, a_conv_w, a_conv_b, a_w_r, a_b_r, a_w_i, a_b_i, a_lambda, a_w_out,
              b_w_in, b_conv_w, b_conv_b, b_w_out,
              f_w_up, f_conv_w, f_conv_b, f_w_down, final_g):
    rows = x.shape[1] // GRID_W

    def latent_vconv(t, w, b):
        return grid_conv(t, w, b, 1, rows, 1)

    def latent_hconv(t, w, b):
        return grid_conv(t, w, b, 1, rows, 2)

    def ctx_conv(t, w, b):
        return seq_conv(t, w, b, 1)

    h_ctx = ctx
    for l in range(DEPTH):
        j = l // N_MIXERS
        ctx_needed = any((k % N_MIXERS) == 0 for k in range(l + 1, DEPTH))
        sm, cm, gm, sf, cf, gf = [m[:, None, :] for m in adaln(c, ada_w[l], ada_b[l])]
        smc, cmc, gmc, sfc, cfc, gfc = adaln(c_ctx, ada_w[l], ada_b[l])

        hl = modulate(rms_norm(x, norm_mix_g[l]), sm, cm)
        yc = None
        if l % N_MIXERS == 0:
            hc = modulate(rms_norm(h_ctx, norm_mix_g[l]), smc, cmc)
            yl, yc = rglru_mixer(hl, hc, a_w_x[j], a_w_gate[j], a_conv_w[j], a_conv_b[j],
                                 a_w_r[j], a_b_r[j], a_w_i[j], a_b_i[j], a_lambda[j], a_w_out[j],
                                 ctx_needed)
        else:
            yl = shortconv_mixer(hl, b_w_in[j], b_conv_w[j], b_conv_b[j], b_w_out[j], latent_vconv)
            if ctx_needed:
                hc = modulate(rms_norm(h_ctx, norm_mix_g[l]), smc, cmc)
                yc = shortconv_mixer(hc, b_w_in[j], b_conv_w[j], b_conv_b[j], b_w_out[j], ctx_conv)
        x = x + (gm * yl).astype(x.dtype)
        if ctx_needed:
            h_ctx = h_ctx + (gmc * yc).astype(h_ctx.dtype)

        hl = modulate(rms_norm(x, norm_ffn_g[l]), sf, cf)
        x = x + (gf * conv_ffn(hl, f_w_up[l], f_conv_w[l], f_conv_b[l], f_w_down[l], latent_hconv)).astype(x.dtype)
        if ctx_needed:
            hc = modulate(rms_norm(h_ctx, norm_ffn_g[l]), sfc, cfc)
            h_ctx = h_ctx + (gfc * conv_ffn(hc, f_w_up[l], f_conv_w[l], f_conv_b[l], f_w_down[l], ctx_conv)).astype(h_ctx.dtype)

    return rms_norm(x, final_g)
```

```cpp
#include <hip/hip_runtime.h>
#include <cstdio>
#include <cstdint>

#ifndef MK_DUP_MASK
#define MK_DUP_MASK 0u
#endif
#ifndef MK_PER_PHASE
#define MK_PER_PHASE 0
#endif

#define LAS __attribute__((address_space(3)))
typedef unsigned short bf16_t;
typedef short bf16x8 __attribute__((ext_vector_type(8)));
typedef float f32x4 __attribute__((ext_vector_type(4)));
typedef float f32x2 __attribute__((ext_vector_type(2)));
typedef unsigned u32x4 __attribute__((ext_vector_type(4)));
typedef unsigned u32x2 __attribute__((ext_vector_type(2)));
typedef _Float16 h16;
typedef _Float16 h16x2 __attribute__((ext_vector_type(2)));
typedef _Float16 h16x4 __attribute__((ext_vector_type(4)));

constexpr int T = 16384, D = 1024, CT = 256, DFF = 2816, NMOD = 6144;
constexpr float EPS = 1e-6f;

enum { IX_X = 0, IX_C, IX_CTX, IX_CCTX, IX_ADAW, IX_ADAB, IX_NMG, IX_NFG, IX_AWX, IX_AWG, IX_ACW, IX_ACB, IX_AWR, IX_ABR, IX_AWI, IX_ABI, IX_ALAM, IX_AWO,
       IX_BWIN, IX_BCW, IX_BCB, IX_BWO, IX_FWU, IX_FCW, IX_FCB, IX_FWD, IX_FG, N_IN };

constexpr size_t MiB = 1u << 20, KiB = 1u << 10;
constexpr size_t WS_CTL = 0, CTL_ZERO_BYTES = 64 * KiB;
constexpr size_t WS_MODS = 1 * MiB;
constexpr size_t WS_BIASM = 1 * MiB + 256 * KiB;
constexpr size_t WS_BIASF = 1 * MiB + 512 * KiB;
constexpr size_t WS_LA8 = 1 * MiB + 768 * KiB;
constexpr size_t WS_H0 = WS_LA8 + 16 * KiB;
constexpr size_t WS_SSP = 2 * MiB;
constexpr size_t WS_AGGT = 11 * MiB;
constexpr size_t WS_AGG32 = 12 * MiB;
constexpr size_t WS_CTXR = 20 * MiB;
constexpr size_t CX_H = WS_CTXR;
constexpr size_t CX_XB = WS_CTXR + 1 * MiB;
constexpr size_t CX_U = WS_CTXR + 4 * MiB;
constexpr size_t CX_G = WS_CTXR + 5 * MiB;
constexpr size_t CX_GS = CX_G + 512 * KiB;
constexpr size_t CX_Q = WS_CTXR + 6 * MiB;
constexpr size_t CX_Y = CX_Q + 512 * KiB;
constexpr size_t CX_SSP = WS_CTXR + 10 * MiB;
constexpr size_t WS_W = 32 * MiB;
constexpr size_t W_A1 = WS_W, W_A2 = WS_W + 8 * MiB, W_A3 = WS_W + 12 * MiB, W_B1 = WS_W + 16 * MiB, W_B2 = WS_W + 28 * MiB, W_F1 = WS_W + 32 * MiB, W_F2 = WS_W + 76 * MiB;
constexpr size_t SZ_A1 = 4 * MiB, SZ_A2 = 2 * MiB, SZ_A3 = 2 * MiB, SZ_B1 = 6 * MiB, SZ_B2 = 2 * MiB, SZ_F1 = 11 * MiB, SZ_F2 = 5632 * KiB;
constexpr size_t WS_SLOT = 130 * MiB, SLOT = 32 * MiB;
constexpr size_t WS_XRES = WS_SLOT + 6 * SLOT;
constexpr size_t WS_END = WS_XRES + SLOT;
static_assert(W_F2 + 4 * SZ_F2 <= WS_SLOT, "weights fit");

constexpr int RING_BYTES = 131072, LDSCTL_OFF = RING_BYTES, MISC_OFF = LDSCTL_OFF + 320, LDS_BYTES = 147456;

__device__ __forceinline__ float bf2f(unsigned b) { return __uint_as_float(b << 16); }
__device__ __forceinline__ unsigned cvt_pk_bf16(float lo, float hi) { unsigned r; asm volatile("v_cvt_pk_bf16_f32 %0, %1, %2" : "=v"(r) : "v"(lo), "v"(hi)); return r; }
__device__ __forceinline__ float sigm(float x) { return __builtin_amdgcn_rcpf(1.f + __builtin_amdgcn_exp2f(-1.4426950409f * x)); }
__device__ __forceinline__ float silu_f(float x) { return x * sigm(x); }
__device__ __forceinline__ float gelu_t(float x) { const float u = x + 0.044715f * x * x * x; return x * __builtin_amdgcn_rcpf(1.f + __builtin_amdgcn_exp2f(-2.3022081986f * u)); }
__device__ __forceinline__ float one_minus_exp(float x) {
    float p = 1.f / 720.f; p = p * x + 1.f / 120.f; p = p * x + 1.f / 24.f; p = p * x + 1.f / 6.f; p = p * x + 0.5f; p = p * x + 1.f;
    const float small = -(p * x);
    const float big = 1.f - __builtin_amdgcn_exp2f(1.4426950409f * x);
    return x < -0.25f ? big : small;
}
__device__ __forceinline__ int lane_id() { return (int)__builtin_amdgcn_mbcnt_hi(~0u, __builtin_amdgcn_mbcnt_lo(~0u, 0u)); }
#define SWZ_X4 0x101F
#define SWZ_X8 0x201F
#define SWZ_X16 0x401F
__device__ __forceinline__ float add_x16(float v) { return v + __builtin_bit_cast(float, __builtin_amdgcn_ds_swizzle(__builtin_bit_cast(int, v), SWZ_X16)); }
__device__ __forceinline__ float add_x32(float v, int xl) { return v + __builtin_bit_cast(float, __builtin_amdgcn_ds_bpermute(xl, __builtin_bit_cast(int, v))); }
#define XL32(fr, fq) ((((fr) + 16 * (fq)) ^ 32) << 2)
__device__ __forceinline__ float wave_sum(float v) {
    v += __builtin_bit_cast(float, __builtin_amdgcn_update_dpp(0, __builtin_bit_cast(int, v), 0xB1, 0xf, 0xf, false));
    v += __builtin_bit_cast(float, __builtin_amdgcn_update_dpp(0, __builtin_bit_cast(int, v), 0x4E, 0xf, 0xf, false));
    v += __builtin_bit_cast(float, __builtin_amdgcn_ds_swizzle(__builtin_bit_cast(int, v), SWZ_X4));
    v += __builtin_bit_cast(float, __builtin_amdgcn_ds_swizzle(__builtin_bit_cast(int, v), SWZ_X8));
    v = add_x16(v);
    return __builtin_bit_cast(float, __builtin_amdgcn_readlane(__builtin_bit_cast(int, v), 0)) + __builtin_bit_cast(float, __builtin_amdgcn_readlane(__builtin_bit_cast(int, v), 32));
}
__device__ __forceinline__ float dpp_ror1(float x) { return __builtin_bit_cast(float, __builtin_amdgcn_update_dpp(0, __builtin_bit_cast(int, x), 0x121, 0xf, 0xf, false)); }
__device__ __forceinline__ float dpp_ror15(float x) { return __builtin_bit_cast(float, __builtin_amdgcn_update_dpp(0, __builtin_bit_cast(int, x), 0x12F, 0xf, 0xf, false)); }
__device__ __forceinline__ unsigned pk_h2(float a, float b) { h16x2 v = {(h16)a, (h16)b}; return __builtin_bit_cast(unsigned, v); }
__device__ __forceinline__ f32x4 h4_to_f4(u32x2 w) { h16x4 h = __builtin_bit_cast(h16x4, w); return (f32x4){(float)h[0], (float)h[1], (float)h[2], (float)h[3]}; }
__device__ __forceinline__ f32x4 bf4_to_f4(u32x2 w) { return (f32x4){bf2f(w.x & 0xffffu), bf2f(w.x >> 16), bf2f(w.y & 0xffffu), bf2f(w.y >> 16)}; }

namespace pg8 {
constexpr int BM = 256, BK = 64, HALF = 128, HTB = HALF * BK * 2, STAGE_BYTES = 8 * HTB, NXCD = 8, WGM = 4;
__host__ __device__ __forceinline__ int lds_byte(int r, int c) { const int st = (r >> 4) * 2 + (c >> 5), rr = r & 15, cc = c & 31, ob = rr * 64 + cc * 2; return st * 1024 + (ob ^ (((ob >> 9) & 1) << 5)); }
__host__ __device__ __forceinline__ void stage_rc(int b, int& R, int& C) { const int st = b / 1024, sb = b % 1024, swz = sb ^ (((sb >> 9) & 1) << 5); R = (st >> 1) * 16 + swz / 64; C = (st & 1) * 32 + (swz % 64) / 2; }
__host__ __device__ __forceinline__ int perm32(int rho) { const int n = rho >> 4, i = rho & 15; return 8 * (i >> 2) + 4 * n + (i & 3); }
struct Unit { int pm, pn, hrow, nai; };
struct Gemm { const bf16_t* A; const bf16_t* Bt; int lda, K, nM, nN, acs, acm; };
struct StaticOrder {
    int nM, nN, nwg, G, c; bool halves;
    __device__ void init(int nM_, int nN_, int G_, int c_, bool halves_ = false) { nM = nM_; nN = nN_; nwg = nM * nN; G = G_; c = c_; halves = halves_; }
    __device__ bool next(int i, Unit& u) const {
        const int fullr = nwg / G, rem = nwg - fullr * G; const bool split = halves && (rem * 2 == G);
        long L; u.hrow = 0; u.nai = 2;
        if (i < fullr) L = (long)i * G + c;
        else if (i == fullr && split) { L = (long)fullr * G + (c >> 1); u.hrow = (c & 1) * 128; u.nai = 1; }
        else if (i == fullr && c < rem) L = (long)i * G + c;
        else return false;
        int wgid = (int)L; { const int q = nwg / NXCD, r = nwg % NXCD, xcd = wgid % NXCD, off = wgid / NXCD; wgid = (xcd < r ? xcd * (q + 1) : r * (q + 1) + (xcd - r) * q) + off; }
        const int nig = WGM * nN, gid = wgid / nig, fm = gid * WGM, gsz = (nM - fm) < WGM ? (nM - fm) : WGM;
        u.pm = fm + ((wgid % nig) % gsz); u.pn = (wgid % nig) / gsz; return true;
    }
};

template <class Epi, bool PERM = true>
__device__ __forceinline__ void gemm_phase(LAS unsigned char* lds, const Gemm g, const StaticOrder& S, const Epi& E, int wid_) {
    int lane_ = lane_id(); asm volatile("" : "+v"(lane_));
    const int wid = wid_, lane = lane_, tid = wid * 64 + lane, wr = wid >> 2, wc = wid & 3, fr = lane & 15, fq = lane >> 4;
    const int K = g.K, nt = K / BK;
    unsigned voffA[2], voffB[2];
#pragma unroll
    for (int i = 0; i < 2; ++i) { int R, C; stage_rc(tid * 16 + i * 8192, R, C); const int Rb = PERM ? (R & ~31) + perm32(R & 31) : R;
        voffA[i] = (unsigned)(R * g.lda + C) * 2u; voffB[i] = (unsigned)(Rb * K + C) * 2u; }
    const unsigned kstep = (unsigned)(BK * 2);
    const unsigned hstepA = (unsigned)HALF * (unsigned)g.lda * 2u, tstepA = 2u * hstepA;
    const unsigned hstepB = (unsigned)HALF * (unsigned)K * 2u, tstepB = 2u * hstepB;
    const unsigned ldsw = (unsigned)wid * 1024u;
    const int aoff = lds_byte(wr * 64 + fr, fq * 8), boff = lds_byte(wc * 32 + fr, fq * 8);
    const __amdgpu_buffer_rsrc_t rsA = __builtin_amdgcn_make_buffer_rsrc((void*)g.A, 0, 0x7fffffff, 0x00020000);
    const __amdgpu_buffer_rsrc_t rsB = __builtin_amdgcn_make_buffer_rsrc((void*)g.Bt, 0, 0x7fffffff, 0x00020000);
#define PG8_UA(u) ((unsigned)(u).pm * tstepA + ((u).hrow ? hstepA : 0u) + (unsigned)((((u).pn >> g.acs) & g.acm) * 512))
#define PG8_UB(u) ((unsigned)(u).pn * tstepB)
#define PG8_SA(b, h) (((b) * 2 + (h)) * HTB)
#define PG8_SB(b, h) ((4 + (b) * 2 + (h)) * HTB)
#define PG8_STAGE(bufoff, rs, soff, voff) do { _Pragma("unroll") for (int _i = 0; _i < 2; ++_i) \
        __builtin_amdgcn_raw_ptr_buffer_load_lds(rs, (LAS void*)(lds + (bufoff) + ldsw + _i * 8192), 16, (int)(voff)[_i], (int)(soff), 0, 0); } while (0)
#define PG8_LDA(dst, b, h) do { _Pragma("unroll") for (int m = 0; m < 4; ++m) _Pragma("unroll") for (int k = 0; k < 2; ++k) dst[m][k] = *(const LAS bf16x8*)(lds + PG8_SA(b, h) + aoff + m * 2048 + k * 1024); } while (0)
#define PG8_LDB(dst, b, h) do { _Pragma("unroll") for (int n = 0; n < 2; ++n) _Pragma("unroll") for (int k = 0; k < 2; ++k) dst[n][k] = *(const LAS bf16x8*)(lds + PG8_SB(b, h) + boff + n * 2048 + k * 1024); } while (0)
#define PG8_MMA(ai, bj, At, Bt) do { __builtin_amdgcn_s_setprio(1); _Pragma("unroll") for (int m = 0; m < 4; ++m) _Pragma("unroll") for (int n = 0; n < 2; ++n) _Pragma("unroll") for (int k = 0; k < 2; ++k) \
        acc[ai][bj][m][n] = __builtin_amdgcn_mfma_f32_16x16x32_bf16(Bt[n][k], At[m][k], acc[ai][bj][m][n], 0, 0, 0); __builtin_amdgcn_s_setprio(0); } while (0)
#define PG8_WAIT_V(n) asm volatile("s_waitcnt vmcnt(" #n ")" ::: "memory")
#define PG8_WAIT_L(n) asm volatile("s_waitcnt lgkmcnt(" #n ")" ::: "memory")
#define PG8_BAR __builtin_amdgcn_s_barrier()
#define PG8_SCHED __builtin_amdgcn_sched_barrier(0)
    Unit cur, nxt; int ui = 0;
    if (!S.next(0, cur)) return;
    f32x4 acc[2][2][4][2];
#pragma unroll
    for (int a = 0; a < 2; ++a)
#pragma unroll
        for (int b = 0; b < 2; ++b)
#pragma unroll
            for (int m = 0; m < 4; ++m)
#pragma unroll
                for (int n = 0; n < 2; ++n) acc[a][b][m][n] = (f32x4){0.f, 0.f, 0.f, 0.f};
    bf16x8 At[4][2], B0[2][2], B1[2][2];
    unsigned cA = PG8_UA(cur), cB = PG8_UB(cur);
    PG8_STAGE(PG8_SB(0, 0), rsB, cB, voffB); PG8_STAGE(PG8_SB(0, 1), rsB, cB + hstepB, voffB); PG8_STAGE(PG8_SA(0, 0), rsA, cA, voffA); PG8_STAGE(PG8_SA(0, 1), rsA, cA + hstepA, voffA);
    if (wr == 1) PG8_BAR;
    PG8_WAIT_V(2); PG8_BAR;
    PG8_STAGE(PG8_SB(1, 0), rsB, cB + kstep, voffB); PG8_STAGE(PG8_SA(1, 0), rsA, cA + kstep, voffA); PG8_STAGE(PG8_SB(1, 1), rsB, cB + hstepB + kstep, voffB);
    PG8_WAIT_V(6); PG8_BAR;
    for (;;) {
        const bool has_next = S.next(ui + 1, nxt);
        const unsigned nA = has_next ? PG8_UA(nxt) : cA, nB = has_next ? PG8_UB(nxt) : cB;
        for (int t = 0; t < nt; t += 2) {
            const bool last = (t == nt - 2);
            const unsigned a1 = cA + (unsigned)(t + 1) * kstep;
            const unsigned a2 = last ? nA : cA + (unsigned)(t + 2) * kstep, b2 = last ? nB : cB + (unsigned)(t + 2) * kstep;
            const unsigned a3 = a2 + kstep, b3 = b2 + kstep;
            PG8_LDB(B0, 0, 0); PG8_LDB(B1, 0, 1); PG8_SCHED; PG8_LDA(At, 0, 0); PG8_STAGE(PG8_SA(1, 1), rsA, a1 + hstepA, voffA);
            PG8_WAIT_V(8); PG8_WAIT_L(0); PG8_BAR; PG8_MMA(0, 0, At, B0); PG8_MMA(0, 1, At, B1); PG8_BAR; PG8_SCHED;
            PG8_LDA(At, 0, 1); PG8_STAGE(PG8_SB(0, 0), rsB, b2, voffB); PG8_STAGE(PG8_SB(0, 1), rsB, b2 + hstepB, voffB); PG8_STAGE(PG8_SA(0, 0), rsA, a2, voffA);
            PG8_WAIT_V(8); PG8_WAIT_L(0); PG8_BAR; if (cur.nai == 2) { PG8_MMA(1, 0, At, B0); PG8_MMA(1, 1, At, B1); } PG8_BAR; PG8_SCHED;
            PG8_LDB(B0, 1, 0); PG8_LDB(B1, 1, 1); PG8_SCHED; PG8_LDA(At, 1, 0); PG8_STAGE(PG8_SA(0, 1), rsA, a2 + hstepA, voffA);
            PG8_WAIT_V(8); PG8_WAIT_L(0); PG8_BAR; PG8_MMA(0, 0, At, B0); PG8_MMA(0, 1, At, B1); PG8_BAR; PG8_SCHED;
            PG8_LDA(At, 1, 1); PG8_STAGE(PG8_SB(1, 0), rsB, b3, voffB); PG8_STAGE(PG8_SB(1, 1), rsB, b3 + hstepB, voffB); PG8_STAGE(PG8_SA(1, 0), rsA, a3, voffA);
            PG8_WAIT_V(8); PG8_WAIT_L(0); PG8_BAR; if (cur.nai == 2) { PG8_MMA(1, 0, At, B0); PG8_MMA(1, 1, At, B1); } PG8_BAR; PG8_SCHED;
        }
        if (wr == 0) PG8_BAR;
        { int lnE = lane_id(); asm volatile("" : "+v"(lnE)); int frE = lnE & 15, fqE = lnE >> 4, wrE = wr, wcE = wc; asm volatile("" : "+s"(wrE), "+s"(wcE));
          E(acc, cur, wrE, wcE, frE, fqE); }
        if (!has_next) break;
#pragma unroll
        for (int a = 0; a < 2; ++a)
#pragma unroll
            for (int b = 0; b < 2; ++b)
#pragma unroll
                for (int m = 0; m < 4; ++m)
#pragma unroll
                    for (int n = 0; n < 2; ++n) acc[a][b][m][n] = (f32x4){0.f, 0.f, 0.f, 0.f};
        cur = nxt; cA = nA; cB = nB; ++ui;
        if (wr == 1) PG8_BAR;
    }
    PG8_WAIT_V(0);
    PG8_BAR;
#undef PG8_UA
#undef PG8_UB
#undef PG8_SA
#undef PG8_SB
#undef PG8_STAGE
#undef PG8_LDA
#undef PG8_LDB
#undef PG8_MMA
#undef PG8_WAIT_V
#undef PG8_WAIT_L
#undef PG8_BAR
#undef PG8_SCHED
}
}

typedef f32x4 Acc[2][2][4][2];

__device__ __forceinline__ void load_rstd(float (&rs)[2][4], const float* ssp, int row0, int fr, int fq) {
#pragma unroll
    for (int ai = 0; ai < 2; ++ai)
#pragma unroll
        for (int m = 0; m < 4; ++m) {
            const f32x4 p = *(const f32x4*)(ssp + (size_t)(row0 + ai * 128 + m * 16) * 16 + fq * 4);
            float s = (p.x + p.y) + (p.z + p.w);
            s = add_x16(s); s = add_x32(s, XL32(fr, fq));
            rs[ai][m] = __builtin_amdgcn_rsqf(s * (1.0f / D) + EPS);
        }
}

struct EpiA1 {
    bf16_t* UPRE; bf16_t* G; const float* bias; const float* ssp;
    __device__ __forceinline__ void operator()(const Acc& acc, const pg8::Unit& u, int wr, int wc, int fr, int fq) const {
        const int row0 = u.pm * 256 + wr * 64 + fr;
        float rs[2][4]; load_rstd(rs, ssp, row0, fr, fq);
        const bool isg = u.pn >= 4; bf16_t* out = isg ? G : UPRE;
        const int oc0 = (u.pn & 3) * 256 + wc * 32 + 8 * fq, bc0 = u.pn * 256 + wc * 32 + 8 * fq;
        f32x4 bv[2][2];
#pragma unroll
        for (int bj = 0; bj < 2; ++bj)
#pragma unroll
            for (int n = 0; n < 2; ++n) bv[bj][n] = *(const f32x4*)(bias + bc0 + bj * 128 + 4 * n);
#pragma unroll
        for (int ai = 0; ai < 2; ++ai)
#pragma unroll
            for (int m = 0; m < 4; ++m) { bf16_t* rowp = out + (size_t)(row0 + ai * 128 + m * 16) * D + oc0; const float r = rs[ai][m];
#pragma unroll
                for (int bj = 0; bj < 2; ++bj) { f32x4 v0 = acc[ai][bj][m][0] * r + bv[bj][0], v1 = acc[ai][bj][m][1] * r + bv[bj][1];
                    if (isg) { v0 = (f32x4){gelu_t(v0[0]), gelu_t(v0[1]), gelu_t(v0[2]), gelu_t(v0[3])}; v1 = (f32x4){gelu_t(v1[0]), gelu_t(v1[1]), gelu_t(v1[2]), gelu_t(v1[3])}; }
                    u32x4 w; w.x = cvt_pk_bf16(v0[0], v0[1]); w.y = cvt_pk_bf16(v0[2], v0[3]); w.z = cvt_pk_bf16(v1[0], v1[1]); w.w = cvt_pk_bf16(v1[2], v1[3]);
                    *(u32x4*)(rowp + bj * 128) = w; } }
    }
};

struct EpiA2 {
    const bf16_t* U; h16* EB; const float* br; const float* bi; const float* la8;
    __device__ __forceinline__ void operator()(const Acc& acc, const pg8::Unit& u, int wr, int wc, int fr, int fq) const {
        const int row0 = u.pm * 256 + wr * 64 + fr, d = u.pn >> 3, q = u.pn & 7, c0 = q * 128 + wc * 32 + 4 * fq;
        h16* Ed = EB + (size_t)d * T * D * 2;
        u32x2 uw[2][4][2];
#pragma unroll
        for (int ai = 0; ai < 2; ++ai)
#pragma unroll
            for (int m = 0; m < 4; ++m)
#pragma unroll
                for (int n = 0; n < 2; ++n) uw[ai][m][n] = *(const u32x2*)(U + (size_t)(row0 + ai * 128 + m * 16) * D + c0 + 16 * n);
        f32x4 brv2[2], biv2[2], lav2[2];
#pragma unroll
        for (int n = 0; n < 2; ++n) { brv2[n] = *(const f32x4*)(br + d * D + c0 + 16 * n); biv2[n] = *(const f32x4*)(bi + d * D + c0 + 16 * n); lav2[n] = *(const f32x4*)(la8 + d * D + c0 + 16 * n); }
#pragma unroll
        for (int ai = 0; ai < 2; ++ai)
#pragma unroll
            for (int m = 0; m < 4; ++m)
#pragma unroll
                for (int n = 0; n < 2; ++n) { const size_t off = (size_t)(row0 + ai * 128 + m * 16) * D + c0 + 16 * n;
                    const f32x4 uu = bf4_to_f4(uw[ai][m][n]); const f32x4 brv = brv2[n], biv = biv2[n], lav = lav2[n];
                    unsigned w[4];
#pragma unroll
                    for (int j = 0; j < 4; ++j) { const float r = sigm(acc[ai][0][m][n][j] + brv[j]), ig = sigm(acc[ai][1][m][n][j] + biv[j]);
                        const float a = __builtin_amdgcn_exp2f(r * lav[j]), e = 1.0f - a; w[j] = pk_h2(e, __builtin_amdgcn_sqrtf(e * (1.0f + a)) * ig * uu[j]); }
                    *(u32x4*)(Ed + off * 2) = (u32x4){w[0], w[1], w[2], w[3]}; }
    }
};

struct EpiRes {
    bf16_t* xres; bf16_t* xb; const float* gate; const float* ng; const float* sc; float* sspo;
    __device__ __forceinline__ void operator()(const Acc& acc, const pg8::Unit& u, int wr, int wc, int fr, int fq) const {
        const int row0 = u.pm * 256 + wr * 64 + fr, c0 = u.pn * 256 + wc * 32 + 8 * fq;
        f32x4 gv[2][2], gs[2][2];
#pragma unroll
        for (int bj = 0; bj < 2; ++bj)
#pragma unroll
            for (int n = 0; n < 2; ++n) { gv[bj][n] = *(const f32x4*)(gate + c0 + bj * 128 + 4 * n);
                if (ng) { const f32x4 a = *(const f32x4*)(ng + c0 + bj * 128 + 4 * n), b = *(const f32x4*)(sc + c0 + bj * 128 + 4 * n); gs[bj][n] = a * (b + 1.0f); } else gs[bj][n] = (f32x4){0.f, 0.f, 0.f, 0.f}; }
#pragma unroll
        for (int ai = 0; ai < 2; ++ai) {
            u32x4 xo[1][4][2];
#pragma unroll
            for (int m = 0; m < 4; ++m)
#pragma unroll
                for (int bj = 0; bj < 2; ++bj) xo[0][m][bj] = *(const u32x4*)(xres + (size_t)(row0 + ai * 128 + m * 16) * D + c0 + bj * 128);
#pragma unroll
            for (int m = 0; m < 4; ++m) { const int row = row0 + ai * 128 + m * 16; const size_t off = (size_t)row * D + c0; float ss = 0.f;
#pragma unroll
                for (int bj = 0; bj < 2; ++bj) { const u32x4 w0 = xo[0][m][bj];
                    const f32x4 o0 = (f32x4){bf2f(w0.x & 0xffffu), bf2f(w0.x >> 16), bf2f(w0.y & 0xffffu), bf2f(w0.y >> 16)}, o1 = (f32x4){bf2f(w0.z & 0xffffu), bf2f(w0.z >> 16), bf2f(w0.w & 0xffffu), bf2f(w0.w >> 16)};
                    const f32x4 x0 = o0 + gv[bj][0] * acc[ai][bj][m][0], x1 = o1 + gv[bj][1] * acc[ai][bj][m][1];
                    u32x4 wx; wx.x = cvt_pk_bf16(x0[0], x0[1]); wx.y = cvt_pk_bf16(x0[2], x0[3]); wx.z = cvt_pk_bf16(x1[0], x1[1]); wx.w = cvt_pk_bf16(x1[2], x1[3]);
                    *(u32x4*)(xres + off + bj * 128) = wx;
                    ss += (x0[0] * x0[0] + x0[1] * x0[1]) + (x0[2] * x0[2] + x0[3] * x0[3]) + (x1[0] * x1[0] + x1[1] * x1[1]) + (x1[2] * x1[2] + x1[3] * x1[3]);
                    if (ng) { const f32x4 y0 = x0 * gs[bj][0], y1 = x1 * gs[bj][1]; u32x4 w; w.x = cvt_pk_bf16(y0[0], y0[1]); w.y = cvt_pk_bf16(y0[2], y0[3]); w.z = cvt_pk_bf16(y1[0], y1[1]); w.w = cvt_pk_bf16(y1[2], y1[3]);
                        *(u32x4*)(xb + off + bj * 128) = w; } }
                ss = add_x16(ss); ss = add_x32(ss, XL32(fr, fq));
                if (fq == 0) sspo[(size_t)row * 16 + u.pn * 4 + wc] = ss; }
        }
    }
};

struct EpiB1 {
    bf16_t* GB; bf16_t* Z; const float* bias; const float* ssp;
    __device__ __forceinline__ void operator()(const Acc& acc, const pg8::Unit& u, int wr, int wc, int fr, int fq) const {
        const int row0 = u.pm * 256 + wr * 64 + fr;
        float rs[2][4]; load_rstd(rs, ssp, row0, fr, fq);
        const int bc0 = u.pn * 256 + wc * 32 + 8 * fq;
        f32x4 bv[2][2];
#pragma unroll
        for (int bj = 0; bj < 2; ++bj)
#pragma unroll
            for (int n = 0; n < 2; ++n) bv[bj][n] = *(const f32x4*)(bias + bc0 + bj * 128 + 4 * n);
        if (u.pn < 4) {
#pragma unroll
            for (int ai = 0; ai < 2; ++ai)
#pragma unroll
                for (int m = 0; m < 4; ++m) { bf16_t* rowp = GB + (size_t)(row0 + ai * 128 + m * 16) * D + bc0; const float r = rs[ai][m];
#pragma unroll
                    for (int bj = 0; bj < 2; ++bj) { const f32x4 v0 = acc[ai][bj][m][0] * r + bv[bj][0], v1 = acc[ai][bj][m][1] * r + bv[bj][1];
                        u32x4 w; w.x = cvt_pk_bf16(v0[0], v0[1]); w.y = cvt_pk_bf16(v0[2], v0[3]); w.z = cvt_pk_bf16(v1[0], v1[1]); w.w = cvt_pk_bf16(v1[2], v1[3]);
                        *(u32x4*)(rowp + bj * 128) = w; } }
        } else {
            const int c0 = (u.pn - 4) * 128 + wc * 32 + 8 * fq;
#pragma unroll
            for (int ai = 0; ai < 2; ++ai)
#pragma unroll
                for (int m = 0; m < 4; ++m) { const float r = rs[ai][m];
                    const f32x4 z0 = (acc[ai][0][m][0] * r + bv[0][0]) * (acc[ai][1][m][0] * r + bv[1][0]), z1 = (acc[ai][0][m][1] * r + bv[0][1]) * (acc[ai][1][m][1] * r + bv[1][1]);
                    u32x4 w; w.x = cvt_pk_bf16(z0[0], z0[1]); w.y = cvt_pk_bf16(z0[2], z0[3]); w.z = cvt_pk_bf16(z1[0], z1[1]); w.w = cvt_pk_bf16(z1[2], z1[3]);
                    *(u32x4*)(Z + (size_t)(row0 + ai * 128 + m * 16) * D + c0) = w; }
        }
    }
};

struct EpiF1 {
    bf16_t* Y; const float* bias; const float* ssp; const float* cw; const float* cb;
    __device__ __forceinline__ void operator()(const Acc& acc, const pg8::Unit& u, int wr, int wc, int fr, int fq) const {
        const int row0 = u.pm * 256 + u.hrow + wr * 64 + fr;
        const int bc0 = u.pn * 256 + wc * 32 + 8 * fq, c0 = u.pn * 128 + wc * 32 + 8 * fq;
        f32x4 bg[2], bvv[2], w0[2], w1[2], w2[2], cbv[2];
#pragma unroll
        for (int n = 0; n < 2; ++n) { bg[n] = *(const f32x4*)(bias + bc0 + 4 * n); bvv[n] = *(const f32x4*)(bias + bc0 + 128 + 4 * n);
            w0[n] = *(const f32x4*)(cw + c0 + 4 * n); w1[n] = *(const f32x4*)(cw + DFF + c0 + 4 * n); w2[n] = *(const f32x4*)(cw + 2 * DFF + c0 + 4 * n); cbv[n] = *(const f32x4*)(cb + c0 + 4 * n); }
        float rs[2][4]; load_rstd(rs, ssp, row0, fr, fq);
        const bool first = (fr == 0), lastl = (fr == 15);
#pragma unroll
        for (int ai = 0; ai < 2; ++ai) {
            if (ai >= u.nai) break;
            unsigned pk0[4][2];
#pragma unroll
            for (int n = 0; n < 2; ++n) {
                f32x4 gq[4];
#pragma unroll
                for (int m = 0; m < 4; ++m) gq[m] = acc[ai][0][m][n] * rs[ai][m] + bg[n];
#pragma unroll
                for (int m = 0; m < 4; ++m) {
#define ROR1V(v) ((f32x4){dpp_ror1((v)[0]), dpp_ror1((v)[1]), dpp_ror1((v)[2]), dpp_ror1((v)[3])})
#define ROR15V(v) ((f32x4){dpp_ror15((v)[0]), dpp_ror15((v)[1]), dpp_ror15((v)[2]), dpp_ror15((v)[3])})
                    const f32x4 ls = ROR1V(gq[m]), rsm = ROR15V(gq[m]);
                    f32x4 lf, rt;
                    if (m == 0) lf = first ? (f32x4){0.f, 0.f, 0.f, 0.f} : ls; else { const f32x4 lp = ROR1V(gq[m > 0 ? m - 1 : 0]); lf = first ? lp : ls; }
                    if (m == 3) rt = lastl ? (f32x4){0.f, 0.f, 0.f, 0.f} : rsm; else { const f32x4 rn = ROR15V(gq[m < 3 ? m + 1 : 3]); rt = lastl ? rn : rsm; }
                    const f32x4 gc = cbv[n] + w0[n] * lf + w1[n] * gq[m] + w2[n] * rt;
                    const f32x4 vv = acc[ai][1][m][n] * rs[ai][m] + bvv[n];
                    const f32x4 y = (f32x4){silu_f(gc[0]) * vv[0], silu_f(gc[1]) * vv[1], silu_f(gc[2]) * vv[2], silu_f(gc[3]) * vv[3]};
                    const unsigned p0 = cvt_pk_bf16(y[0], y[1]), p1 = cvt_pk_bf16(y[2], y[3]);
                    if (n == 0) { pk0[m][0] = p0; pk0[m][1] = p1; }
                    else *(u32x4*)(Y + (size_t)(row0 + ai * 128 + m * 16) * DFF + c0) = (u32x4){pk0[m][0], pk0[m][1], p0, p1}; }
            }
        }
    }
};

#define XB_TMO      128
#define XB_XCNT(j)  (256  + 64 * (j))
#define XB_XSUB(j)  (1280 + 64 * (j))
#define XB_XGEN(j)  (2304 + 64 * (j))
#define XB_TOP      3328
#define XB_TOPGEN   3392
#define XCD_BAR_WORDS 3456
#define XB_SPIN_CAP (1u << 18)
__device__ __forceinline__ unsigned xb_ld(unsigned* p)              { return __hip_atomic_load(p, __ATOMIC_RELAXED, __HIP_MEMORY_SCOPE_AGENT); }
__device__ __forceinline__ unsigned xb_add(unsigned* p, unsigned v) { return __hip_atomic_fetch_add(p, v, __ATOMIC_RELAXED, __HIP_MEMORY_SCOPE_AGENT); }
__device__ __forceinline__ unsigned xb_xcc_id() { return (unsigned)__builtin_amdgcn_s_getreg((3 << 11) | 20) & 0xFu; }
#define XB_SPIN(cond, bar) do { unsigned _sp = 0; while (cond) { __builtin_amdgcn_s_sleep(1); \
    if ((++_sp & 255u) == 0u) { if (xb_ld(&(bar)[XB_TMO])) break; if (_sp > XB_SPIN_CAP) { atomicAdd(&(bar)[XB_TMO], 1u); break; } } } } while (0)
struct XcdBarrier { unsigned* bar; unsigned x; volatile LAS unsigned* st; };
__device__ __forceinline__ XcdBarrier xcd_barrier_post(unsigned* bar, volatile LAS unsigned* st) {
    XcdBarrier b; b.bar = bar; b.x = xb_xcc_id(); b.st = st;
    if (threadIdx.x == 0) (void)xb_add(&bar[XB_XCNT(b.x)], 1u);
    return b;
}
__device__ __forceinline__ void xcd_barrier_complete(unsigned* bar, unsigned x, unsigned& nloc, unsigned& nx) {
    const unsigned G = gridDim.x * gridDim.y * gridDim.z;
    unsigned sum, cnt, mine, sp = 0u;
    for (;;) {
        sum = 0u; cnt = 0u; mine = 0u;
#pragma unroll
        for (unsigned j = 0; j < 16; ++j) { const unsigned c = xb_ld(&bar[XB_XCNT(j)]); sum += c; cnt += (c > 0u) ? 1u : 0u; mine = (j == x) ? c : mine; }
        if (sum == G) break;
        __builtin_amdgcn_s_sleep(1);
        if ((++sp & 255u) == 0u) { if (xb_ld(&bar[XB_TMO])) break; if (sp > XB_SPIN_CAP) { atomicAdd(&bar[XB_TMO], 1u); break; } }
    }
    nloc = mine > 0u ? mine : 1u; nx = cnt > 0u ? cnt : 1u;
}
__device__ __forceinline__ void xcd_barrier(const XcdBarrier& b) {
    asm volatile("s_waitcnt vmcnt(0)" ::: "memory");
    __syncthreads();
    if (threadIdx.x == 0) {
        unsigned* bar = b.bar;
        __builtin_amdgcn_s_waitcnt(0);
        unsigned nloc = b.st[0], nx = b.st[1];
        if (nloc == 0u) { xcd_barrier_complete(bar, b.x, nloc, nx); b.st[0] = nloc; b.st[1] = nx; }
        const unsigned old = xb_add(&bar[XB_XSUB(b.x)], 1u);
        const unsigned gen = old / nloc;
        if (old + 1u == (gen + 1u) * nloc) {
            __builtin_amdgcn_fence(__ATOMIC_RELEASE, "agent");
            asm volatile("s_waitcnt vmcnt(0)" ::: "memory");
            const unsigned og = xb_add(&bar[XB_TOP], 1u);
            const unsigned tg = og / nx;
            if (og + 1u == (tg + 1u) * nx) xb_add(&bar[XB_TOPGEN], 1u);
            else XB_SPIN(xb_ld(&bar[XB_TOPGEN]) == tg, bar);
            __builtin_amdgcn_fence(__ATOMIC_ACQUIRE, "agent");
            xb_add(&bar[XB_XGEN(b.x)], 1u);
            asm volatile("s_waitcnt vmcnt(0)" ::: "memory");
        } else {
            XB_SPIN(xb_ld(&bar[XB_XGEN(b.x)]) == gen, bar);
            __builtin_amdgcn_fence(__ATOMIC_ACQUIRE, "agent");
            asm volatile("s_waitcnt vmcnt(0)" ::: "memory");
        }
    }
    __syncthreads();
}

struct Args { const float* in[N_IN]; float* out; unsigned char* ws; int ph_lo, ph_hi; };
struct Ctx {
    const float* const* in; float* out; unsigned char* ws; LAS unsigned char* lds;
    int tid, lane, wave, G, bid;
};
#define WSP(type, off) ((type*)(C.ws + (off)))
#define INP(i) (C.in[i])
#define LDS_WAIT() asm volatile("s_waitcnt lgkmcnt(0)" ::: "memory")

__device__ __forceinline__ void p0_adaln(const Ctx& C, int item) {
    LAS float* sv = (LAS float*)C.lds;
    LAS float* red = (LAS float*)(C.lds + 8192);
    const int l = item / 48, cbk = item % 48;
    for (int i = C.tid; i < 2048; i += 512) { const float v = i < 1024 ? INP(IX_C)[i] : INP(IX_CCTX)[i - 1024]; sv[i] = silu_f(v); }
    __syncthreads();
    const float* W = INP(IX_ADAW) + (size_t)l * D * NMOD + cbk * 128 + 2 * C.lane;
    const int k0 = C.wave * 128;
    f32x2 a0 = {0.f, 0.f}, a1 = {0.f, 0.f};
#pragma unroll 16
    for (int k = 0; k < 128; ++k) { const f32x2 w = *(const f32x2*)(W + (size_t)(k0 + k) * NMOD); const float s0 = sv[k0 + k], s1 = sv[1024 + k0 + k]; a0 += w * s0; a1 += w * s1; }
    red[(C.wave * 2 + 0) * 128 + 2 * C.lane] = a0.x; red[(C.wave * 2 + 0) * 128 + 2 * C.lane + 1] = a0.y;
    red[(C.wave * 2 + 1) * 128 + 2 * C.lane] = a1.x; red[(C.wave * 2 + 1) * 128 + 2 * C.lane + 1] = a1.y;
    __syncthreads();
    if (C.tid < 256) { const int s = C.tid >> 7, c = C.tid & 127; float v = INP(IX_ADAB)[l * NMOD + cbk * 128 + c];
#pragma unroll
        for (int w = 0; w < 8; ++w) v += red[(w * 2 + s) * 128 + c];
        WSP(float, WS_MODS)[(size_t)(l * 2 + s) * NMOD + cbk * 128 + c] = v; }
    __syncthreads();
}
struct WBlk { const float* src; int ld, c0, K; bf16_t* dst; };
__device__ __forceinline__ WBlk get_wblk(const Ctx& C, int cls, int vb) {
    WBlk w;
    if (cls == 0) {
        w.K = 1024;
        if (vb < 48) { const int j = vb / 24, r = vb % 24;
            if (r < 16) { w.src = (r < 8 ? INP(IX_AWX) : INP(IX_AWG)) + (size_t)j * D * D; w.ld = D; w.c0 = (r & 7) * 128; w.dst = WSP(bf16_t, W_A1 + j * SZ_A1) + (size_t)r * 128 * 1024; }
            else { const int rr = r - 16; w.src = INP(IX_AWO) + (size_t)j * D * D; w.ld = D; w.c0 = rr * 128; w.dst = WSP(bf16_t, W_A3 + j * SZ_A3) + (size_t)rr * 128 * 1024; }
        } else if (vb < 112) { const int bb = vb - 48, j = bb / 32, r = bb % 32;
            if (r < 24) { int c0; if (r < 8) c0 = r * 128; else { const int rr = r - 8; c0 = 1024 + (rr & 1) * 1024 + (rr >> 1) * 128; }
                w.src = INP(IX_BWIN) + (size_t)j * D * 3072; w.ld = 3072; w.c0 = c0; w.dst = WSP(bf16_t, W_B1 + j * SZ_B1) + (size_t)r * 128 * 1024; }
            else { const int rr = r - 24; w.src = INP(IX_BWO) + (size_t)j * D * D; w.ld = D; w.c0 = rr * 128; w.dst = WSP(bf16_t, W_B2 + j * SZ_B2) + (size_t)rr * 128 * 1024; }
        } else { const int bb = vb - 112, l = bb / 44, r = bb % 44;
            w.src = INP(IX_FWU) + (size_t)l * D * 2 * DFF; w.ld = 2 * DFF; w.c0 = (r & 1) * DFF + (r >> 1) * 128; w.dst = WSP(bf16_t, W_F1 + l * SZ_F1) + (size_t)r * 128 * 1024; }
    } else if (cls == 1) {
        const int j = vb / 32, rr = vb % 32, pn = rr >> 1, mem = rr & 1, d = pn >> 3, q = pn & 7, h = q >> 1, half = q & 1;
        w.K = 256; w.src = (mem ? INP(IX_AWI) : INP(IX_AWR)) + (size_t)(((j * 2 + d) * 4 + h)) * 65536; w.ld = 256; w.c0 = half * 128;
        w.dst = WSP(bf16_t, W_A2 + j * SZ_A2) + (size_t)(pn * 256 + mem * 128) * 256;
    } else {
        const int l = vb / 8, rr = vb % 8;
        w.K = DFF; w.src = INP(IX_FWD) + (size_t)l * DFF * D; w.ld = D; w.c0 = rr * 128; w.dst = WSP(bf16_t, W_F2 + l * SZ_F2) + (size_t)rr * 128 * DFF;
    }
    return w;
}
__device__ __forceinline__ void p0_transpose(const WBlk& w, int rg, int kb, LAS float* scr, int lane) {
    const int k0 = 64 * kb, n0 = 32 * rg;
    { const int r8 = lane >> 3, c4 = lane & 7; f32x4 v[8];
#pragma unroll
        for (int i = 0; i < 8; ++i) v[i] = *(const f32x4*)(w.src + (size_t)(k0 + 8 * i + r8) * w.ld + w.c0 + n0 + 4 * c4);
#pragma unroll
        for (int i = 0; i < 8; ++i) { LAS float* d = scr + (8 * i + r8) * 33 + 4 * c4; d[0] = v[i].x; d[1] = v[i].y; d[2] = v[i].z; d[3] = v[i].w; } }
    LDS_WAIT(); asm volatile("" ::: "memory");
    const int c = lane & 7;
#pragma unroll
    for (int j = 0; j < 4; ++j) { const int n = (lane >> 3) + 8 * j; const LAS float* s = scr + (8 * c) * 33 + n;
        u32x4 o; o.x = cvt_pk_bf16(s[0 * 33], s[1 * 33]); o.y = cvt_pk_bf16(s[2 * 33], s[3 * 33]); o.z = cvt_pk_bf16(s[4 * 33], s[5 * 33]); o.w = cvt_pk_bf16(s[6 * 33], s[7 * 33]);
        *(u32x4*)(w.dst + (size_t)(n0 + n) * w.K + k0 + 8 * c) = o; }
    LDS_WAIT(); asm volatile("" ::: "memory");
}
__device__ __forceinline__ void phase_p0(const Ctx& C) {
    for (int it = C.bid; it < 192; it += C.G) p0_adaln(C, it);
    LAS float* scr = (LAS float*)(C.lds + C.wave * 16384);
    const int gw = C.bid * 8 + C.wave, NGW = C.G * 8;
    constexpr int N0 = 288 * 16, N1 = 64 * 4, N2 = 32 * 44;
    for (int it = gw; it < N0 + N1 + N2; it += NGW) {
        int cls, vb, rg, kc;
        if (it < N0) { cls = 0; vb = it >> 4; rg = (it >> 2) & 3; kc = it & 3; }
        else if (it < N0 + N1) { const int r = it - N0; cls = 1; vb = r >> 2; rg = r & 3; kc = 0; }
        else { const int r = it - N0 - N1; cls = 2; vb = r / 44; const int rem = r % 44; rg = rem / 11; kc = rem % 11; }
        const WBlk w = get_wblk(C, cls, vb);
        for (int kb = 4 * kc; kb < 4 * kc + 4; ++kb) p0_transpose(w, rg, kb, scr, C.lane);
    }
}

__device__ __forceinline__ void p1_rows4(const float* __restrict__ xbase, bf16_t* __restrict__ obase, bf16_t* __restrict__ rbase, float* __restrict__ ssbase, int nss, const f32x4 (&gs)[4], int r0, int lane) {
    f32x4 v[4][4];
#pragma unroll
    for (int q = 0; q < 4; ++q)
#pragma unroll
        for (int j = 0; j < 4; ++j) v[q][j] = ((const f32x4*)(xbase + (size_t)(r0 + q) * D) + lane)[64 * j];
#pragma unroll
    for (int q = 0; q < 4; ++q) { float s = 0.f;
#pragma unroll
        for (int j = 0; j < 4; ++j) s += (v[q][j].x * v[q][j].x + v[q][j].y * v[q][j].y) + (v[q][j].z * v[q][j].z + v[q][j].w * v[q][j].w);
        s = wave_sum(s);
        if (lane < nss) ssbase[(size_t)(r0 + q) * nss + lane] = lane == 0 ? s : 0.f;
#pragma unroll
        for (int j = 0; j < 4; ++j) { const f32x4 y = v[q][j] * gs[j]; u32x2 w; w.x = cvt_pk_bf16(y.x, y.y); w.y = cvt_pk_bf16(y.z, y.w); ((u32x2*)(obase + (size_t)(r0 + q) * D) + lane)[64 * j] = w;
            if (rbase) { u32x2 r; r.x = cvt_pk_bf16(v[q][j].x, v[q][j].y); r.y = cvt_pk_bf16(v[q][j].z, v[q][j].w); ((u32x2*)(rbase + (size_t)(r0 + q) * D) + lane)[64 * j] = r; } } }
}
__device__ __forceinline__ void phase_p1(const Ctx& C) {
    const int gw = C.bid * 8 + C.wave, NGW = C.G * 8;
    const float* __restrict__ mods = WSP(float, WS_MODS);
    for (int s = 0; s < 2; ++s) {
        f32x4 gs[4];
#pragma unroll
        for (int j = 0; j < 4; ++j) gs[j] = *((const f32x4*)INP(IX_NMG) + C.lane + 64 * j) * (*((const f32x4*)(mods + (size_t)s * NMOD + 1024) + C.lane + 64 * j) + 1.0f);
        const int nrow = s ? CT : T;
        for (int r0 = gw * 4; r0 < nrow; r0 += NGW * 4)
            p1_rows4(s ? INP(IX_CTX) : INP(IX_X), s ? WSP(bf16_t, CX_XB) : WSP(bf16_t, WS_SLOT), s ? nullptr : WSP(bf16_t, WS_XRES), s ? WSP(float, CX_SSP) : WSP(float, WS_SSP), s ? 64 : 16, gs, r0, C.lane);
    }
    for (int rb = gw; rb < 2048; rb += NGW) {
        const int r = rb * 16; const bf16_t* __restrict__ bt; int l, shoff; float* __restrict__ outp; int ostride;
        if (r < 4096) { const int j = r / 2048, n = r % 2048; bt = WSP(bf16_t, W_A1 + j * SZ_A1) + (size_t)n * 1024; l = 2 * j; shoff = 0; outp = WSP(float, WS_BIASM) + (size_t)(l * 2) * 3072 + n; ostride = 3072; }
        else if (r < 10240) { const int rr = r - 4096, j = rr / 3072, n = rr % 3072; bt = WSP(bf16_t, W_B1 + j * SZ_B1) + (size_t)n * 1024; l = 2 * j + 1; shoff = 0; outp = WSP(float, WS_BIASM) + (size_t)(l * 2) * 3072 + n; ostride = 3072; }
        else { const int rr = r - 10240; l = rr / 5632; const int n = rr % 5632; bt = WSP(bf16_t, W_F1 + l * SZ_F1) + (size_t)n * 1024; shoff = 3072; outp = WSP(float, WS_BIASF) + (size_t)(l * 2) * 5632 + n; ostride = 5632; }
        f32x4 sh[2][2][2];
#pragma unroll
        for (int st = 0; st < 2; ++st)
#pragma unroll
            for (int h = 0; h < 2; ++h) { const float* p = mods + (size_t)(l * 2 + st) * NMOD + shoff + h * 512 + 8 * C.lane; sh[st][h][0] = *(const f32x4*)p; sh[st][h][1] = *(const f32x4*)(p + 4); }
#pragma unroll 1
        for (int b4 = 0; b4 < 4; ++b4) {
            u32x4 wv[4][2];
#pragma unroll
            for (int q = 0; q < 4; ++q)
#pragma unroll
                for (int h = 0; h < 2; ++h) wv[q][h] = *(const u32x4*)(bt + (size_t)(b4 * 4 + q) * 1024 + h * 512 + 8 * C.lane);
#pragma unroll
            for (int q = 0; q < 4; ++q) { float a0 = 0.f, a1 = 0.f;
#pragma unroll
                for (int h = 0; h < 2; ++h) { const u32x4 w = wv[q][h];
                    const f32x4 lo = (f32x4){bf2f(w.x & 0xffffu), bf2f(w.x >> 16), bf2f(w.y & 0xffffu), bf2f(w.y >> 16)}, hi = (f32x4){bf2f(w.z & 0xffffu), bf2f(w.z >> 16), bf2f(w.w & 0xffffu), bf2f(w.w >> 16)};
                    const f32x4 p0 = lo * sh[0][h][0] + hi * sh[0][h][1], p1 = lo * sh[1][h][0] + hi * sh[1][h][1];
                    a0 += (p0.x + p0.y) + (p0.z + p0.w); a1 += (p1.x + p1.y) + (p1.z + p1.w); }
                a0 = wave_sum(a0); a1 = wave_sum(a1);
                if (C.lane == 0) { outp[b4 * 4 + q] = a0; outp[ostride + b4 * 4 + q] = a1; } }
        }
    }
    for (int i = C.bid * 512 + C.tid; i < 4096; i += C.G * 512) { const float x = INP(IX_ALAM)[i]; const float ls = fminf(x, 0.f) - log1pf(expf(-fabsf(x))); WSP(float, WS_LA8)[i] = 8.0f * 1.4426950409f * ls; }
}

__device__ __forceinline__ void phase_conv4(const Ctx& C, const bf16_t* __restrict__ UPRE, bf16_t* __restrict__ U, const float* __restrict__ cw, const float* __restrict__ cb) {
    const int cg = C.tid & 127, sub = C.tid >> 7, c0 = cg * 8;
    float w[4][8], b[8];
#pragma unroll
    for (int k = 0; k < 4; ++k)
#pragma unroll
        for (int e = 0; e < 8; ++e) w[k][e] = cw[k * D + c0 + e];
#pragma unroll
    for (int e = 0; e < 8; ++e) b[e] = cb[c0 + e];
    for (int it = C.bid; it < T / 64; it += C.G) {
        const int t0 = it * 64 + sub * 16;
        float win[3][8];
#pragma unroll
        for (int r = 0; r < 3; ++r) { const int t = t0 - 2 + r; u32x4 v = *(const u32x4*)(UPRE + (size_t)(t >= 0 ? t : 0) * D + c0); if (t < 0) v = (u32x4){0u, 0u, 0u, 0u};
            win[r][0] = bf2f(v.x & 0xffffu); win[r][1] = bf2f(v.x >> 16); win[r][2] = bf2f(v.y & 0xffffu); win[r][3] = bf2f(v.y >> 16); win[r][4] = bf2f(v.z & 0xffffu); win[r][5] = bf2f(v.z >> 16); win[r][6] = bf2f(v.w & 0xffffu); win[r][7] = bf2f(v.w >> 16); }
#pragma unroll
        for (int i = 0; i < 16; ++i) { const int t = t0 + i; u32x4 v = *(const u32x4*)(UPRE + (size_t)(t + 1 < T ? t + 1 : T - 1) * D + c0); if (t + 1 >= T) v = (u32x4){0u, 0u, 0u, 0u};
            const float nx[8] = {bf2f(v.x & 0xffffu), bf2f(v.x >> 16), bf2f(v.y & 0xffffu), bf2f(v.y >> 16), bf2f(v.z & 0xffffu), bf2f(v.z >> 16), bf2f(v.w & 0xffffu), bf2f(v.w >> 16)};
            float o[8];
#pragma unroll
            for (int e = 0; e < 8; ++e) { o[e] = b[e] + w[0][e] * win[0][e] + w[1][e] * win[1][e] + w[2][e] * win[2][e] + w[3][e] * nx[e]; win[0][e] = win[1][e]; win[1][e] = win[2][e]; win[2][e] = nx[e]; }
            u32x4 ow; ow.x = cvt_pk_bf16(o[0], o[1]); ow.y = cvt_pk_bf16(o[2], o[3]); ow.z = cvt_pk_bf16(o[4], o[5]); ow.w = cvt_pk_bf16(o[6], o[7]);
            *(u32x4*)(U + (size_t)t * D + c0) = ow; }
    }
}
__device__ __forceinline__ void phase_vconv(const Ctx& C, const bf16_t* __restrict__ GB, const bf16_t* __restrict__ Z, bf16_t* __restrict__ Q, const float* __restrict__ cw, const float* __restrict__ cb) {
    const int cg = C.tid & 127, sub = C.tid >> 7, c0 = cg * 8;
    float w[3][8], b[8];
#pragma unroll
    for (int k = 0; k < 3; ++k)
#pragma unroll
        for (int e = 0; e < 8; ++e) w[k][e] = cw[k * D + c0 + e];
#pragma unroll
    for (int e = 0; e < 8; ++e) b[e] = cb[c0 + e];
    const int vb = (C.G & 7) == 0 ? (C.bid & 7) * (C.G >> 3) + (C.bid >> 3) : C.bid;
    for (int it = vb; it < T / 64; it += C.G) {
        const int t0 = it * 64 + sub * 16;
        const bool lo_ok = it > 0, hi_ok = it < T / 64 - 1;
        const long om = lo_ok ? -(long)64 * D : 0, op = hi_ok ? (long)64 * D : 0; const float ml = lo_ok ? 1.f : 0.f, mh = hi_ok ? 1.f : 0.f;
#pragma unroll 8
        for (int i = 0; i < 16; ++i) { const int t = t0 + i; const size_t off = (size_t)t * D + c0;
            const u32x4 g = *(const u32x4*)(GB + off), z1 = *(const u32x4*)(Z + off);
            const u32x4 z0 = *(const u32x4*)(Z + (long)off + om), z2 = *(const u32x4*)(Z + (long)off + op);
            const unsigned gw[4] = {g.x, g.y, g.z, g.w}, a0[4] = {z0.x, z0.y, z0.z, z0.w}, a1[4] = {z1.x, z1.y, z1.z, z1.w}, a2[4] = {z2.x, z2.y, z2.z, z2.w};
            unsigned ow[4];
#pragma unroll
            for (int p = 0; p < 4; ++p) {
                const float lo = bf2f(gw[p] & 0xffffu) * (b[2 * p] + ml * w[0][2 * p] * bf2f(a0[p] & 0xffffu) + w[1][2 * p] * bf2f(a1[p] & 0xffffu) + mh * w[2][2 * p] * bf2f(a2[p] & 0xffffu));
                const float hi = bf2f(gw[p] >> 16) * (b[2 * p + 1] + ml * w[0][2 * p + 1] * bf2f(a0[p] >> 16) + w[1][2 * p + 1] * bf2f(a1[p] >> 16) + mh * w[2][2 * p + 1] * bf2f(a2[p] >> 16));
                ow[p] = cvt_pk_bf16(lo, hi); }
            *(u32x4*)(Q + off) = (u32x4){ow[0], ow[1], ow[2], ow[3]}; }
    }
}

typedef _Float16 h16x8 __attribute__((ext_vector_type(8)));
__device__ __forceinline__ void eb_unpack(u32x4 w, f32x4& a, f32x4& b) {
    const h16x8 h = __builtin_bit_cast(h16x8, w);
    a = (f32x4){1.0f - (float)h[0], 1.0f - (float)h[2], 1.0f - (float)h[4], 1.0f - (float)h[6]}; b = (f32x4){(float)h[1], (float)h[3], (float)h[5], (float)h[7]};
}
__device__ __forceinline__ void phase_scan1(const Ctx& C, const h16* __restrict__ EB) {
    LAS float* lagg = (LAS float*)C.lds;
    for (int task = C.bid; task < 256; task += C.G) {
        const int j = task >> 2, cbk = task & 3, ch = cbk * 256 + 4 * C.lane, r0 = j * 256 + 32 * C.wave;
#pragma unroll
        for (int d = 0; d < 2; ++d) {
            const h16* e = EB + (((size_t)d * T + r0) * D + ch) * 2;
            f32x4 P = {1.f, 1.f, 1.f, 1.f}, Q = {0.f, 0.f, 0.f, 0.f};
            u32x4 ev[32];
#pragma unroll
            for (int i = 0; i < 32; ++i) ev[i] = *(const u32x4*)(e + (size_t)i * D * 2);
#pragma unroll
            for (int i = 0; i < 32; ++i) { const int ii = d ? 31 - i : i; f32x4 a, bb; eb_unpack(ev[ii], a, bb); P = P * a; Q = a * Q + bb; }
            float* ag = WSP(float, WS_AGG32) + (((size_t)d * 512 + j * 8 + C.wave) * D + ch) * 2;
            *(f32x4*)ag = (f32x4){P[0], Q[0], P[1], Q[1]}; *(f32x4*)(ag + 4) = (f32x4){P[2], Q[2], P[3], Q[3]};
            LAS float* la = lagg + ((d * 8 + C.wave) * 256 + 4 * C.lane) * 2;
            *(LAS f32x4*)la = (f32x4){P[0], Q[0], P[1], Q[1]}; *(LAS f32x4*)(la + 4) = (f32x4){P[2], Q[2], P[3], Q[3]};
        }
        __syncthreads();
        { const int d = C.tid >> 8, c = C.tid & 255; float P = 1.f, Q = 0.f;
#pragma unroll
            for (int i = 0; i < 8; ++i) { const int w = d ? 7 - i : i; const f32x2 pq = *(const LAS f32x2*)(lagg + ((d * 8 + w) * 256 + c) * 2); Q = pq.x * Q + pq.y; P *= pq.x; }
            *(f32x2*)(WSP(float, WS_AGGT) + (((size_t)d * 64 + j) * D + cbk * 256 + c) * 2) = (f32x2){P, Q}; }
        __syncthreads();
    }
}
__device__ __forceinline__ void phase_scan2(const Ctx& C, const h16* __restrict__ EB, const bf16_t* __restrict__ Gt, bf16_t* __restrict__ GS, const float* __restrict__ h0) {
    LAS float* cin = (LAS float*)(C.lds + RING_BYTES + 1024);
    LAS unsigned char* hbw = C.lds + C.wave * 16384 + 8 * C.lane;
    for (int task = C.bid; task < 256; task += C.G) {
        const int j = task >> 2, cbk = task & 3;
        const int ch = cbk * 256 + 4 * C.lane, r0 = j * 256 + 32 * C.wave;
        u32x4 ev[32];
        { const h16* e = EB + (((size_t)T + r0) * D + ch) * 2;
#pragma unroll
            for (int i = 0; i < 32; ++i) ev[i] = *(const u32x4*)(e + (size_t)i * D * 2); }
        { int tid_ = C.tid; asm volatile("" : "+v"(tid_));
            const int d = tid_ >> 8, c = tid_ & 255, chn = cbk * 256 + c; float h = h0[d * D + chn];
            const int n = d ? 63 - j : j; const float* base = WSP(float, WS_AGGT) + ((size_t)d * 64 * D + chn) * 2;
            for (int i = 0; i < n; i += 16) { f32x2 pq[16];
#pragma unroll
                for (int u = 0; u < 16; ++u) { const int ii = i + u; const int im = ii < n ? ii : n - 1; const int jj = d ? 63 - im : im; pq[u] = *(const f32x2*)(base + (size_t)jj * D * 2); if (ii >= n) pq[u] = (f32x2){1.f, 0.f}; }
#pragma unroll
                for (int u = 0; u < 16; ++u) h = pq[u].x * h + pq[u].y; }
            cin[d * 256 + c] = h; }
        __syncthreads();
        f32x4 hc[2];
#pragma unroll
        for (int d = 0; d < 2; ++d) { f32x4 h = *(const LAS f32x4*)(cin + d * 256 + 4 * C.lane); const int n = d ? 7 - C.wave : C.wave;
            f32x4 pq[7][2];
#pragma unroll
            for (int u = 0; u < 7; ++u) { const int im = u < n ? u : (n > 0 ? n - 1 : 0); const int w = d ? 7 - im : im; const float* ag = WSP(float, WS_AGG32) + (((size_t)d * 512 + j * 8 + w) * D + ch) * 2; pq[u][0] = *(const f32x4*)ag; pq[u][1] = *(const f32x4*)(ag + 4); }
#pragma unroll
            for (int u = 0; u < 7; ++u) if (u < n) { h[0] = pq[u][0][0] * h[0] + pq[u][0][1]; h[1] = pq[u][0][2] * h[1] + pq[u][0][3]; h[2] = pq[u][1][0] * h[2] + pq[u][1][1]; h[3] = pq[u][1][2] * h[3] + pq[u][1][3]; }
            hc[d] = h; }
        { f32x4 h = hc[1];
#pragma unroll
            for (int i = 31; i >= 0; --i) { f32x4 a, bb; eb_unpack(ev[i], a, bb); h = a * h + bb;
                u32x2 w; w.x = cvt_pk_bf16(h[0], h[1]); w.y = cvt_pk_bf16(h[2], h[3]); *(LAS u32x2*)(hbw + i * 512) = w; } }
        { f32x4 h = hc[0]; const h16* e = EB + ((size_t)r0 * D + ch) * 2;
#pragma unroll
            for (int hb2 = 0; hb2 < 2; ++hb2) { u32x2 gv[16];
#pragma unroll
                for (int i = 0; i < 16; ++i) { ev[i] = *(const u32x4*)(e + (size_t)(16 * hb2 + i) * D * 2); gv[i] = *(const u32x2*)(Gt + (size_t)(r0 + 16 * hb2 + i) * D + ch); }
#pragma unroll
                for (int i = 0; i < 16; ++i) { f32x4 a, bb; eb_unpack(ev[i], a, bb); h = a * h + bb;
                    const f32x4 hb = bf4_to_f4(*(const LAS u32x2*)(hbw + (16 * hb2 + i) * 512)); const f32x4 o = bf4_to_f4(gv[i]) * (h + hb);
                    u32x2 w; w.x = cvt_pk_bf16(o[0], o[1]); w.y = cvt_pk_bf16(o[2], o[3]); *(u32x2*)(GS + (size_t)(r0 + 16 * hb2 + i) * D + ch) = w; } } }
        __syncthreads();
    }
}
__device__ __forceinline__ void phase_final(const Ctx& C, const float* __restrict__ ssp) {
    const int gw = C.bid * 8 + C.wave, NGW = C.G * 8;
    const bf16_t* __restrict__ xres = WSP(bf16_t, WS_XRES); float* __restrict__ out = C.out; const float* __restrict__ fg = INP(IX_FG);
    f32x4 g[4];
#pragma unroll
    for (int j = 0; j < 4; ++j) g[j] = *((const f32x4*)fg + C.lane + 64 * j);
    for (int r0 = gw * 4; r0 < T; r0 += NGW * 4) {
        u32x2 xv[4][4]; float sv[4];
#pragma unroll
        for (int q = 0; q < 4; ++q) { { const float v_ = ssp[(size_t)(r0 + q) * 16 + (C.lane & 15)]; sv[q] = C.lane < 16 ? v_ : 0.f; }
#pragma unroll
            for (int j = 0; j < 4; ++j) xv[q][j] = ((const u32x2*)(xres + (size_t)(r0 + q) * D) + C.lane)[64 * j]; }
#pragma unroll
        for (int q = 0; q < 4; ++q) { const float rstd = 1.0f / sqrtf(wave_sum(sv[q]) * (1.0f / D) + EPS); f32x4* orow = (f32x4*)(out + (size_t)(r0 + q) * D) + C.lane;
#pragma unroll
            for (int j = 0; j < 4; ++j) orow[64 * j] = bf4_to_f4(xv[q][j]) * rstd * g[j]; }
    }
}
template <int NB, int UNR, int K>
__device__ __forceinline__ void ctx_mm(f32x4 (&acc)[2][NB], const bf16_t* A, int lda, const bf16_t* const (&Bp)[NB], int wave, int lane, int tid, LAS unsigned char* lds) {
    const int fr = lane & 15, fq = lane >> 4;
    constexpr int ROWB = K * 2 + 16, PPT = K / 256;
    {   u32x4 stg[NB][PPT];
#pragma unroll
        for (int nb = 0; nb < NB; ++nb)
#pragma unroll
            for (int q = 0; q < PPT; ++q) { const int p = tid + 512 * q, r = p / (K / 8), kc = p % (K / 8); stg[nb][q] = *(const u32x4*)(Bp[nb] + (size_t)r * K + kc * 8); }
#pragma unroll
        for (int nb = 0; nb < NB; ++nb)
#pragma unroll
            for (int q = 0; q < PPT; ++q) { const int p = tid + 512 * q, r = p / (K / 8), kc = p % (K / 8); *(LAS u32x4*)(lds + (nb * 16 + r) * ROWB + kc * 16) = stg[nb][q]; } }
    const bf16_t* a0 = A + (size_t)(32 * wave + fr) * lda + 8 * fq; const bf16_t* a1 = a0 + (size_t)16 * lda;
#pragma unroll
    for (int nb = 0; nb < NB; ++nb) { acc[0][nb] = (f32x4){0.f, 0.f, 0.f, 0.f}; acc[1][nb] = (f32x4){0.f, 0.f, 0.f, 0.f}; }
    __syncthreads();
    const LAS unsigned char* bl = lds + fr * ROWB + fq * 16;
#pragma unroll 1
    for (int k0 = 0; k0 < K; k0 += 32 * UNR) {
        bf16x8 af[UNR][2];
#pragma unroll
        for (int u = 0; u < UNR; ++u) { af[u][0] = *(const bf16x8*)(a0 + k0 + 32 * u); af[u][1] = *(const bf16x8*)(a1 + k0 + 32 * u); }
        __builtin_amdgcn_sched_barrier(0);
#pragma unroll
        for (int u = 0; u < UNR; ++u)
#pragma unroll
            for (int nb = 0; nb < NB; ++nb) { const bf16x8 bf = *(const LAS bf16x8*)(bl + nb * 16 * ROWB + (k0 + 32 * u) * 2);
                acc[0][nb] = __builtin_amdgcn_mfma_f32_16x16x32_bf16(bf, af[u][0], acc[0][nb], 0, 0, 0); acc[1][nb] = __builtin_amdgcn_mfma_f32_16x16x32_bf16(bf, af[u][1], acc[1][nb], 0, 0, 0); }
        __builtin_amdgcn_sched_barrier(0);
    }
    __syncthreads();
}
template <int UNR, int K>
__device__ __forceinline__ void ctx_mm1(f32x4& acc, const bf16_t* A, int lda, const bf16_t* Bp, int row0, int lane, int tid, LAS unsigned char* lds) {
    const int fr = lane & 15, fq = lane >> 4;
    constexpr int ROWB = K * 2 + 16, PPT = K / 256;
    {   u32x4 stg[PPT];
#pragma unroll
        for (int q = 0; q < PPT; ++q) { const int p = tid + 512 * q, r = p / (K / 8), kc = p % (K / 8); stg[q] = *(const u32x4*)(Bp + (size_t)r * K + kc * 8); }
#pragma unroll
        for (int q = 0; q < PPT; ++q) { const int p = tid + 512 * q, r = p / (K / 8), kc = p % (K / 8); *(LAS u32x4*)(lds + r * ROWB + kc * 16) = stg[q]; } }
    const bf16_t* a0 = A + (size_t)(row0 + fr) * lda + 8 * fq;
    acc = (f32x4){0.f, 0.f, 0.f, 0.f};
    __syncthreads();
    const LAS unsigned char* bl = lds + fr * ROWB + fq * 16;
#pragma unroll 1
    for (int k0 = 0; k0 < K; k0 += 32 * UNR) {
        bf16x8 af[UNR];
#pragma unroll
        for (int u = 0; u < UNR; ++u) af[u] = *(const bf16x8*)(a0 + k0 + 32 * u);
        __builtin_amdgcn_sched_barrier(0);
#pragma unroll
        for (int u = 0; u < UNR; ++u) { const bf16x8 bf = *(const LAS bf16x8*)(bl + (k0 + 32 * u) * 2); acc = __builtin_amdgcn_mfma_f32_16x16x32_bf16(bf, af[u], acc, 0, 0, 0); }
        __builtin_amdgcn_sched_barrier(0);
    }
    __syncthreads();
}
struct CtxSS { f32x4 a, b, c, d; };
__device__ __forceinline__ CtxSS ctx_ss_load(const float* sspc, int row, int fq) { const float* p = sspc + (size_t)row * 64 + fq * 16; CtxSS r; r.a = *(const f32x4*)p; r.b = *(const f32x4*)(p + 4); r.c = *(const f32x4*)(p + 8); r.d = *(const f32x4*)(p + 12); return r; }
__device__ __forceinline__ float ctx_rstd_fin(const CtxSS& v, int fr, int fq) {
    float s = ((v.a.x + v.a.y) + (v.a.z + v.a.w)) + ((v.b.x + v.b.y) + (v.b.z + v.b.w)) + ((v.c.x + v.c.y) + (v.c.z + v.c.w)) + ((v.d.x + v.d.y) + (v.d.z + v.d.w));
    s = add_x16(s); s = add_x32(s, XL32(fr, fq));
    return 1.0f / sqrtf(s * (1.0f / D) + EPS);
}
struct CtxP {
    int kind;
    const bf16_t* A; int lda, K; const bf16_t* Bt; const float* sspi; const float* bias;
    const float* hin; float* hout; bf16_t* xbo; const float* gate; const float* ng; const float* sc; float* sspo;
    bf16_t* o1; bf16_t* o2;
    const float* cw; const float* cb; const float* br; const float* bi; const float* la8; float* h0;
};
template <int KW> struct CtxCW { f32x4 w[KW][2]; f32x4 b[2]; };
template <int KW>
__device__ __forceinline__ CtxCW<KW> ctx_cw_load(const float* cw, int cstride, const float* cb, int c) {
    CtxCW<KW> r;
#pragma unroll
    for (int k = 0; k < KW; ++k) { r.w[k][0] = *(const f32x4*)(cw + (size_t)k * cstride + c); r.w[k][1] = *(const f32x4*)(cw + (size_t)k * cstride + c + 4); }
    r.b[0] = *(const f32x4*)(cb + c); r.b[1] = *(const f32x4*)(cb + c + 4);
    return r;
}
template <int KW, int PAD>
__device__ __forceinline__ void ctx_conv_rows(float (&o)[8], const LAS float* tile, int t, int hh, const CtxCW<KW>& cwv) {
    f32x4 o0 = cwv.b[0], o1 = cwv.b[1];
#pragma unroll
    for (int k = 0; k < KW; ++k) { const int tt = t + k - PAD; if (tt >= 0 && tt < CT) {
        const f32x4 a = *(const LAS f32x4*)(tile + tt * 16 + 8 * hh), b = *(const LAS f32x4*)(tile + tt * 16 + 8 * hh + 4);
        o0 += cwv.w[k][0] * a; o1 += cwv.w[k][1] * b; } }
    o[0] = o0[0]; o[1] = o0[1]; o[2] = o0[2]; o[3] = o0[3]; o[4] = o1[0]; o[5] = o1[1]; o[6] = o1[2]; o[7] = o1[3];
}
__device__ __forceinline__ void ctx_item(const Ctx& C0, const CtxP& P, int item) {
    Ctx C = C0; asm volatile("" : "+v"(C.lane)); C.tid = C.wave * 64 + C.lane;
    const int fr = C.lane & 15, fq = C.lane >> 4, c0 = 16 * item;
    LAS float* t0 = (LAS float*)C.lds; LAS float* t1 = t0 + 4096; LAS float* t2 = t1 + 4096; LAS float* t3 = t2 + 4096; LAS float* tagg = t3 + 4096;
    const int tt = C.tid >> 1, hh = C.tid & 1;
    if (P.kind == 1) {
        f32x4 acc[2][2]; const bf16_t* const Bp[2] = {P.Bt + (size_t)c0 * P.K, P.Bt + (size_t)(1024 + c0) * P.K};
        const f32x4 b0 = *(const f32x4*)(P.bias + c0 + 4 * fq), b1 = *(const f32x4*)(P.bias + 1024 + c0 + 4 * fq);
        const CtxSS ssv[2] = {ctx_ss_load(P.sspi, 32 * C.wave + fr, fq), ctx_ss_load(P.sspi, 32 * C.wave + 16 + fr, fq)};
        ctx_mm<2, 16, 1024>(acc, P.A, P.lda, Bp, C.wave, C.lane, C.tid, C.lds);
        const CtxCW<4> cwv = ctx_cw_load<4>(P.cw, D, P.cb, c0 + 8 * hh);
#pragma unroll
        for (int g = 0; g < 2; ++g) { const int t = 32 * C.wave + 16 * g + fr; const float rs = ctx_rstd_fin(ssv[g], fr, fq);
            *(LAS f32x4*)(t0 + t * 16 + 4 * fq) = acc[g][0] * rs + b0;
            const f32x4 gp = acc[g][1] * rs + b1; u32x2 w; w.x = cvt_pk_bf16(gelu_t(gp[0]), gelu_t(gp[1])); w.y = cvt_pk_bf16(gelu_t(gp[2]), gelu_t(gp[3]));
            *(u32x2*)(P.o2 + (size_t)t * D + c0 + 4 * fq) = w; }
        __syncthreads();
        float o[8]; ctx_conv_rows<4, 2>(o, t0, tt, hh, cwv);
        u32x4 w; w.x = cvt_pk_bf16(o[0], o[1]); w.y = cvt_pk_bf16(o[2], o[3]); w.z = cvt_pk_bf16(o[4], o[5]); w.w = cvt_pk_bf16(o[6], o[7]);
        *(u32x4*)(P.o1 + (size_t)tt * D + c0 + 8 * hh) = w;
        __syncthreads();
    } else if (P.kind == 2) {
        f32x4 acc[2][4]; const int q = c0 >> 7, cl = c0 & 127, h = c0 >> 8;
        const bf16_t* const Bp[4] = {P.Bt + (size_t)((0 * 8 + q) * 256 + cl) * 256, P.Bt + (size_t)((0 * 8 + q) * 256 + 128 + cl) * 256, P.Bt + (size_t)((1 * 8 + q) * 256 + cl) * 256, P.Bt + (size_t)((1 * 8 + q) * 256 + 128 + cl) * 256};
        const u32x2 uw2[2] = {*(const u32x2*)(P.A + (size_t)(32 * C.wave + fr) * P.lda + c0 + 4 * fq), *(const u32x2*)(P.A + (size_t)(32 * C.wave + 16 + fr) * P.lda + c0 + 4 * fq)};
        f32x4 brv2[2], biv2[2], lav2[2];
#pragma unroll
        for (int d = 0; d < 2; ++d) { brv2[d] = *(const f32x4*)(P.br + d * D + c0 + 4 * fq); biv2[d] = *(const f32x4*)(P.bi + d * D + c0 + 4 * fq); lav2[d] = *(const f32x4*)(P.la8 + d * D + c0 + 4 * fq); }
        ctx_mm<4, 8, 256>(acc, P.A + h * 256, P.lda, Bp, C.wave, C.lane, C.tid, C.lds);
#pragma unroll
        for (int g = 0; g < 2; ++g) { const int t = 32 * C.wave + 16 * g + fr; const f32x4 uu = bf4_to_f4(uw2[g]);
#pragma unroll
            for (int d = 0; d < 2; ++d) { const f32x4 brv = brv2[d], biv = biv2[d], lav = lav2[d];
                f32x4 av, bv;
#pragma unroll
                for (int j = 0; j < 4; ++j) { const float r = sigm(acc[g][2 * d][j] + brv[j]), ig = sigm(acc[g][2 * d + 1][j] + biv[j]); const float a = __builtin_amdgcn_exp2f(r * lav[j]), e = 1.0f - a; av[j] = a; bv[j] = __builtin_amdgcn_sqrtf(e * (1.0f + a)) * ig * uu[j]; }
                *(LAS f32x4*)((d ? t2 : t0) + t * 16 + 4 * fq) = av; *(LAS f32x4*)((d ? t3 : t1) + t * 16 + 4 * fq) = bv; } }
        __syncthreads();
        { const int c = C.tid & 15, d = (C.tid >> 4) & 1, chk = C.tid >> 5; const LAS float* ta = d ? t2 : t0; LAS float* tb = d ? t3 : t1;
            float Pp = 1.f, Qq = 0.f;
#pragma unroll
            for (int i = 0; i < 16; ++i) { const int t = 16 * chk + (d ? 15 - i : i); const float a = ta[t * 16 + c], b = tb[t * 16 + c]; Qq = a * Qq + b; Pp *= a; }
            tagg[((d * 16 + chk) * 16 + c) * 2] = Pp; tagg[((d * 16 + chk) * 16 + c) * 2 + 1] = Qq;
            __syncthreads();
            float hcar = 0.f; const int n = d ? 15 - chk : chk;
            for (int i = 0; i < n; ++i) { const int cc = d ? 15 - i : i; hcar = tagg[((d * 16 + cc) * 16 + c) * 2] * hcar + tagg[((d * 16 + cc) * 16 + c) * 2 + 1]; }
#pragma unroll
            for (int i = 0; i < 16; ++i) { const int t = 16 * chk + (d ? 15 - i : i); hcar = ta[t * 16 + c] * hcar + tb[t * 16 + c]; tb[t * 16 + c] = hcar; }
            if ((d == 0 && chk == 15) || (d == 1 && chk == 0)) P.h0[d * D + c0 + c] = hcar; }
        __syncthreads();
        if (P.o1) { const f32x4 f0 = *(const LAS f32x4*)(t1 + tt * 16 + 8 * hh), f1 = *(const LAS f32x4*)(t1 + tt * 16 + 8 * hh + 4), r0 = *(const LAS f32x4*)(t3 + tt * 16 + 8 * hh), r1 = *(const LAS f32x4*)(t3 + tt * 16 + 8 * hh + 4);
            const u32x4 gw = *(const u32x4*)(P.o2 + (size_t)tt * D + c0 + 8 * hh);
            const f32x4 s0 = f0 + r0, s1 = f1 + r1;
            u32x4 w; w.x = cvt_pk_bf16(bf2f(gw.x & 0xffffu) * s0[0], bf2f(gw.x >> 16) * s0[1]); w.y = cvt_pk_bf16(bf2f(gw.y & 0xffffu) * s0[2], bf2f(gw.y >> 16) * s0[3]);
            w.z = cvt_pk_bf16(bf2f(gw.z & 0xffffu) * s1[0], bf2f(gw.z >> 16) * s1[1]); w.w = cvt_pk_bf16(bf2f(gw.w & 0xffffu) * s1[2], bf2f(gw.w >> 16) * s1[3]);
            *(u32x4*)(P.o1 + (size_t)tt * D + c0 + 8 * hh) = w; }
        __syncthreads();
    } else if (P.kind == 4) {
        const int cg = item & 63, c4 = 16 * cg, t = 128 * (item >> 6) + 16 * C.wave + fr; const size_t off = (size_t)t * D + c4 + 4 * fq;
        const f32x4 gv = *(const f32x4*)(P.gate + c4 + 4 * fq); const f32x4 gs = *(const f32x4*)(P.ng + c4 + 4 * fq) * (*(const f32x4*)(P.sc + c4 + 4 * fq) + 1.0f);
        const f32x4 hold = *(const f32x4*)(P.hin + off);
        f32x4 acc;
        if (P.K == D) ctx_mm1<32, 1024>(acc, P.A, P.lda, P.Bt + (size_t)c4 * 1024, 128 * (item >> 6) + 16 * C.wave, C.lane, C.tid, C.lds);
        else ctx_mm1<22, 2816>(acc, P.A, P.lda, P.Bt + (size_t)c4 * 2816, 128 * (item >> 6) + 16 * C.wave, C.lane, C.tid, C.lds);
        const f32x4 hn = hold + gv * acc;
        *(f32x4*)(P.hout + off) = hn;
        float ss = (hn[0] * hn[0] + hn[1] * hn[1]) + (hn[2] * hn[2] + hn[3] * hn[3]); ss = add_x16(ss); ss = add_x32(ss, XL32(fr, fq));
        if (fq == 0) P.sspo[(size_t)t * 64 + cg] = ss;
        const f32x4 y = hn * gs; u32x2 w; w.x = cvt_pk_bf16(y[0], y[1]); w.y = cvt_pk_bf16(y[2], y[3]); *(u32x2*)(P.xbo + off) = w;
    } else if (P.kind == 5) {
        f32x4 acc[2][2]; const int q = c0 >> 7, cl = c0 & 127, nb0 = q * 256 + cl;
        const bf16_t* const Bp[2] = {P.Bt + (size_t)nb0 * P.K, P.Bt + (size_t)(nb0 + 128) * P.K};
        const f32x4 b0 = *(const f32x4*)(P.bias + nb0 + 4 * fq), b1 = *(const f32x4*)(P.bias + nb0 + 128 + 4 * fq);
        const CtxSS ssv[2] = {ctx_ss_load(P.sspi, 32 * C.wave + fr, fq), ctx_ss_load(P.sspi, 32 * C.wave + 16 + fr, fq)};
        ctx_mm<2, 16, 1024>(acc, P.A, P.lda, Bp, C.wave, C.lane, C.tid, C.lds);
        const CtxCW<3> cwv = ctx_cw_load<3>(P.cw, DFF, P.cb, c0 + 8 * hh);
#pragma unroll
        for (int g = 0; g < 2; ++g) { const int t = 32 * C.wave + 16 * g + fr; const float rs = ctx_rstd_fin(ssv[g], fr, fq);
            *(LAS f32x4*)(t0 + t * 16 + 4 * fq) = acc[g][0] * rs + b0; *(LAS f32x4*)(t1 + t * 16 + 4 * fq) = acc[g][1] * rs + b1; }
        __syncthreads();
        float o[8]; ctx_conv_rows<3, 1>(o, t0, tt, hh, cwv);
        const f32x4 v0 = *(const LAS f32x4*)(t1 + tt * 16 + 8 * hh), v1 = *(const LAS f32x4*)(t1 + tt * 16 + 8 * hh + 4);
        u32x4 w; w.x = cvt_pk_bf16(silu_f(o[0]) * v0[0], silu_f(o[1]) * v0[1]); w.y = cvt_pk_bf16(silu_f(o[2]) * v0[2], silu_f(o[3]) * v0[3]);
        w.z = cvt_pk_bf16(silu_f(o[4]) * v1[0], silu_f(o[5]) * v1[1]); w.w = cvt_pk_bf16(silu_f(o[6]) * v1[2], silu_f(o[7]) * v1[3]);
        *(u32x4*)(P.o1 + (size_t)tt * DFF + c0 + 8 * hh) = w;
        __syncthreads();
    } else {
        f32x4 acc[2][3]; const int q = c0 >> 7, cl = c0 & 127, nb1 = 1024 + q * 256 + cl;
        const bf16_t* const Bp[3] = {P.Bt + (size_t)c0 * P.K, P.Bt + (size_t)nb1 * P.K, P.Bt + (size_t)(nb1 + 128) * P.K};
        const f32x4 b0 = *(const f32x4*)(P.bias + c0 + 4 * fq), b1 = *(const f32x4*)(P.bias + nb1 + 4 * fq), b2 = *(const f32x4*)(P.bias + nb1 + 128 + 4 * fq);
        const CtxSS ssv[2] = {ctx_ss_load(P.sspi, 32 * C.wave + fr, fq), ctx_ss_load(P.sspi, 32 * C.wave + 16 + fr, fq)};
        ctx_mm<3, 16, 1024>(acc, P.A, P.lda, Bp, C.wave, C.lane, C.tid, C.lds);
        const CtxCW<3> cwv = ctx_cw_load<3>(P.cw, D, P.cb, c0 + 8 * hh);
#pragma unroll
        for (int g = 0; g < 2; ++g) { const int t = 32 * C.wave + 16 * g + fr; const float rs = ctx_rstd_fin(ssv[g], fr, fq);
            *(LAS f32x4*)(t0 + t * 16 + 4 * fq) = (acc[g][1] * rs + b1) * (acc[g][2] * rs + b2); *(LAS f32x4*)(t1 + t * 16 + 4 * fq) = acc[g][0] * rs + b0; }
        __syncthreads();
        float o[8]; ctx_conv_rows<3, 1>(o, t0, tt, hh, cwv);
        const f32x4 v0 = *(const LAS f32x4*)(t1 + tt * 16 + 8 * hh), v1 = *(const LAS f32x4*)(t1 + tt * 16 + 8 * hh + 4);
        u32x4 w; w.x = cvt_pk_bf16(o[0] * v0[0], o[1] * v0[1]); w.y = cvt_pk_bf16(o[2] * v0[2], o[3] * v0[3]); w.z = cvt_pk_bf16(o[4] * v1[0], o[5] * v1[1]); w.w = cvt_pk_bf16(o[6] * v1[2], o[7] * v1[3]);
        *(u32x4*)(P.o1 + (size_t)tt * D + c0 + 8 * hh) = w;
        __syncthreads();
    }
}
__device__ __forceinline__ int ctx_step(const Ctx& C, int ph, CtxP& P) {
    const float* mods = WSP(float, WS_MODS);
#define CMOD(l, chunk) (mods + (size_t)((l) * 2 + 1) * NMOD + (chunk) * 1024)
#define CXB(i) (WSP(bf16_t, CX_XB) + (size_t)(i) * CT * D)
#define CSSP(i) (WSP(float, CX_SSP) + (size_t)(i) * CT * 64)
    P.kind = 0; P.A = nullptr; P.lda = D; P.K = D; P.Bt = nullptr; P.sspi = nullptr; P.bias = nullptr; P.hin = nullptr; P.hout = nullptr; P.xbo = nullptr; P.gate = nullptr; P.ng = nullptr; P.sc = nullptr; P.sspo = nullptr;
    P.o1 = nullptr; P.o2 = nullptr; P.cw = nullptr; P.cb = nullptr; P.br = nullptr; P.bi = nullptr; P.la8 = nullptr; P.h0 = nullptr;
    int sid; switch (ph) { case 2: sid = 2; break; case 3: sid = 3; break; case 4: sid = 4; break; case 5: sid = 5; break; case 8: sid = 6; break; case 9: sid = 7; break; case 10: sid = 8; break;
                           case 11: sid = 9; break; case 13: sid = 10; break; case 14: sid = 11; break; case 15: sid = 12; break; default: sid = 0; }
    switch (sid) {
    case 2: case 11: { const int j = sid == 2 ? 0 : 1, l = 2 * j, xi = sid == 2 ? 0 : 4;
        P.kind = 1; P.A = CXB(xi); P.lda = D; P.K = D; P.Bt = WSP(bf16_t, W_A1 + j * SZ_A1); P.sspi = CSSP(xi); P.bias = WSP(float, WS_BIASM) + (size_t)(l * 2 + 1) * 3072;
        P.o1 = WSP(bf16_t, CX_U) + (size_t)j * CT * D; P.o2 = WSP(bf16_t, CX_G); P.cw = INP(IX_ACW) + (size_t)j * 4 * D; P.cb = INP(IX_ACB) + (size_t)j * D; return 64; }
    case 3: case 12: { const int j = sid == 3 ? 0 : 1;
        P.kind = 2; P.A = WSP(bf16_t, CX_U) + (size_t)j * CT * D; P.lda = D; P.K = 256; P.Bt = WSP(bf16_t, W_A2 + j * SZ_A2);
        P.br = INP(IX_ABR) + (size_t)j * 2 * D; P.bi = INP(IX_ABI) + (size_t)j * 2 * D; P.la8 = WSP(float, WS_LA8) + (size_t)j * 2 * D; P.h0 = WSP(float, WS_H0) + (size_t)j * 2 * D;
        P.o1 = j == 0 ? WSP(bf16_t, CX_GS) : nullptr; P.o2 = WSP(bf16_t, CX_G); return 64; }
    case 4: P.kind = 4; P.A = WSP(bf16_t, CX_GS); P.lda = D; P.K = D; P.Bt = WSP(bf16_t, W_A3); P.hin = INP(IX_CTX); P.hout = WSP(float, CX_H); P.xbo = CXB(1); P.gate = CMOD(0, 2); P.ng = INP(IX_NFG); P.sc = CMOD(0, 4); P.sspo = CSSP(1); return 128;
    case 5: case 9: { const int l = sid == 5 ? 0 : 1, xi = sid == 5 ? 1 : 3;
        P.kind = 5; P.A = CXB(xi); P.lda = D; P.K = D; P.Bt = WSP(bf16_t, W_F1 + l * SZ_F1); P.sspi = CSSP(xi); P.bias = WSP(float, WS_BIASF) + (size_t)(l * 2 + 1) * 5632;
        P.o1 = WSP(bf16_t, CX_Y + l * 1536 * KiB); P.cw = INP(IX_FCW) + (size_t)l * 3 * DFF; P.cb = INP(IX_FCB) + (size_t)l * DFF; return 176; }
    case 6: case 10: { const int l = sid == 6 ? 0 : 1, xo = sid == 6 ? 2 : 4;
        P.kind = 4; P.A = WSP(bf16_t, CX_Y + l * 1536 * KiB); P.lda = DFF; P.K = DFF; P.Bt = WSP(bf16_t, W_F2 + l * SZ_F2); P.hin = WSP(float, CX_H); P.hout = WSP(float, CX_H); P.xbo = CXB(xo);
        P.gate = CMOD(l, 5); P.ng = INP(IX_NMG) + (size_t)(l + 1) * D; P.sc = CMOD(l + 1, 1); P.sspo = CSSP(xo); return 128; }
    case 7: P.kind = 7; P.A = CXB(2); P.lda = D; P.K = D; P.Bt = WSP(bf16_t, W_B1); P.sspi = CSSP(2); P.bias = WSP(float, WS_BIASM) + (size_t)(1 * 2 + 1) * 3072;
        P.o1 = WSP(bf16_t, CX_Q); P.cw = INP(IX_BCW); P.cb = INP(IX_BCB); return 64;
    case 8: P.kind = 4; P.A = WSP(bf16_t, CX_Q); P.lda = D; P.K = D; P.Bt = WSP(bf16_t, W_B2); P.hin = WSP(float, CX_H); P.hout = WSP(float, CX_H); P.xbo = CXB(3); P.gate = CMOD(1, 2); P.ng = INP(IX_NFG) + D; P.sc = CMOD(1, 4); P.sspo = CSSP(3); return 128;
    default: return 0;
    }
#undef CMOD
#undef CXB
#undef CSSP
}

__global__ void __launch_bounds__(512, 2) mega_fwd(Args args) {
    extern __shared__ __attribute__((aligned(16))) unsigned char lds_raw[];
    Ctx C;
    C.in = args.in; C.out = args.out; C.ws = args.ws; C.lds = (LAS unsigned char*)lds_raw;
    C.tid = threadIdx.x; C.lane = C.tid & 63; C.wave = __builtin_amdgcn_readfirstlane(C.tid >> 6); C.G = gridDim.x; C.bid = blockIdx.x;
    volatile LAS unsigned* MISC = (volatile LAS unsigned*)(C.lds + MISC_OFF);
    for (int u = C.tid; u < (LDS_BYTES - LDSCTL_OFF) / 4; u += 512) ((LAS unsigned*)(C.lds + LDSCTL_OFF))[u] = 0u;
    __syncthreads();
    XcdBarrier bar; bar.bar = (unsigned*)(C.ws + WS_CTL) + 4096; bar.x = 0; bar.st = nullptr;
#if !MK_PER_PHASE
    bar = xcd_barrier_post((unsigned*)(C.ws + WS_CTL) + 4096, MISC + 8);
#endif
    const int lo = args.ph_lo, hi = args.ph_hi;
#define REFRESH_LANE() do { C.lane = lane_id(); asm volatile("" : "+v"(C.lane)); C.tid = C.wave * 64 + C.lane; } while (0)
#define IN(k) (lo <= (k) && (k) < hi)
#ifndef MK_BAR_REPS
#define MK_BAR_REPS 1
#endif
#define SEAM(k) do { if (IN(k) && IN((k) + 1)) { for (int br_ = 0; br_ < MK_BAR_REPS; ++br_) xcd_barrier(bar); } } while (0)
    const float* mods = WSP(float, WS_MODS);
#define LMOD(l, chunk) (mods + (size_t)((l) * 2) * NMOD + (chunk) * 1024)
#define SLOTP(type, i) WSP(type, WS_SLOT + (size_t)(i) * SLOT)
#define SSPA(i) (WSP(float, WS_SSP) + (size_t)(i) * T * 16)
    int ph = 0;
    if (IN(ph)) { REFRESH_LANE(); phase_p0(C); }
    SEAM(ph); ++ph;
    if (IN(ph)) { REFRESH_LANE(); phase_p1(C); }
    SEAM(ph); ++ph;
    for (ph = 2; ph < 28; ++ph) {
        if (IN(ph)) {
            asm volatile("" : "+s"(C.wave), "+s"(C.bid), "+s"(C.G));
            { size_t zz = 0; asm volatile("" : "+s"(zz)); C.ws = args.ws + zz; C.out = args.out + zz; }
            REFRESH_LANE();
            { CtxP cp; const int nci = ctx_step(C, ph, cp); const int coff = (ph == 8 || ph == 13) ? (C.G >> 1) : 0;
              for (int it = C.bid - coff; it < nci; it += C.G) if (it >= 0) ctx_item(C, cp, it); }
            int p = ph - 2, l = 0;
            if (p >= 13) { p -= 13; l = 2; }
            int kind;
            if (p < 8) kind = p; else { l += 1; p -= 8; kind = p == 0 ? 8 : p == 1 ? 9 : p + 3; }
            const int j = l >> 1;
            if (kind == 0) {
                pg8::Gemm g{SLOTP(bf16_t, 0), WSP(bf16_t, W_A1 + j * SZ_A1), D, D, 64, 8, 0, 0}; pg8::StaticOrder S; S.init(64, 8, C.G, C.bid);
                EpiA1 E{SLOTP(bf16_t, 1), SLOTP(bf16_t, 4), WSP(float, WS_BIASM) + (size_t)(l * 2) * 3072, SSPA(2 * l)};
                pg8::gemm_phase(C.lds, g, S, E, C.wave);
            } else if (kind == 1) {
                REFRESH_LANE();
                phase_conv4(C, SLOTP(bf16_t, 1), SLOTP(bf16_t, 5), INP(IX_ACW) + (size_t)j * 4 * D, INP(IX_ACB) + (size_t)j * D);
            } else if (kind == 2) {
                int kk = 256; asm volatile("" : "+s"(kk));
                pg8::Gemm g{SLOTP(bf16_t, 5), WSP(bf16_t, W_A2 + j * SZ_A2), D, kk, 64, 16, 1, 3}; pg8::StaticOrder S; S.init(64, 16, C.G, C.bid);
                EpiA2 E{SLOTP(bf16_t, 5), SLOTP(h16, 0), INP(IX_ABR) + (size_t)j * 2 * D, INP(IX_ABI) + (size_t)j * 2 * D, WSP(float, WS_LA8) + (size_t)j * 2 * D};
                pg8::gemm_phase<EpiA2, false>(C.lds, g, S, E, C.wave);
            } else if (kind == 3) {
                REFRESH_LANE();
                phase_scan1(C, SLOTP(h16, 0));
            } else if (kind == 4) {
                REFRESH_LANE();
                phase_scan2(C, SLOTP(h16, 0), SLOTP(bf16_t, 4), SLOTP(bf16_t, 5), WSP(float, WS_H0) + (size_t)j * 2 * D);
            } else if (kind == 5) {
                const bf16_t* bt = (l & 1) ? WSP(bf16_t, W_B2 + j * SZ_B2) : WSP(bf16_t, W_A3 + j * SZ_A3);
                pg8::Gemm g{(l & 1) ? SLOTP(bf16_t, 3) : SLOTP(bf16_t, 5), bt, D, D, 64, 4, 0, 0}; pg8::StaticOrder S; S.init(64, 4, C.G, C.bid);
                EpiRes E{WSP(bf16_t, WS_XRES), SLOTP(bf16_t, 0), LMOD(l, 2), INP(IX_NFG) + (size_t)l * D, LMOD(l, 4), SSPA(2 * l + 1)};
                pg8::gemm_phase(C.lds, g, S, E, C.wave);
            } else if (kind == 6) {
                pg8::Gemm g{SLOTP(bf16_t, 0), WSP(bf16_t, W_F1 + l * SZ_F1), D, D, 64, 22, 0, 0}; pg8::StaticOrder S; S.init(64, 22, C.G, C.bid, ph > 13);
                EpiF1 E{SLOTP(bf16_t, 1), WSP(float, WS_BIASF) + (size_t)(l * 2) * 5632, SSPA(2 * l + 1), INP(IX_FCW) + (size_t)l * 3 * DFF, INP(IX_FCB) + (size_t)l * DFF};
                pg8::gemm_phase(C.lds, g, S, E, C.wave);
            } else if (kind == 7) {
                pg8::Gemm g{SLOTP(bf16_t, 1), WSP(bf16_t, W_F2 + l * SZ_F2), DFF, DFF, 64, 4, 0, 0}; pg8::StaticOrder S; S.init(64, 4, C.G, C.bid);
                EpiRes E{WSP(bf16_t, WS_XRES), SLOTP(bf16_t, 0), LMOD(l, 5), l < 3 ? INP(IX_NMG) + (size_t)(l + 1) * D : nullptr, l < 3 ? LMOD(l + 1, 1) : nullptr, SSPA(2 * l + 2)};
                pg8::gemm_phase(C.lds, g, S, E, C.wave);
            } else if (kind == 8) {
                pg8::Gemm g{SLOTP(bf16_t, 0), WSP(bf16_t, W_B1 + j * SZ_B1), D, D, 64, 12, 0, 0}; pg8::StaticOrder S; S.init(64, 12, C.G, C.bid);
                EpiB1 E{SLOTP(bf16_t, 1), SLOTP(bf16_t, 2), WSP(float, WS_BIASM) + (size_t)(l * 2) * 3072, SSPA(2 * l)};
                pg8::gemm_phase(C.lds, g, S, E, C.wave);
            } else {
                REFRESH_LANE();
                phase_vconv(C, SLOTP(bf16_t, 1), SLOTP(bf16_t, 2), SLOTP(bf16_t, 3), INP(IX_BCW) + (size_t)j * 3 * D, INP(IX_BCB) + (size_t)j * D);
            }
        }
        SEAM(ph);
    }
    if (IN(ph)) { REFRESH_LANE(); phase_final(C, SSPA(8)); }
}
constexpr int N_PHASES = 29;

extern "C" void kernel_launch(void* const* d_in, const int* in_sizes, int n_in, void* d_out, int out_size, void* d_ws, size_t ws_size, hipStream_t stream) {
    static int grid = 0;
    if (grid == 0) {
        if (n_in != N_IN || in_sizes[0] != T * D || out_size != T * D || ws_size < WS_END) { fprintf(stderr, "kernel_launch: unexpected problem shape (n_in %d, in0 %d, out %d, ws %zu < %zu)\n", n_in, n_in > 0 ? in_sizes[0] : -1, out_size, ws_size, (size_t)WS_END); grid = -1; return; }
        int dev = 0, cus = 0, per_cu = 0;
        if (hipGetDevice(&dev) != hipSuccess || hipDeviceGetAttribute(&cus, hipDeviceAttributeMultiprocessorCount, dev) != hipSuccess) { grid = -1; return; }
        if (hipFuncSetAttribute((const void*)mega_fwd, hipFuncAttributeMaxDynamicSharedMemorySize, LDS_BYTES) != hipSuccess) { fprintf(stderr, "kernel_launch: hipFuncSetAttribute failed\n"); grid = -1; return; }
        if (hipOccupancyMaxActiveBlocksPerMultiprocessor(&per_cu, (const void*)mega_fwd, 512, LDS_BYTES) != hipSuccess || per_cu < 1) fprintf(stderr, "kernel_launch: occupancy query reports %d\n", per_cu);
        (void)hipGetLastError();
        grid = cus;
    }
    if (grid < 0) return;
    (void)hipMemsetAsync((char*)d_ws + WS_CTL, 0, CTL_ZERO_BYTES, stream);
    Args a{};
    for (int i = 0; i < N_IN; ++i) a.in[i] = (const float*)d_in[i];
    a.out = (float*)d_out; a.ws = (unsigned char*)d_ws;
#if MK_PER_PHASE
    for (int p = 0; p < N_PHASES; ++p) {
        const bool dup = (MK_DUP_MASK >> p) & 1u;
        bool inplace = false;
        if (p >= 2 && p < 28) { int q = p - 2, l = 0; if (q >= 13) { q -= 13; l = 2; } int kind; if (q < 8) kind = q; else { l += 1; q -= 8; kind = q == 0 ? 8 : q == 1 ? 9 : q + 3; } inplace = kind == 5 || kind == 7; }
        const bool cin = (p == 6 || p == 8 || p == 10);
        char* xbk = (char*)d_ws + WS_SLOT + 4 * SLOT; char* cbk = (char*)d_ws + WS_END;
        if (dup && inplace) (void)hipMemcpyAsync(xbk, (char*)d_ws + WS_XRES, (size_t)T * D * 2, hipMemcpyDeviceToDevice, stream);
        if (dup && cin) (void)hipMemcpyAsync(cbk, (char*)d_ws + CX_H, (size_t)CT * D * 4, hipMemcpyDeviceToDevice, stream);
        a.ph_lo = p; a.ph_hi = p + 1; hipLaunchKernelGGL(mega_fwd, dim3(grid), dim3(512), LDS_BYTES, stream, a);
        if (dup) {
            if (inplace) (void)hipMemcpyAsync((char*)d_ws + WS_XRES, xbk, (size_t)T * D * 2, hipMemcpyDeviceToDevice, stream);
            if (cin) (void)hipMemcpyAsync((char*)d_ws + CX_H, cbk, (size_t)CT * D * 4, hipMemcpyDeviceToDevice, stream);
            hipLaunchKernelGGL(mega_fwd, dim3(grid), dim3(512), LDS_BYTES, stream, a);
        }
    }
#else
    a.ph_lo = 0; a.ph_hi = N_PHASES;
    hipLaunchKernelGGL(mega_fwd, dim3(grid), dim3(512), LDS_BYTES, stream, a);
#endif
}
```

```cpp
#include <hip/hip_runtime.h>
#include <cstdio>
#include <cstdint>

#ifndef MK_DUP_MASK
#define MK_DUP_MASK 0u
#endif
#ifndef MK_PER_PHASE
#define MK_PER_PHASE 0
#endif

#define LAS __attribute__((address_space(3)))
typedef unsigned short bf16_t;
typedef short bf16x8 __attribute__((ext_vector_type(8)));
typedef float f32x4 __attribute__((ext_vector_type(4)));
typedef float f32x2 __attribute__((ext_vector_type(2)));
typedef unsigned u32x4 __attribute__((ext_vector_type(4)));
typedef unsigned u32x2 __attribute__((ext_vector_type(2)));
typedef _Float16 h16;
typedef _Float16 h16x2 __attribute__((ext_vector_type(2)));
typedef _Float16 h16x4 __attribute__((ext_vector_type(4)));

constexpr int T = 16384, D = 1024, CT = 256, DFF = 2816, NMOD = 6144;
constexpr float EPS = 1e-6f;

enum { IX_X = 0, IX_C, IX_CTX, IX_CCTX, IX_ADAW, IX_ADAB, IX_NMG, IX_NFG, IX_AWX, IX_AWG, IX_ACW, IX_ACB, IX_AWR, IX_ABR, IX_AWI, IX_ABI, IX_ALAM, IX_AWO,
       IX_BWIN, IX_BCW, IX_BCB, IX_BWO, IX_FWU, IX_FCW, IX_FCB, IX_FWD, IX_FG, N_IN };

constexpr size_t MiB = 1u << 20, KiB = 1u << 10;
constexpr size_t WS_CTL = 0, CTL_ZERO_BYTES = 64 * KiB;
constexpr size_t WS_MODS = 1 * MiB;
constexpr size_t WS_BIASM = 1 * MiB + 256 * KiB;
constexpr size_t WS_BIASF = 1 * MiB + 512 * KiB;
constexpr size_t WS_LA8 = 1 * MiB + 768 * KiB;
constexpr size_t WS_H0 = WS_LA8 + 16 * KiB;
constexpr size_t WS_SSP = 2 * MiB;
constexpr size_t WS_AGGT = 11 * MiB;
constexpr size_t WS_AGG32 = 12 * MiB;
constexpr size_t WS_CTXR = 20 * MiB;
constexpr size_t CX_H = WS_CTXR;
constexpr size_t CX_XB = WS_CTXR + 1 * MiB;
constexpr size_t CX_U = WS_CTXR + 4 * MiB;
constexpr size_t CX_G = WS_CTXR + 5 * MiB;
constexpr size_t CX_GS = CX_G + 512 * KiB;
constexpr size_t CX_Q = WS_CTXR + 6 * MiB;
constexpr size_t CX_Y = CX_Q + 512 * KiB;
constexpr size_t CX_SSP = WS_CTXR + 10 * MiB;
constexpr size_t WS_W = 32 * MiB;
constexpr size_t W_A1 = WS_W, W_A2 = WS_W + 8 * MiB, W_A3 = WS_W + 12 * MiB, W_B1 = WS_W + 16 * MiB, W_B2 = WS_W + 28 * MiB, W_F1 = WS_W + 32 * MiB, W_F2 = WS_W + 76 * MiB;
constexpr size_t SZ_A1 = 4 * MiB, SZ_A2 = 2 * MiB, SZ_A3 = 2 * MiB, SZ_B1 = 6 * MiB, SZ_B2 = 2 * MiB, SZ_F1 = 11 * MiB, SZ_F2 = 5632 * KiB;
constexpr size_t WS_SLOT = 130 * MiB, SLOT = 32 * MiB;
constexpr size_t WS_XRES = WS_SLOT + 6 * SLOT;
constexpr size_t WS_END = WS_XRES + SLOT;
static_assert(W_F2 + 4 * SZ_F2 <= WS_SLOT, "weights fit");

constexpr int RING_BYTES = 131072, LDSCTL_OFF = RING_BYTES, MISC_OFF = LDSCTL_OFF + 320, LDS_BYTES = 147456;

__device__ __forceinline__ float bf2f(unsigned b) { return __uint_as_float(b << 16); }
__device__ __forceinline__ unsigned cvt_pk_bf16(float lo, float hi) { unsigned r; asm volatile("v_cvt_pk_bf16_f32 %0, %1, %2" : "=v"(r) : "v"(lo), "v"(hi)); return r; }
__device__ __forceinline__ float sigm(float x) { return __builtin_amdgcn_rcpf(1.f + __builtin_amdgcn_exp2f(-1.4426950409f * x)); }
__device__ __forceinline__ float silu_f(float x) { return x * sigm(x); }
__device__ __forceinline__ float gelu_t(float x) { const float u = x + 0.044715f * x * x * x; return x * __builtin_amdgcn_rcpf(1.f + __builtin_amdgcn_exp2f(-2.3022081986f * u)); }
__device__ __forceinline__ float one_minus_exp(float x) {
    float p = 1.f / 720.f; p = p * x + 1.f / 120.f; p = p * x + 1.f / 24.f; p = p * x + 1.f / 6.f; p = p * x + 0.5f; p = p * x + 1.f;
    const float small = -(p * x);
    const float big = 1.f - __builtin_amdgcn_exp2f(1.4426950409f * x);
    return x < -0.25f ? big : small;
}
__device__ __forceinline__ int lane_id() { return (int)__builtin_amdgcn_mbcnt_hi(~0u, __builtin_amdgcn_mbcnt_lo(~0u, 0u)); }
#define SWZ_X4 0x101F
#define SWZ_X8 0x201F
#define SWZ_X16 0x401F
__device__ __forceinline__ float add_x16(float v) { return v + __builtin_bit_cast(float, __builtin_amdgcn_ds_swizzle(__builtin_bit_cast(int, v), SWZ_X16)); }
__device__ __forceinline__ float add_x32(float v, int xl) { return v + __builtin_bit_cast(float, __builtin_amdgcn_ds_bpermute(xl, __builtin_bit_cast(int, v))); }
#define XL32(fr, fq) ((((fr) + 16 * (fq)) ^ 32) << 2)
__device__ __forceinline__ float wave_sum(float v) {
    v += __builtin_bit_cast(float, __builtin_amdgcn_update_dpp(0, __builtin_bit_cast(int, v), 0xB1, 0xf, 0xf, false));
    v += __builtin_bit_cast(float, __builtin_amdgcn_update_dpp(0, __builtin_bit_cast(int, v), 0x4E, 0xf, 0xf, false));
    v += __builtin_bit_cast(float, __builtin_amdgcn_ds_swizzle(__builtin_bit_cast(int, v), SWZ_X4));
    v += __builtin_bit_cast(float, __builtin_amdgcn_ds_swizzle(__builtin_bit_cast(int, v), SWZ_X8));
    v = add_x16(v);
    return __builtin_bit_cast(float, __builtin_amdgcn_readlane(__builtin_bit_cast(int, v), 0)) + __builtin_bit_cast(float, __builtin_amdgcn_readlane(__builtin_bit_cast(int, v), 32));
}
__device__ __forceinline__ float dpp_ror1(float x) { return __builtin_bit_cast(float, __builtin_amdgcn_update_dpp(0, __builtin_bit_cast(int, x), 0x121, 0xf, 0xf, false)); }
__device__ __forceinline__ float dpp_ror15(float x) { return __builtin_bit_cast(float, __builtin_amdgcn_update_dpp(0, __builtin_bit_cast(int, x), 0x12F, 0xf, 0xf, false)); }
__device__ __forceinline__ unsigned pk_h2(float a, float b) { h16x2 v = {(h16)a, (h16)b}; return __builtin_bit_cast(unsigned, v); }
__device__ __forceinline__ f32x4 h4_to_f4(u32x2 w) { h16x4 h = __builtin_bit_cast(h16x4, w); return (f32x4){(float)h[0], (float)h[1], (float)h[2], (float)h[3]}; }
__device__ __forceinline__ f32x4 bf4_to_f4(u32x2 w) { return (f32x4){bf2f(w.x & 0xffffu), bf2f(w.x >> 16), bf2f(w.y & 0xffffu), bf2f(w.y >> 16)}; }

namespace pg8 {
constexpr int BM = 256, BK = 64, HALF = 128, HTB = HALF * BK * 2, STAGE_BYTES = 8 * HTB, NXCD = 8, WGM = 4;
__host__ __device__ __forceinline__ int lds_byte(int r, int c) { const int st = (r >> 4) * 2 + (c >> 5), rr = r & 15, cc = c & 31, ob = rr * 64 + cc * 2; return st * 1024 + (ob ^ (((ob >> 9) & 1) << 5)); }
__host__ __device__ __forceinline__ void stage_rc(int b, int& R, int& C) { const int st = b / 1024, sb = b % 1024, swz = sb ^ (((sb >> 9) & 1) << 5); R = (st >> 1) * 16 + swz / 64; C = (st & 1) * 32 + (swz % 64) / 2; }
__host__ __device__ __forceinline__ int perm32(int rho) { const int n = rho >> 4, i = rho & 15; return 8 * (i >> 2) + 4 * n + (i & 3); }
struct Unit { int pm, pn, hrow, nai; };
struct Gemm { const bf16_t* A; const bf16_t* Bt; int lda, K, nM, nN, acs, acm; };
struct StaticOrder {
    int nM, nN, nwg, G, c; bool halves;
    __device__ void init(int nM_, int nN_, int G_, int c_, bool halves_ = false) { nM = nM_; nN = nN_; nwg = nM * nN; G = G_; c = c_; halves = halves_; }
    __device__ bool next(int i, Unit& u) const {
        const int fullr = nwg / G, rem = nwg - fullr * G; const bool split = halves && (rem * 2 == G);
        long L; u.hrow = 0; u.nai = 2;
        if (i < fullr) L = (long)i * G + c;
        else if (i == fullr && split) { L = (long)fullr * G + (c >> 1); u.hrow = (c & 1) * 128; u.nai = 1; }
        else if (i == fullr && c < rem) L = (long)i * G + c;
        else return false;
        int wgid = (int)L; { const int q = nwg / NXCD, r = nwg % NXCD, xcd = wgid % NXCD, off = wgid / NXCD; wgid = (xcd < r ? xcd * (q + 1) : r * (q + 1) + (xcd - r) * q) + off; }
        const int nig = WGM * nN, gid = wgid / nig, fm = gid * WGM, gsz = (nM - fm) < WGM ? (nM - fm) : WGM;
        u.pm = fm + ((wgid % nig) % gsz); u.pn = (wgid % nig) / gsz; return true;
    }
};

template <class Epi, bool PERM = true>
__device__ __forceinline__ void gemm_phase(LAS unsigned char* lds, const Gemm g, const StaticOrder& S, const Epi& E, int wid_) {
    int lane_ = lane_id(); asm volatile("" : "+v"(lane_));
    const int wid = wid_, lane = lane_, tid = wid * 64 + lane, wr = wid >> 2, wc = wid & 3, fr = lane & 15, fq = lane >> 4;
    const int K = g.K, nt = K / BK;
    unsigned voffA[2], voffB[2];
#pragma unroll
    for (int i = 0; i < 2; ++i) { int R, C; stage_rc(tid * 16 + i * 8192, R, C); const int Rb = PERM ? (R & ~31) + perm32(R & 31) : R;
        voffA[i] = (unsigned)(R * g.lda + C) * 2u; voffB[i] = (unsigned)(Rb * K + C) * 2u; }
    const unsigned kstep = (unsigned)(BK * 2);
    const unsigned hstepA = (unsigned)HALF * (unsigned)g.lda * 2u, tstepA = 2u * hstepA;
    const unsigned hstepB = (unsigned)HALF * (unsigned)K * 2u, tstepB = 2u * hstepB;
    const unsigned ldsw = (unsigned)wid * 1024u;
    const int aoff = lds_byte(wr * 64 + fr, fq * 8), boff = lds_byte(wc * 32 + fr, fq * 8);
    const __amdgpu_buffer_rsrc_t rsA = __builtin_amdgcn_make_buffer_rsrc((void*)g.A, 0, 0x7fffffff, 0x00020000);
    const __amdgpu_buffer_rsrc_t rsB = __builtin_amdgcn_make_buffer_rsrc((void*)g.Bt, 0, 0x7fffffff, 0x00020000);
#define PG8_UA(u) ((unsigned)(u).pm * tstepA + ((u).hrow ? hstepA : 0u) + (unsigned)((((u).pn >> g.acs) & g.acm) * 512))
#define PG8_UB(u) ((unsigned)(u).pn * tstepB)
#define PG8_SA(b, h) (((b) * 2 + (h)) * HTB)
#define PG8_SB(b, h) ((4 + (b) * 2 + (h)) * HTB)
#define PG8_STAGE(bufoff, rs, soff, voff) do { _Pragma("unroll") for (int _i = 0; _i < 2; ++_i) \
        __builtin_amdgcn_raw_ptr_buffer_load_lds(rs, (LAS void*)(lds + (bufoff) + ldsw + _i * 8192), 16, (int)(voff)[_i], (int)(soff), 0, 0); } while (0)
#define PG8_LDA(dst, b, h) do { _Pragma("unroll") for (int m = 0; m < 4; ++m) _Pragma("unroll") for (int k = 0; k < 2; ++k) dst[m][k] = *(const LAS bf16x8*)(lds + PG8_SA(b, h) + aoff + m * 2048 + k * 1024); } while (0)
#define PG8_LDB(dst, b, h) do { _Pragma("unroll") for (int n = 0; n < 2; ++n) _Pragma("unroll") for (int k = 0; k < 2; ++k) dst[n][k] = *(const LAS bf16x8*)(lds + PG8_SB(b, h) + boff + n * 2048 + k * 1024); } while (0)
#define PG8_MMA(ai, bj, At, Bt) do { __builtin_amdgcn_s_setprio(1); _Pragma("unroll") for (int m = 0; m < 4; ++m) _Pragma("unroll") for (int n = 0; n < 2; ++n) _Pragma("unroll") for (int k = 0; k < 2; ++k) \
        acc[ai][bj][m][n] = __builtin_amdgcn_mfma_f32_16x16x32_bf16(Bt[n][k], At[m][k], acc[ai][bj][m][n], 0, 0, 0); __builtin_amdgcn_s_setprio(0); } while (0)
#define PG8_WAIT_V(n) asm volatile("s_waitcnt vmcnt(" #n ")" ::: "memory")
#define PG8_WAIT_L(n) asm volatile("s_waitcnt lgkmcnt(" #n ")" ::: "memory")
#define PG8_BAR __builtin_amdgcn_s_barrier()
#define PG8_SCHED __builtin_amdgcn_sched_barrier(0)
    Unit cur, nxt; int ui = 0;
    if (!S.next(0, cur)) return;
    f32x4 acc[2][2][4][2];
#pragma unroll
    for (int a = 0; a < 2; ++a)
#pragma unroll
        for (int b = 0; b < 2; ++b)
#pragma unroll
            for (int m = 0; m < 4; ++m)
#pragma unroll
                for (int n = 0; n < 2; ++n) acc[a][b][m][n] = (f32x4){0.f, 0.f, 0.f, 0.f};
    bf16x8 At[4][2], B0[2][2], B1[2][2];
    unsigned cA = PG8_UA(cur), cB = PG8_UB(cur);
    PG8_STAGE(PG8_SB(0, 0), rsB, cB, voffB); PG8_STAGE(PG8_SB(0, 1), rsB, cB + hstepB, voffB); PG8_STAGE(PG8_SA(0, 0), rsA, cA, voffA); PG8_STAGE(PG8_SA(0, 1), rsA, cA + hstepA, voffA);
    if (wr == 1) PG8_BAR;
    PG8_WAIT_V(2); PG8_BAR;
    PG8_STAGE(PG8_SB(1, 0), rsB, cB + kstep, voffB); PG8_STAGE(PG8_SA(1, 0), rsA, cA + kstep, voffA); PG8_STAGE(PG8_SB(1, 1), rsB, cB + hstepB + kstep, voffB);
    PG8_WAIT_V(6); PG8_BAR;
    for (;;) {
        const bool has_next = S.next(ui + 1, nxt);
        const unsigned nA = has_next ? PG8_UA(nxt) : cA, nB = has_next ? PG8_UB(nxt) : cB;
        for (int t = 0; t < nt; t += 2) {
            const bool last = (t == nt - 2);
            const unsigned a1 = cA + (unsigned)(t + 1) * kstep;
            const unsigned a2 = last ? nA : cA + (unsigned)(t + 2) * kstep, b2 = last ? nB : cB + (unsigned)(t + 2) * kstep;
            const unsigned a3 = a2 + kstep, b3 = b2 + kstep;
            PG8_LDB(B0, 0, 0); PG8_LDB(B1, 0, 1); PG8_SCHED; PG8_LDA(At, 0, 0); PG8_STAGE(PG8_SA(1, 1), rsA, a1 + hstepA, voffA);
            PG8_WAIT_V(8); PG8_WAIT_L(0); PG8_BAR; PG8_MMA(0, 0, At, B0); PG8_MMA(0, 1, At, B1); PG8_BAR; PG8_SCHED;
            PG8_LDA(At, 0, 1); PG8_STAGE(PG8_SB(0, 0), rsB, b2, voffB); PG8_STAGE(PG8_SB(0, 1), rsB, b2 + hstepB, voffB); PG8_STAGE(PG8_SA(0, 0), rsA, a2, voffA);
            PG8_WAIT_V(8); PG8_WAIT_L(0); PG8_BAR; if (cur.nai == 2) { PG8_MMA(1, 0, At, B0); PG8_MMA(1, 1, At, B1); } PG8_BAR; PG8_SCHED;
            PG8_LDB(B0, 1, 0); PG8_LDB(B1, 1, 1); PG8_SCHED; PG8_LDA(At, 1, 0); PG8_STAGE(PG8_SA(0, 1), rsA, a2 + hstepA, voffA);
            PG8_WAIT_V(8); PG8_WAIT_L(0); PG8_BAR; PG8_MMA(0, 0, At, B0); PG8_MMA(0, 1, At, B1); PG8_BAR; PG8_SCHED;
            PG8_LDA(At, 1, 1); PG8_STAGE(PG8_SB(1, 0), rsB, b3, voffB); PG8_STAGE(PG8_SB(1, 1), rsB, b3 + hstepB, voffB); PG8_STAGE(PG8_SA(1, 0), rsA, a3, voffA);
            PG8_WAIT_V(8); PG8_WAIT_L(0); PG8_BAR; if (cur.nai == 2) { PG8_MMA(1, 0, At, B0); PG8_MMA(1, 1, At, B1); } PG8_BAR; PG8_SCHED;
        }
        if (wr == 0) PG8_BAR;
        { int lnE = lane_id(); asm volatile("" : "+v"(lnE)); int frE = lnE & 15, fqE = lnE >> 4, wrE = wr, wcE = wc; asm volatile("" : "+s"(wrE), "+s"(wcE));
          E(acc, cur, wrE, wcE, frE, fqE); }
        if (!has_next) break;
#pragma unroll
        for (int a = 0; a < 2; ++a)
#pragma unroll
            for (int b = 0; b < 2; ++b)
#pragma unroll
                for (int m = 0; m < 4; ++m)
#pragma unroll
                    for (int n = 0; n < 2; ++n) acc[a][b][m][n] = (f32x4){0.f, 0.f, 0.f, 0.f};
        cur = nxt; cA = nA; cB = nB; ++ui;
        if (wr == 1) PG8_BAR;
    }
    PG8_WAIT_V(0);
    PG8_BAR;
#undef PG8_UA
#undef PG8_UB
#undef PG8_SA
#undef PG8_SB
#undef PG8_STAGE
#undef PG8_LDA
#undef PG8_LDB
#undef PG8_MMA
#undef PG8_WAIT_V
#undef PG8_WAIT_L
#undef PG8_BAR
#undef PG8_SCHED
}
}

typedef f32x4 Acc[2][2][4][2];

__device__ __forceinline__ void load_rstd(float (&rs)[2][4], const float* ssp, int row0, int fr, int fq) {
#pragma unroll
    for (int ai = 0; ai < 2; ++ai)
#pragma unroll
        for (int m = 0; m < 4; ++m) {
            const f32x4 p = *(const f32x4*)(ssp + (size_t)(row0 + ai * 128 + m * 16) * 16 + fq * 4);
            float s = (p.x + p.y) + (p.z + p.w);
            s = add_x16(s); s = add_x32(s, XL32(fr, fq));
            rs[ai][m] = __builtin_amdgcn_rsqf(s * (1.0f / D) + EPS);
        }
}

struct EpiA1 {
    bf16_t* UPRE; bf16_t* G; const float* bias; const float* ssp;
    __device__ __forceinline__ void operator()(const Acc& acc, const pg8::Unit& u, int wr, int wc, int fr, int fq) const {
        const int row0 = u.pm * 256 + wr * 64 + fr;
        float rs[2][4]; load_rstd(rs, ssp, row0, fr, fq);
        const bool isg = u.pn >= 4; bf16_t* out = isg ? G : UPRE;
        const int oc0 = (u.pn & 3) * 256 + wc * 32 + 8 * fq, bc0 = u.pn * 256 + wc * 32 + 8 * fq;
        f32x4 bv[2][2];
#pragma unroll
        for (int bj = 0; bj < 2; ++bj)
#pragma unroll
            for (int n = 0; n < 2; ++n) bv[bj][n] = *(const f32x4*)(bias + bc0 + bj * 128 + 4 * n);
#pragma unroll
        for (int ai = 0; ai < 2; ++ai)
#pragma unroll
            for (int m = 0; m < 4; ++m) { bf16_t* rowp = out + (size_t)(row0 + ai * 128 + m * 16) * D + oc0; const float r = rs[ai][m];
#pragma unroll
                for (int bj = 0; bj < 2; ++bj) { f32x4 v0 = acc[ai][bj][m][0] * r + bv[bj][0], v1 = acc[ai][bj][m][1] * r + bv[bj][1];
                    if (isg) { v0 = (f32x4){gelu_t(v0[0]), gelu_t(v0[1]), gelu_t(v0[2]), gelu_t(v0[3])}; v1 = (f32x4){gelu_t(v1[0]), gelu_t(v1[1]), gelu_t(v1[2]), gelu_t(v1[3])}; }
                    u32x4 w; w.x = cvt_pk_bf16(v0[0], v0[1]); w.y = cvt_pk_bf16(v0[2], v0[3]); w.z = cvt_pk_bf16(v1[0], v1[1]); w.w = cvt_pk_bf16(v1[2], v1[3]);
                    *(u32x4*)(rowp + bj * 128) = w; } }
    }
};

struct EpiA2 {
    const bf16_t* U; h16* EB; const float* br; const float* bi; const float* la8;
    __device__ __forceinline__ void operator()(const Acc& acc, const pg8::Unit& u, int wr, int wc, int fr, int fq) const {
        const int row0 = u.pm * 256 + wr * 64 + fr, d = u.pn >> 3, q = u.pn & 7, c0 = q * 128 + wc * 32 + 4 * fq;
        h16* Ed = EB + (size_t)d * T * D * 2;
        u32x2 uw[2][4][2];
#pragma unroll
        for (int ai = 0; ai < 2; ++ai)
#pragma unroll
            for (int m = 0; m < 4; ++m)
#pragma unroll
                for (int n = 0; n < 2; ++n) uw[ai][m][n] = *(const u32x2*)(U + (size_t)(row0 + ai * 128 + m * 16) * D + c0 + 16 * n);
        f32x4 brv2[2], biv2[2], lav2[2];
#pragma unroll
        for (int n = 0; n < 2; ++n) { brv2[n] = *(const f32x4*)(br + d * D + c0 + 16 * n); biv2[n] = *(const f32x4*)(bi + d * D + c0 + 16 * n); lav2[n] = *(const f32x4*)(la8 + d * D + c0 + 16 * n); }
#pragma unroll
        for (int ai = 0; ai < 2; ++ai)
#pragma unroll
            for (int m = 0; m < 4; ++m)
#pragma unroll
                for (int n = 0; n < 2; ++n) { const size_t off = (size_t)(row0 + ai * 128 + m * 16) * D + c0 + 16 * n;
                    const f32x4 uu = bf4_to_f4(uw[ai][m][n]); const f32x4 brv = brv2[n], biv = biv2[n], lav = lav2[n];
                    unsigned w[4];
#pragma unroll
                    for (int j = 0; j < 4; ++j) { const float r = sigm(acc[ai][0][m][n][j] + brv[j]), ig = sigm(acc[ai][1][m][n][j] + biv[j]);
                        const float a = __builtin_amdgcn_exp2f(r * lav[j]), e = 1.0f - a; w[j] = pk_h2(e, __builtin_amdgcn_sqrtf(e * (1.0f + a)) * ig * uu[j]); }
                    *(u32x4*)(Ed + off * 2) = (u32x4){w[0], w[1], w[2], w[3]}; }
    }
};

struct EpiRes {
    bf16_t* xres; bf16_t* xb; const float* gate; const float* ng; const float* sc; float* sspo;
    __device__ __forceinline__ void operator()(const Acc& acc, const pg8::Unit& u, int wr, int wc, int fr, int fq) const {
        const int row0 = u.pm * 256 + wr * 64 + fr, c0 = u.pn * 256 + wc * 32 + 8 * fq;
        f32x4 gv[2][2], gs[2][2];
#pragma unroll
        for (int bj = 0; bj < 2; ++bj)
#pragma unroll
            for (int n = 0; n < 2; ++n) { gv[bj][n] = *(const f32x4*)(gate + c0 + bj * 128 + 4 * n);
                if (ng) { const f32x4 a = *(const f32x4*)(ng + c0 + bj * 128 + 4 * n), b = *(const f32x4*)(sc + c0 + bj * 128 + 4 * n); gs[bj][n] = a * (b + 1.0f); } else gs[bj][n] = (f32x4){0.f, 0.f, 0.f, 0.f}; }
#pragma unroll
        for (int ai = 0; ai < 2; ++ai) {
            u32x4 xo[1][4][2];
#pragma unroll
            for (int m = 0; m < 4; ++m)
#pragma unroll
                for (int bj = 0; bj < 2; ++bj) xo[0][m][bj] = *(const u32x4*)(xres + (size_t)(row0 + ai * 128 + m * 16) * D + c0 + bj * 128);
#pragma unroll
            for (int m = 0; m < 4; ++m) { const int row = row0 + ai * 128 + m * 16; const size_t off = (size_t)row * D + c0; float ss = 0.f;
#pragma unroll
                for (int bj = 0; bj < 2; ++bj) { const u32x4 w0 = xo[0][m][bj];
                    const f32x4 o0 = (f32x4){bf2f(w0.x & 0xffffu), bf2f(w0.x >> 16), bf2f(w0.y & 0xffffu), bf2f(w0.y >> 16)}, o1 = (f32x4){bf2f(w0.z & 0xffffu), bf2f(w0.z >> 16), bf2f(w0.w & 0xffffu), bf2f(w0.w >> 16)};
                    const f32x4 x0 = o0 + gv[bj][0] * acc[ai][bj][m][0], x1 = o1 + gv[bj][1] * acc[ai][bj][m][1];
                    u32x4 wx; wx.x = cvt_pk_bf16(x0[0], x0[1]); wx.y = cvt_pk_bf16(x0[2], x0[3]); wx.z = cvt_pk_bf16(x1[0], x1[1]); wx.w = cvt_pk_bf16(x1[2], x1[3]);
                    *(u32x4*)(xres + off + bj * 128) = wx;
                    ss += (x0[0] * x0[0] + x0[1] * x0[1]) + (x0[2] * x0[2] + x0[3] * x0[3]) + (x1[0] * x1[0] + x1[1] * x1[1]) + (x1[2] * x1[2] + x1[3] * x1[3]);
                    if (ng) { const f32x4 y0 = x0 * gs[bj][0], y1 = x1 * gs[bj][1]; u32x4 w; w.x = cvt_pk_bf16(y0[0], y0[1]); w.y = cvt_pk_bf16(y0[2], y0[3]); w.z = cvt_pk_bf16(y1[0], y1[1]); w.w = cvt_pk_bf16(y1[2], y1[3]);
                        *(u32x4*)(xb + off + bj * 128) = w; } }
                ss = add_x16(ss); ss = add_x32(ss, XL32(fr, fq));
                if (fq == 0) sspo[(size_t)row * 16 + u.pn * 4 + wc] = ss; }
        }
    }
};

struct EpiB1 {
    bf16_t* GB; bf16_t* Z; const float* bias; const float* ssp;
    __device__ __forceinline__ void operator()(const Acc& acc, const pg8::Unit& u, int wr, int wc, int fr, int fq) const {
        const int row0 = u.pm * 256 + wr * 64 + fr;
        float rs[2][4]; load_rstd(rs, ssp, row0, fr, fq);
        const int bc0 = u.pn * 256 + wc * 32 + 8 * fq;
        f32x4 bv[2][2];
#pragma unroll
        for (int bj = 0; bj < 2; ++bj)
#pragma unroll
            for (int n = 0; n < 2; ++n) bv[bj][n] = *(const f32x4*)(bias + bc0 + bj * 128 + 4 * n);
        if (u.pn < 4) {
#pragma unroll
            for (int ai = 0; ai < 2; ++ai)
#pragma unroll
                for (int m = 0; m < 4; ++m) { bf16_t* rowp = GB + (size_t)(row0 + ai * 128 + m * 16) * D + bc0; const float r = rs[ai][m];
#pragma unroll
                    for (int bj = 0; bj < 2; ++bj) { const f32x4 v0 = acc[ai][bj][m][0] * r + bv[bj][0], v1 = acc[ai][bj][m][1] * r + bv[bj][1];
                        u32x4 w; w.x = cvt_pk_bf16(v0[0], v0[1]); w.y = cvt_pk_bf16(v0[2], v0[3]); w.z = cvt_pk_bf16(v1[0], v1[1]); w.w = cvt_pk_bf16(v1[2], v1[3]);
                        *(u32x4*)(rowp + bj * 128) = w; } }
        } else {
            const int c0 = (u.pn - 4) * 128 + wc * 32 + 8 * fq;
#pragma unroll
            for (int ai = 0; ai < 2; ++ai)
#pragma unroll
                for (int m = 0; m < 4; ++m) { const float r = rs[ai][m];
                    const f32x4 z0 = (acc[ai][0][m][0] * r + bv[0][0]) * (acc[ai][1][m][0] * r + bv[1][0]), z1 = (acc[ai][0][m][1] * r + bv[0][1]) * (acc[ai][1][m][1] * r + bv[1][1]);
                    u32x4 w; w.x = cvt_pk_bf16(z0[0], z0[1]); w.y = cvt_pk_bf16(z0[2], z0[3]); w.z = cvt_pk_bf16(z1[0], z1[1]); w.w = cvt_pk_bf16(z1[2], z1[3]);
                    *(u32x4*)(Z + (size_t)(row0 + ai * 128 + m * 16) * D + c0) = w; }
        }
    }
};

struct EpiF1 {
    bf16_t* Y; const float* bias; const float* ssp; const float* cw; const float* cb;
    __device__ __forceinline__ void operator()(const Acc& acc, const pg8::Unit& u, int wr, int wc, int fr, int fq) const {
        const int row0 = u.pm * 256 + u.hrow + wr * 64 + fr;
        const int bc0 = u.pn * 256 + wc * 32 + 8 * fq, c0 = u.pn * 128 + wc * 32 + 8 * fq;
        f32x4 bg[2], bvv[2], w0[2], w1[2], w2[2], cbv[2];
#pragma unroll
        for (int n = 0; n < 2; ++n) { bg[n] = *(const f32x4*)(bias + bc0 + 4 * n); bvv[n] = *(const f32x4*)(bias + bc0 + 128 + 4 * n);
            w0[n] = *(const f32x4*)(cw + c0 + 4 * n); w1[n] = *(const f32x4*)(cw + DFF + c0 + 4 * n); w2[n] = *(const f32x4*)(cw + 2 * DFF + c0 + 4 * n); cbv[n] = *(const f32x4*)(cb + c0 + 4 * n); }
        float rs[2][4]; load_rstd(rs, ssp, row0, fr, fq);
        const bool first = (fr == 0), lastl = (fr == 15);
#pragma unroll
        for (int ai = 0; ai < 2; ++ai) {
            if (ai >= u.nai) break;
            unsigned pk0[4][2];
#pragma unroll
            for (int n = 0; n < 2; ++n) {
                f32x4 gq[4];
#pragma unroll
                for (int m = 0; m < 4; ++m) gq[m] = acc[ai][0][m][n] * rs[ai][m] + bg[n];
#pragma unroll
                for (int m = 0; m < 4; ++m) {
#define ROR1V(v) ((f32x4){dpp_ror1((v)[0]), dpp_ror1((v)[1]), dpp_ror1((v)[2]), dpp_ror1((v)[3])})
#define ROR15V(v) ((f32x4){dpp_ror15((v)[0]), dpp_ror15((v)[1]), dpp_ror15((v)[2]), dpp_ror15((v)[3])})
                    const f32x4 ls = ROR1V(gq[m]), rsm = ROR15V(gq[m]);
                    f32x4 lf, rt;
                    if (m == 0) lf = first ? (f32x4){0.f, 0.f, 0.f, 0.f} : ls; else { const f32x4 lp = ROR1V(gq[m > 0 ? m - 1 : 0]); lf = first ? lp : ls; }
                    if (m == 3) rt = lastl ? (f32x4){0.f, 0.f, 0.f, 0.f} : rsm; else { const f32x4 rn = ROR15V(gq[m < 3 ? m + 1 : 3]); rt = lastl ? rn : rsm; }
                    const f32x4 gc = cbv[n] + w0[n] * lf + w1[n] * gq[m] + w2[n] * rt;
                    const f32x4 vv = acc[ai][1][m][n] * rs[ai][m] + bvv[n];
                    const f32x4 y = (f32x4){silu_f(gc[0]) * vv[0], silu_f(gc[1]) * vv[1], silu_f(gc[2]) * vv[2], silu_f(gc[3]) * vv[3]};
                    const unsigned p0 = cvt_pk_bf16(y[0], y[1]), p1 = cvt_pk_bf16(y[2], y[3]);
                    if (n == 0) { pk0[m][0] = p0; pk0[m][1] = p1; }
                    else *(u32x4*)(Y + (size_t)(row0 + ai * 128 + m * 16) * DFF + c0) = (u32x4){pk0[m][0], pk0[m][1], p0, p1}; }
            }
        }
    }
};

#define XB_TMO      128
#define XB_XCNT(j)  (256  + 64 * (j))
#define XB_XSUB(j)  (1280 + 64 * (j))
#define XB_XGEN(j)  (2304 + 64 * (j))
#define XB_TOP      3328
#define XB_TOPGEN   3392
#define XCD_BAR_WORDS 3456
#define XB_SPIN_CAP (1u << 18)
__device__ __forceinline__ unsigned xb_ld(unsigned* p)              { return __hip_atomic_load(p, __ATOMIC_RELAXED, __HIP_MEMORY_SCOPE_AGENT); }
__device__ __forceinline__ unsigned xb_add(unsigned* p, unsigned v) { return __hip_atomic_fetch_add(p, v, __ATOMIC_RELAXED, __HIP_MEMORY_SCOPE_AGENT); }
__device__ __forceinline__ unsigned xb_xcc_id() { return (unsigned)__builtin_amdgcn_s_getreg((3 << 11) | 20) & 0xFu; }
#define XB_SPIN(cond, bar) do { unsigned _sp = 0; while (cond) { __builtin_amdgcn_s_sleep(1); \
    if ((++_sp & 255u) == 0u) { if (xb_ld(&(bar)[XB_TMO])) break; if (_sp > XB_SPIN_CAP) { atomicAdd(&(bar)[XB_TMO], 1u); break; } } } } while (0)
struct XcdBarrier { unsigned* bar; unsigned x; volatile LAS unsigned* st; };
__device__ __forceinline__ XcdBarrier xcd_barrier_post(unsigned* bar, volatile LAS unsigned* st) {
    XcdBarrier b; b.bar = bar; b.x = xb_xcc_id(); b.st = st;
    if (threadIdx.x == 0) (void)xb_add(&bar[XB_XCNT(b.x)], 1u);
    return b;
}
__device__ __forceinline__ void xcd_barrier_complete(unsigned* bar, unsigned x, unsigned& nloc, unsigned& nx) {
    const unsigned G = gridDim.x * gridDim.y * gridDim.z;
    unsigned sum, cnt, mine, sp = 0u;
    for (;;) {
        sum = 0u; cnt = 0u; mine = 0u;
#pragma unroll
        for (unsigned j = 0; j < 16; ++j) { const unsigned c = xb_ld(&bar[XB_XCNT(j)]); sum += c; cnt += (c > 0u) ? 1u : 0u; mine = (j == x) ? c : mine; }
        if (sum == G) break;
        __builtin_amdgcn_s_sleep(1);
        if ((++sp & 255u) == 0u) { if (xb_ld(&bar[XB_TMO])) break; if (sp > XB_SPIN_CAP) { atomicAdd(&bar[XB_TMO], 1u); break; } }
    }
    nloc = mine > 0u ? mine : 1u; nx = cnt > 0u ? cnt : 1u;
}
__device__ __forceinline__ void xcd_barrier(const XcdBarrier& b) {
    asm volatile("s_waitcnt vmcnt(0)" ::: "memory");
    __syncthreads();
    if (threadIdx.x == 0) {
        unsigned* bar = b.bar;
        __builtin_amdgcn_s_waitcnt(0);
        unsigned nloc = b.st[0], nx = b.st[1];
        if (nloc == 0u) { xcd_barrier_complete(bar, b.x, nloc, nx); b.st[0] = nloc; b.st[1] = nx; }
        const unsigned old = xb_add(&bar[XB_XSUB(b.x)], 1u);
        const unsigned gen = old / nloc;
        if (old + 1u == (gen + 1u) * nloc) {
            __builtin_amdgcn_fence(__ATOMIC_RELEASE, "agent");
            asm volatile("s_waitcnt vmcnt(0)" ::: "memory");
            const unsigned og = xb_add(&bar[XB_TOP], 1u);
            const unsigned tg = og / nx;
            if (og + 1u == (tg + 1u) * nx) xb_add(&bar[XB_TOPGEN], 1u);
            else XB_SPIN(xb_ld(&bar[XB_TOPGEN]) == tg, bar);
            __builtin_amdgcn_fence(__ATOMIC_ACQUIRE, "agent");
            xb_add(&bar[XB_XGEN(b.x)], 1u);
            asm volatile("s_waitcnt vmcnt(0)" ::: "memory");
        } else {
            XB_SPIN(xb_ld(&bar[XB_XGEN(b.x)]) == gen, bar);
            __builtin_amdgcn_fence(__ATOMIC_ACQUIRE, "agent");
            asm volatile("s_waitcnt vmcnt(0)" ::: "memory");
        }
    }
    __syncthreads();
}

struct Args { const float* in[N_IN]; float* out; unsigned char* ws; int ph_lo, ph_hi; };
struct Ctx {
    const float* const* in; float* out; unsigned char* ws; LAS unsigned char* lds;
    int tid, lane, wave, G, bid;
};
#define WSP(type, off) ((type*)(C.ws + (off)))
#define INP(i) (C.in[i])
#define LDS_WAIT() asm volatile("s_waitcnt lgkmcnt(0)" ::: "memory")

__device__ __forceinline__ void p0_adaln(const Ctx& C, int item) {
    LAS float* sv = (LAS float*)C.lds;
    LAS float* red = (LAS float*)(C.lds + 8192);
    const int l = item / 48, cbk = item % 48;
    for (int i = C.tid; i < 2048; i += 512) { const float v = i < 1024 ? INP(IX_C)[i] : INP(IX_CCTX)[i - 1024]; sv[i] = silu_f(v); }
    __syncthreads();
    const float* W = INP(IX_ADAW) + (size_t)l * D * NMOD + cbk * 128 + 2 * C.lane;
    const int k0 = C.wave * 128;
    f32x2 a0 = {0.f, 0.f}, a1 = {0.f, 0.f};
#pragma unroll 16
    for (int k = 0; k < 128; ++k) { const f32x2 w = *(const f32x2*)(W + (size_t)(k0 + k) * NMOD); const float s0 = sv[k0 + k], s1 = sv[1024 + k0 + k]; a0 += w * s0; a1 += w * s1; }
    red[(C.wave * 2 + 0) * 128 + 2 * C.lane] = a0.x; red[(C.wave * 2 + 0) * 128 + 2 * C.lane + 1] = a0.y;
    red[(C.wave * 2 + 1) * 128 + 2 * C.lane] = a1.x; red[(C.wave * 2 + 1) * 128 + 2 * C.lane + 1] = a1.y;
    __syncthreads();
    if (C.tid < 256) { const int s = C.tid >> 7, c = C.tid & 127; float v = INP(IX_ADAB)[l * NMOD + cbk * 128 + c];
#pragma unroll
        for (int w = 0; w < 8; ++w) v += red[(w * 2 + s) * 128 + c];
        WSP(float, WS_MODS)[(size_t)(l * 2 + s) * NMOD + cbk * 128 + c] = v; }
    __syncthreads();
}
struct WBlk { const float* src; int ld, c0, K; bf16_t* dst; };
__device__ __forceinline__ WBlk get_wblk(const Ctx& C, int cls, int vb) {
    WBlk w;
    if (cls == 0) {
        w.K = 1024;
        if (vb < 48) { const int j = vb / 24, r = vb % 24;
            if (r < 16) { w.src = (r < 8 ? INP(IX_AWX) : INP(IX_AWG)) + (size_t)j * D * D; w.ld = D; w.c0 = (r & 7) * 128; w.dst = WSP(bf16_t, W_A1 + j * SZ_A1) + (size_t)r * 128 * 1024; }
            else { const int rr = r - 16; w.src = INP(IX_AWO) + (size_t)j * D * D; w.ld = D; w.c0 = rr * 128; w.dst = WSP(bf16_t, W_A3 + j * SZ_A3) + (size_t)rr * 128 * 1024; }
        } else if (vb < 112) { const int bb = vb - 48, j = bb / 32, r = bb % 32;
            if (r < 24) { int c0; if (r < 8) c0 = r * 128; else { const int rr = r - 8; c0 = 1024 + (rr & 1) * 1024 + (rr >> 1) * 128; }
                w.src = INP(IX_BWIN) + (size_t)j * D * 3072; w.ld = 3072; w.c0 = c0; w.dst = WSP(bf16_t, W_B1 + j * SZ_B1) + (size_t)r * 128 * 1024; }
            else { const int rr = r - 24; w.src = INP(IX_BWO) + (size_t)j * D * D; w.ld = D; w.c0 = rr * 128; w.dst = WSP(bf16_t, W_B2 + j * SZ_B2) + (size_t)rr * 128 * 1024; }
        } else { const int bb = vb - 112, l = bb / 44, r = bb % 44;
            w.src = INP(IX_FWU) + (size_t)l * D * 2 * DFF; w.ld = 2 * DFF; w.c0 = (r & 1) * DFF + (r >> 1) * 128; w.dst = WSP(bf16_t, W_F1 + l * SZ_F1) + (size_t)r * 128 * 1024; }
    } else if (cls == 1) {
        const int j = vb / 32, rr = vb % 32, pn = rr >> 1, mem = rr & 1, d = pn >> 3, q = pn & 7, h = q >> 1, half = q & 1;
        w.K = 256; w.src = (mem ? INP(IX_AWI) : INP(IX_AWR)) + (size_t)(((j * 2 + d) * 4 + h)) * 65536; w.ld = 256; w.c0 = half * 128;
        w.dst = WSP(bf16_t, W_A2 + j * SZ_A2) + (size_t)(pn * 256 + mem * 128) * 256;
    } else {
        const int l = vb / 8, rr = vb % 8;
        w.K = DFF; w.src = INP(IX_FWD) + (size_t)l * DFF * D; w.ld = D; w.c0 = rr * 128; w.dst = WSP(bf16_t, W_F2 + l * SZ_F2) + (size_t)rr * 128 * DFF;
    }
    return w;
}
__device__ __forceinline__ void p0_transpose(const WBlk& w, int rg, int kb, LAS float* scr, int lane) {
    const int k0 = 64 * kb, n0 = 32 * rg;
    { const int r8 = lane >> 3, c4 = lane & 7; f32x4 v[8];
#pragma unroll
        for (int i = 0; i < 8; ++i) v[i] = *(const f32x4*)(w.src + (size_t)(k0 + 8 * i + r8) * w.ld + w.c0 + n0 + 4 * c4);
#pragma unroll
        for (int i = 0; i < 8; ++i) { LAS float* d = scr + (8 * i + r8) * 33 + 4 * c4; d[0] = v[i].x; d[1] = v[i].y; d[2] = v[i].z; d[3] = v[i].w; } }
    LDS_WAIT(); asm volatile("" ::: "memory");
    const int c = lane & 7;
#pragma unroll
    for (int j = 0; j < 4; ++j) { const int n = (lane >> 3) + 8 * j; const LAS float* s = scr + (8 * c) * 33 + n;
        u32x4 o; o.x = cvt_pk_bf16(s[0 * 33], s[1 * 33]); o.y = cvt_pk_bf16(s[2 * 33], s[3 * 33]); o.z = cvt_pk_bf16(s[4 * 33], s[5 * 33]); o.w = cvt_pk_bf16(s[6 * 33], s[7 * 33]);
        *(u32x4*)(w.dst + (size_t)(n0 + n) * w.K + k0 + 8 * c) = o; }
    LDS_WAIT(); asm volatile("" ::: "memory");
}
__device__ __forceinline__ void phase_p0(const Ctx& C) {
    for (int it = C.bid; it < 192; it += C.G) p0_adaln(C, it);
    LAS float* scr = (LAS float*)(C.lds + C.wave * 16384);
    const int gw = C.bid * 8 + C.wave, NGW = C.G * 8;
    constexpr int N0 = 288 * 16, N1 = 64 * 4, N2 = 32 * 44;
    for (int it = gw; it < N0 + N1 + N2; it += NGW) {
        int cls, vb, rg, kc;
        if (it < N0) { cls = 0; vb = it >> 4; rg = (it >> 2) & 3; kc = it & 3; }
        else if (it < N0 + N1) { const int r = it - N0; cls = 1; vb = r >> 2; rg = r & 3; kc = 0; }
        else { const int r = it - N0 - N1; cls = 2; vb = r / 44; const int rem = r % 44; rg = rem / 11; kc = rem % 11; }
        const WBlk w = get_wblk(C, cls, vb);
        for (int kb = 4 * kc; kb < 4 * kc + 4; ++kb) p0_transpose(w, rg, kb, scr, C.lane);
    }
}

__device__ __forceinline__ size_t cf_off(int t, int c, int K) { return ((size_t)((t >> 4) * (K >> 5) + (c >> 5)) << 9) + (size_t)((((c >> 3) & 3) << 4) + (t & 15)) * 8 + (c & 7); }
__device__ __forceinline__ void p1_rows4(const float* __restrict__ xbase, bf16_t* __restrict__ obase, bf16_t* __restrict__ rbase, float* __restrict__ ssbase, int nss, const f32x4 (&gs)[4], int r0, int lane, bool frag) {
    f32x4 v[4][4];
#pragma unroll
    for (int q = 0; q < 4; ++q)
#pragma unroll
        for (int j = 0; j < 4; ++j) v[q][j] = ((const f32x4*)(xbase + (size_t)(r0 + q) * D) + lane)[64 * j];
#pragma unroll
    for (int q = 0; q < 4; ++q) { float s = 0.f;
#pragma unroll
        for (int j = 0; j < 4; ++j) s += (v[q][j].x * v[q][j].x + v[q][j].y * v[q][j].y) + (v[q][j].z * v[q][j].z + v[q][j].w * v[q][j].w);
        s = wave_sum(s);
        if (lane < nss) ssbase[(size_t)(r0 + q) * nss + lane] = lane == 0 ? s : 0.f;
#pragma unroll
        for (int j = 0; j < 4; ++j) { const f32x4 y = v[q][j] * gs[j]; u32x2 w; w.x = cvt_pk_bf16(y.x, y.y); w.y = cvt_pk_bf16(y.z, y.w); *(u32x2*)(obase + (frag ? cf_off(r0 + q, 4 * lane + 256 * j, D) : (size_t)(r0 + q) * D + 4 * lane + 256 * j)) = w;
            if (rbase) { u32x2 r; r.x = cvt_pk_bf16(v[q][j].x, v[q][j].y); r.y = cvt_pk_bf16(v[q][j].z, v[q][j].w); ((u32x2*)(rbase + (size_t)(r0 + q) * D) + lane)[64 * j] = r; } } }
}
__device__ __forceinline__ void phase_p1(const Ctx& C) {
    const int gw = C.bid * 8 + C.wave, NGW = C.G * 8;
    const float* __restrict__ mods = WSP(float, WS_MODS);
    for (int s = 0; s < 2; ++s) {
        f32x4 gs[4];
#pragma unroll
        for (int j = 0; j < 4; ++j) gs[j] = *((const f32x4*)INP(IX_NMG) + C.lane + 64 * j) * (*((const f32x4*)(mods + (size_t)s * NMOD + 1024) + C.lane + 64 * j) + 1.0f);
        const int nrow = s ? CT : T;
        for (int r0 = gw * 4; r0 < nrow; r0 += NGW * 4)
            p1_rows4(s ? INP(IX_CTX) : INP(IX_X), s ? WSP(bf16_t, CX_XB) : WSP(bf16_t, WS_SLOT), s ? nullptr : WSP(bf16_t, WS_XRES), s ? WSP(float, CX_SSP) : WSP(float, WS_SSP), s ? 64 : 16, gs, r0, C.lane, s != 0);
    }
    for (int rb = gw; rb < 2048; rb += NGW) {
        const int r = rb * 16; const bf16_t* __restrict__ bt; int l, shoff; float* __restrict__ outp; int ostride;
        if (r < 4096) { const int j = r / 2048, n = r % 2048; bt = WSP(bf16_t, W_A1 + j * SZ_A1) + (size_t)n * 1024; l = 2 * j; shoff = 0; outp = WSP(float, WS_BIASM) + (size_t)(l * 2) * 3072 + n; ostride = 3072; }
        else if (r < 10240) { const int rr = r - 4096, j = rr / 3072, n = rr % 3072; bt = WSP(bf16_t, W_B1 + j * SZ_B1) + (size_t)n * 1024; l = 2 * j + 1; shoff = 0; outp = WSP(float, WS_BIASM) + (size_t)(l * 2) * 3072 + n; ostride = 3072; }
        else { const int rr = r - 10240; l = rr / 5632; const int n = rr % 5632; bt = WSP(bf16_t, W_F1 + l * SZ_F1) + (size_t)n * 1024; shoff = 3072; outp = WSP(float, WS_BIASF) + (size_t)(l * 2) * 5632 + n; ostride = 5632; }
        f32x4 sh[2][2][2];
#pragma unroll
        for (int st = 0; st < 2; ++st)
#pragma unroll
            for (int h = 0; h < 2; ++h) { const float* p = mods + (size_t)(l * 2 + st) * NMOD + shoff + h * 512 + 8 * C.lane; sh[st][h][0] = *(const f32x4*)p; sh[st][h][1] = *(const f32x4*)(p + 4); }
#pragma unroll 1
        for (int b4 = 0; b4 < 4; ++b4) {
            u32x4 wv[4][2];
#pragma unroll
            for (int q = 0; q < 4; ++q)
#pragma unroll
                for (int h = 0; h < 2; ++h) wv[q][h] = *(const u32x4*)(bt + (size_t)(b4 * 4 + q) * 1024 + h * 512 + 8 * C.lane);
#pragma unroll
            for (int q = 0; q < 4; ++q) { float a0 = 0.f, a1 = 0.f;
#pragma unroll
                for (int h = 0; h < 2; ++h) { const u32x4 w = wv[q][h];
                    const f32x4 lo = (f32x4){bf2f(w.x & 0xffffu), bf2f(w.x >> 16), bf2f(w.y & 0xffffu), bf2f(w.y >> 16)}, hi = (f32x4){bf2f(w.z & 0xffffu), bf2f(w.z >> 16), bf2f(w.w & 0xffffu), bf2f(w.w >> 16)};
                    const f32x4 p0 = lo * sh[0][h][0] + hi * sh[0][h][1], p1 = lo * sh[1][h][0] + hi * sh[1][h][1];
                    a0 += (p0.x + p0.y) + (p0.z + p0.w); a1 += (p1.x + p1.y) + (p1.z + p1.w); }
                a0 = wave_sum(a0); a1 = wave_sum(a1);
                if (C.lane == 0) { outp[b4 * 4 + q] = a0; outp[ostride + b4 * 4 + q] = a1; } }
        }
    }
    for (int i = C.bid * 512 + C.tid; i < 4096; i += C.G * 512) { const float x = INP(IX_ALAM)[i]; const float ls = fminf(x, 0.f) - log1pf(expf(-fabsf(x))); WSP(float, WS_LA8)[i] = 8.0f * 1.4426950409f * ls; }
}

__device__ __forceinline__ void phase_conv4(const Ctx& C, const bf16_t* __restrict__ UPRE, bf16_t* __restrict__ U, const float* __restrict__ cw, const float* __restrict__ cb) {
    const int cg = C.tid & 127, sub = C.tid >> 7, c0 = cg * 8;
    float w[4][8], b[8];
#pragma unroll
    for (int k = 0; k < 4; ++k)
#pragma unroll
        for (int e = 0; e < 8; ++e) w[k][e] = cw[k * D + c0 + e];
#pragma unroll
    for (int e = 0; e < 8; ++e) b[e] = cb[c0 + e];
    for (int it = C.bid; it < T / 64; it += C.G) {
        const int t0 = it * 64 + sub * 16;
        float win[3][8];
#pragma unroll
        for (int r = 0; r < 3; ++r) { const int t = t0 - 2 + r; u32x4 v = *(const u32x4*)(UPRE + (size_t)(t >= 0 ? t : 0) * D + c0); if (t < 0) v = (u32x4){0u, 0u, 0u, 0u};
            win[r][0] = bf2f(v.x & 0xffffu); win[r][1] = bf2f(v.x >> 16); win[r][2] = bf2f(v.y & 0xffffu); win[r][3] = bf2f(v.y >> 16); win[r][4] = bf2f(v.z & 0xffffu); win[r][5] = bf2f(v.z >> 16); win[r][6] = bf2f(v.w & 0xffffu); win[r][7] = bf2f(v.w >> 16); }
#pragma unroll
        for (int i = 0; i < 16; ++i) { const int t = t0 + i; u32x4 v = *(const u32x4*)(UPRE + (size_t)(t + 1 < T ? t + 1 : T - 1) * D + c0); if (t + 1 >= T) v = (u32x4){0u, 0u, 0u, 0u};
            const float nx[8] = {bf2f(v.x & 0xffffu), bf2f(v.x >> 16), bf2f(v.y & 0xffffu), bf2f(v.y >> 16), bf2f(v.z & 0xffffu), bf2f(v.z >> 16), bf2f(v.w & 0xffffu), bf2f(v.w >> 16)};
            float o[8];
#pragma unroll
            for (int e = 0; e < 8; ++e) { o[e] = b[e] + w[0][e] * win[0][e] + w[1][e] * win[1][e] + w[2][e] * win[2][e] + w[3][e] * nx[e]; win[0][e] = win[1][e]; win[1][e] = win[2][e]; win[2][e] = nx[e]; }
            u32x4 ow; ow.x = cvt_pk_bf16(o[0], o[1]); ow.y = cvt_pk_bf16(o[2], o[3]); ow.z = cvt_pk_bf16(o[4], o[5]); ow.w = cvt_pk_bf16(o[6], o[7]);
            *(u32x4*)(U + (size_t)t * D + c0) = ow; }
    }
}
__device__ __forceinline__ void phase_vconv(const Ctx& C, const bf16_t* __restrict__ GB, const bf16_t* __restrict__ Z, bf16_t* __restrict__ Q, const float* __restrict__ cw, const float* __restrict__ cb) {
    const int cg = C.tid & 127, sub = C.tid >> 7, c0 = cg * 8;
    float w[3][8], b[8];
#pragma unroll
    for (int k = 0; k < 3; ++k)
#pragma unroll
        for (int e = 0; e < 8; ++e) w[k][e] = cw[k * D + c0 + e];
#pragma unroll
    for (int e = 0; e < 8; ++e) b[e] = cb[c0 + e];
    const int vb = (C.G & 7) == 0 ? (C.bid & 7) * (C.G >> 3) + (C.bid >> 3) : C.bid;
    for (int it = vb; it < T / 64; it += C.G) {
        const int t0 = it * 64 + sub * 16;
        const bool lo_ok = it > 0, hi_ok = it < T / 64 - 1;
        const long om = lo_ok ? -(long)64 * D : 0, op = hi_ok ? (long)64 * D : 0; const float ml = lo_ok ? 1.f : 0.f, mh = hi_ok ? 1.f : 0.f;
#pragma unroll 8
        for (int i = 0; i < 16; ++i) { const int t = t0 + i; const size_t off = (size_t)t * D + c0;
            const u32x4 g = *(const u32x4*)(GB + off), z1 = *(const u32x4*)(Z + off);
            const u32x4 z0 = *(const u32x4*)(Z + (long)off + om), z2 = *(const u32x4*)(Z + (long)off + op);
            const unsigned gw[4] = {g.x, g.y, g.z, g.w}, a0[4] = {z0.x, z0.y, z0.z, z0.w}, a1[4] = {z1.x, z1.y, z1.z, z1.w}, a2[4] = {z2.x, z2.y, z2.z, z2.w};
            unsigned ow[4];
#pragma unroll
            for (int p = 0; p < 4; ++p) {
                const float lo = bf2f(gw[p] & 0xffffu) * (b[2 * p] + ml * w[0][2 * p] * bf2f(a0[p] & 0xffffu) + w[1][2 * p] * bf2f(a1[p] & 0xffffu) + mh * w[2][2 * p] * bf2f(a2[p] & 0xffffu));
                const float hi = bf2f(gw[p] >> 16) * (b[2 * p + 1] + ml * w[0][2 * p + 1] * bf2f(a0[p] >> 16) + w[1][2 * p + 1] * bf2f(a1[p] >> 16) + mh * w[2][2 * p + 1] * bf2f(a2[p] >> 16));
                ow[p] = cvt_pk_bf16(lo, hi); }
            *(u32x4*)(Q + off) = (u32x4){ow[0], ow[1], ow[2], ow[3]}; }
    }
}

typedef _Float16 h16x8 __attribute__((ext_vector_type(8)));
__device__ __forceinline__ void eb_unpack(u32x4 w, f32x4& a, f32x4& b) {
    const h16x8 h = __builtin_bit_cast(h16x8, w);
    a = (f32x4){1.0f - (float)h[0], 1.0f - (float)h[2], 1.0f - (float)h[4], 1.0f - (float)h[6]}; b = (f32x4){(float)h[1], (float)h[3], (float)h[5], (float)h[7]};
}
__device__ __forceinline__ void phase_scan1(const Ctx& C, const h16* __restrict__ EB) {
    LAS float* lagg = (LAS float*)C.lds;
    for (int task = C.bid; task < 256; task += C.G) {
        const int j = task >> 2, cbk = task & 3, ch = cbk * 256 + 4 * C.lane, r0 = j * 256 + 32 * C.wave;
#pragma unroll
        for (int d = 0; d < 2; ++d) {
            const h16* e = EB + (((size_t)d * T + r0) * D + ch) * 2;
            f32x4 P = {1.f, 1.f, 1.f, 1.f}, Q = {0.f, 0.f, 0.f, 0.f};
            u32x4 ev[32];
#pragma unroll
            for (int i = 0; i < 32; ++i) ev[i] = *(const u32x4*)(e + (size_t)i * D * 2);
#pragma unroll
            for (int i = 0; i < 32; ++i) { const int ii = d ? 31 - i : i; f32x4 a, bb; eb_unpack(ev[ii], a, bb); P = P * a; Q = a * Q + bb; }
            float* ag = WSP(float, WS_AGG32) + (((size_t)d * 512 + j * 8 + C.wave) * D + ch) * 2;
            *(f32x4*)ag = (f32x4){P[0], Q[0], P[1], Q[1]}; *(f32x4*)(ag + 4) = (f32x4){P[2], Q[2], P[3], Q[3]};
            LAS float* la = lagg + ((d * 8 + C.wave) * 256 + 4 * C.lane) * 2;
            *(LAS f32x4*)la = (f32x4){P[0], Q[0], P[1], Q[1]}; *(LAS f32x4*)(la + 4) = (f32x4){P[2], Q[2], P[3], Q[3]};
        }
        __syncthreads();
        { const int d = C.tid >> 8, c = C.tid & 255; float P = 1.f, Q = 0.f;
#pragma unroll
            for (int i = 0; i < 8; ++i) { const int w = d ? 7 - i : i; const f32x2 pq = *(const LAS f32x2*)(lagg + ((d * 8 + w) * 256 + c) * 2); Q = pq.x * Q + pq.y; P *= pq.x; }
            *(f32x2*)(WSP(float, WS_AGGT) + (((size_t)d * 64 + j) * D + cbk * 256 + c) * 2) = (f32x2){P, Q}; }
        __syncthreads();
    }
}
__device__ __forceinline__ void phase_scan2(const Ctx& C, const h16* __restrict__ EB, const bf16_t* __restrict__ Gt, bf16_t* __restrict__ GS, const float* __restrict__ h0) {
    LAS float* cin = (LAS float*)(C.lds + RING_BYTES + 1024);
    LAS unsigned char* hbw = C.lds + C.wave * 16384 + 8 * C.lane;
    for (int task = C.bid; task < 256; task += C.G) {
        const int j = task >> 2, cbk = task & 3;
        const int ch = cbk * 256 + 4 * C.lane, r0 = j * 256 + 32 * C.wave;
        u32x4 ev[32];
        { const h16* e = EB + (((size_t)T + r0) * D + ch) * 2;
#pragma unroll
            for (int i = 0; i < 32; ++i) ev[i] = *(const u32x4*)(e + (size_t)i * D * 2); }
        { int tid_ = C.tid; asm volatile("" : "+v"(tid_));
            const int d = tid_ >> 8, c = tid_ & 255, chn = cbk * 256 + c; float h = h0[d * D + chn];
            const int n = d ? 63 - j : j; const float* base = WSP(float, WS_AGGT) + ((size_t)d * 64 * D + chn) * 2;
            for (int i = 0; i < n; i += 16) { f32x2 pq[16];
#pragma unroll
                for (int u = 0; u < 16; ++u) { const int ii = i + u; const int im = ii < n ? ii : n - 1; const int jj = d ? 63 - im : im; pq[u] = *(const f32x2*)(base + (size_t)jj * D * 2); if (ii >= n) pq[u] = (f32x2){1.f, 0.f}; }
#pragma unroll
                for (int u = 0; u < 16; ++u) h = pq[u].x * h + pq[u].y; }
            cin[d * 256 + c] = h; }
        __syncthreads();
        f32x4 hc[2];
#pragma unroll
        for (int d = 0; d < 2; ++d) { f32x4 h = *(const LAS f32x4*)(cin + d * 256 + 4 * C.lane); const int n = d ? 7 - C.wave : C.wave;
            f32x4 pq[7][2];
#pragma unroll
            for (int u = 0; u < 7; ++u) { const int im = u < n ? u : (n > 0 ? n - 1 : 0); const int w = d ? 7 - im : im; const float* ag = WSP(float, WS_AGG32) + (((size_t)d * 512 + j * 8 + w) * D + ch) * 2; pq[u][0] = *(const f32x4*)ag; pq[u][1] = *(const f32x4*)(ag + 4); }
#pragma unroll
            for (int u = 0; u < 7; ++u) if (u < n) { h[0] = pq[u][0][0] * h[0] + pq[u][0][1]; h[1] = pq[u][0][2] * h[1] + pq[u][0][3]; h[2] = pq[u][1][0] * h[2] + pq[u][1][1]; h[3] = pq[u][1][2] * h[3] + pq[u][1][3]; }
            hc[d] = h; }
        { f32x4 h = hc[1];
#pragma unroll
            for (int i = 31; i >= 0; --i) { f32x4 a, bb; eb_unpack(ev[i], a, bb); h = a * h + bb;
                u32x2 w; w.x = cvt_pk_bf16(h[0], h[1]); w.y = cvt_pk_bf16(h[2], h[3]); *(LAS u32x2*)(hbw + i * 512) = w; } }
        { f32x4 h = hc[0]; const h16* e = EB + ((size_t)r0 * D + ch) * 2;
#pragma unroll
            for (int hb2 = 0; hb2 < 2; ++hb2) { u32x2 gv[16];
#pragma unroll
                for (int i = 0; i < 16; ++i) { ev[i] = *(const u32x4*)(e + (size_t)(16 * hb2 + i) * D * 2); gv[i] = *(const u32x2*)(Gt + (size_t)(r0 + 16 * hb2 + i) * D + ch); }
#pragma unroll
                for (int i = 0; i < 16; ++i) { f32x4 a, bb; eb_unpack(ev[i], a, bb); h = a * h + bb;
                    const f32x4 hb = bf4_to_f4(*(const LAS u32x2*)(hbw + (16 * hb2 + i) * 512)); const f32x4 o = bf4_to_f4(gv[i]) * (h + hb);
                    u32x2 w; w.x = cvt_pk_bf16(o[0], o[1]); w.y = cvt_pk_bf16(o[2], o[3]); *(u32x2*)(GS + (size_t)(r0 + 16 * hb2 + i) * D + ch) = w; } } }
        __syncthreads();
    }
}
__device__ __forceinline__ void phase_final(const Ctx& C, const float* __restrict__ ssp) {
    const int gw = C.bid * 8 + C.wave, NGW = C.G * 8;
    const bf16_t* __restrict__ xres = WSP(bf16_t, WS_XRES); float* __restrict__ out = C.out; const float* __restrict__ fg = INP(IX_FG);
    f32x4 g[4];
#pragma unroll
    for (int j = 0; j < 4; ++j) g[j] = *((const f32x4*)fg + C.lane + 64 * j);
    for (int r0 = gw * 4; r0 < T; r0 += NGW * 4) {
        u32x2 xv[4][4]; float sv[4];
#pragma unroll
        for (int q = 0; q < 4; ++q) { { const float v_ = ssp[(size_t)(r0 + q) * 16 + (C.lane & 15)]; sv[q] = C.lane < 16 ? v_ : 0.f; }
#pragma unroll
            for (int j = 0; j < 4; ++j) xv[q][j] = ((const u32x2*)(xres + (size_t)(r0 + q) * D) + C.lane)[64 * j]; }
#pragma unroll
        for (int q = 0; q < 4; ++q) { const float rstd = 1.0f / sqrtf(wave_sum(sv[q]) * (1.0f / D) + EPS); f32x4* orow = (f32x4*)(out + (size_t)(r0 + q) * D) + C.lane;
#pragma unroll
            for (int j = 0; j < 4; ++j) orow[64 * j] = bf4_to_f4(xv[q][j]) * rstd * g[j]; }
    }
}
template <int NB, int UNR, int K>
__device__ __forceinline__ void ctx_mm(f32x4 (&acc)[2][NB], const bf16_t* A, int lda, const bf16_t* const (&Bp)[NB], int wave, int lane, int tid, LAS unsigned char* lds) {
    const int fr = lane & 15, fq = lane >> 4;
    constexpr int ROWB = K * 2 + 16, PPT = K / 256;
    {   u32x4 stg[NB][PPT];
#pragma unroll
        for (int nb = 0; nb < NB; ++nb)
#pragma unroll
            for (int q = 0; q < PPT; ++q) { const int p = tid + 512 * q, r = p / (K / 8), kc = p % (K / 8); stg[nb][q] = *(const u32x4*)(Bp[nb] + (size_t)r * K + kc * 8); }
#pragma unroll
        for (int nb = 0; nb < NB; ++nb)
#pragma unroll
            for (int q = 0; q < PPT; ++q) { const int p = tid + 512 * q, r = p / (K / 8), kc = p % (K / 8); *(LAS u32x4*)(lds + (nb * 16 + r) * ROWB + kc * 16) = stg[nb][q]; } }
    const bf16_t* a0 = A + (size_t)(2 * wave) * lda * 16 + lane * 8; const bf16_t* a1 = a0 + (size_t)lda * 16;
#pragma unroll
    for (int nb = 0; nb < NB; ++nb) { acc[0][nb] = (f32x4){0.f, 0.f, 0.f, 0.f}; acc[1][nb] = (f32x4){0.f, 0.f, 0.f, 0.f}; }
    __syncthreads();
    const LAS unsigned char* bl = lds + fr * ROWB + fq * 16;
#pragma unroll 1
    for (int k0 = 0; k0 < K; k0 += 32 * UNR) {
        bf16x8 af[UNR][2];
#pragma unroll
        for (int u = 0; u < UNR; ++u) { af[u][0] = *(const bf16x8*)(a0 + (k0 + 32 * u) * 16); af[u][1] = *(const bf16x8*)(a1 + (k0 + 32 * u) * 16); }
        __builtin_amdgcn_sched_barrier(0);
#pragma unroll
        for (int u = 0; u < UNR; ++u)
#pragma unroll
            for (int nb = 0; nb < NB; ++nb) { const bf16x8 bf = *(const LAS bf16x8*)(bl + nb * 16 * ROWB + (k0 + 32 * u) * 2);
                acc[0][nb] = __builtin_amdgcn_mfma_f32_16x16x32_bf16(bf, af[u][0], acc[0][nb], 0, 0, 0); acc[1][nb] = __builtin_amdgcn_mfma_f32_16x16x32_bf16(bf, af[u][1], acc[1][nb], 0, 0, 0); }
        __builtin_amdgcn_sched_barrier(0);
    }
    __syncthreads();
}
template <int UNR, int K>
__device__ __forceinline__ void ctx_mm1(f32x4& acc, const bf16_t* A, int lda, const bf16_t* Bp, int row0, int lane, int tid, LAS unsigned char* lds) {
    const int fr = lane & 15, fq = lane >> 4;
    constexpr int ROWB = K * 2 + 16, PPT = K / 256;
    {   u32x4 stg[PPT];
#pragma unroll
        for (int q = 0; q < PPT; ++q) { const int p = tid + 512 * q, r = p / (K / 8), kc = p % (K / 8); stg[q] = *(const u32x4*)(Bp + (size_t)r * K + kc * 8); }
#pragma unroll
        for (int q = 0; q < PPT; ++q) { const int p = tid + 512 * q, r = p / (K / 8), kc = p % (K / 8); *(LAS u32x4*)(lds + r * ROWB + kc * 16) = stg[q]; } }
    const bf16_t* a0 = A + (size_t)(row0 >> 4) * lda * 16 + lane * 8;
    acc = (f32x4){0.f, 0.f, 0.f, 0.f};
    __syncthreads();
    const LAS unsigned char* bl = lds + fr * ROWB + fq * 16;
#pragma unroll 1
    for (int k0 = 0; k0 < K; k0 += 32 * UNR) {
        bf16x8 af[UNR];
#pragma unroll
        for (int u = 0; u < UNR; ++u) af[u] = *(const bf16x8*)(a0 + (k0 + 32 * u) * 16);
        __builtin_amdgcn_sched_barrier(0);
#pragma unroll
        for (int u = 0; u < UNR; ++u) { const bf16x8 bf = *(const LAS bf16x8*)(bl + (k0 + 32 * u) * 2); acc = __builtin_amdgcn_mfma_f32_16x16x32_bf16(bf, af[u], acc, 0, 0, 0); }
        __builtin_amdgcn_sched_barrier(0);
    }
    __syncthreads();
}
struct CtxSS { f32x4 a, b, c, d; };
__device__ __forceinline__ CtxSS ctx_ss_load(const float* sspc, int row, int fq) { const float* p = sspc + (size_t)row * 64 + fq * 16; CtxSS r; r.a = *(const f32x4*)p; r.b = *(const f32x4*)(p + 4); r.c = *(const f32x4*)(p + 8); r.d = *(const f32x4*)(p + 12); return r; }
__device__ __forceinline__ float ctx_rstd_fin(const CtxSS& v, int fr, int fq) {
    float s = ((v.a.x + v.a.y) + (v.a.z + v.a.w)) + ((v.b.x + v.b.y) + (v.b.z + v.b.w)) + ((v.c.x + v.c.y) + (v.c.z + v.c.w)) + ((v.d.x + v.d.y) + (v.d.z + v.d.w));
    s = add_x16(s); s = add_x32(s, XL32(fr, fq));
    return 1.0f / sqrtf(s * (1.0f / D) + EPS);
}
struct CtxP {
    int kind;
    const bf16_t* A; int lda, K; const bf16_t* Bt; const float* sspi; const float* bias;
    const float* hin; float* hout; bf16_t* xbo; const float* gate; const float* ng; const float* sc; float* sspo;
    bf16_t* o1; bf16_t* o2;
    const float* cw; const float* cb; const float* br; const float* bi; const float* la8; float* h0;
};
template <int KW> struct CtxCW { f32x4 w[KW][2]; f32x4 b[2]; };
template <int KW>
__device__ __forceinline__ CtxCW<KW> ctx_cw_load(const float* cw, int cstride, const float* cb, int c) {
    CtxCW<KW> r;
#pragma unroll
    for (int k = 0; k < KW; ++k) { r.w[k][0] = *(const f32x4*)(cw + (size_t)k * cstride + c); r.w[k][1] = *(const f32x4*)(cw + (size_t)k * cstride + c + 4); }
    r.b[0] = *(const f32x4*)(cb + c); r.b[1] = *(const f32x4*)(cb + c + 4);
    return r;
}
template <int KW, int PAD>
__device__ __forceinline__ void ctx_conv_rows(float (&o)[8], const LAS float* tile, int t, int hh, const CtxCW<KW>& cwv) {
    f32x4 o0 = cwv.b[0], o1 = cwv.b[1];
#pragma unroll
    for (int k = 0; k < KW; ++k) { const int tt = t + k - PAD; if (tt >= 0 && tt < CT) {
        const f32x4 a = *(const LAS f32x4*)(tile + tt * 16 + 8 * hh), b = *(const LAS f32x4*)(tile + tt * 16 + 8 * hh + 4);
        o0 += cwv.w[k][0] * a; o1 += cwv.w[k][1] * b; } }
    o[0] = o0[0]; o[1] = o0[1]; o[2] = o0[2]; o[3] = o0[3]; o[4] = o1[0]; o[5] = o1[1]; o[6] = o1[2]; o[7] = o1[3];
}
__device__ __forceinline__ void ctx_item(const Ctx& C0, const CtxP& P, int item) {
    Ctx C = C0; asm volatile("" : "+v"(C.lane)); C.tid = C.wave * 64 + C.lane;
    const int fr = C.lane & 15, fq = C.lane >> 4, c0 = 16 * item;
    LAS float* t0 = (LAS float*)C.lds; LAS float* t1 = t0 + 4096; LAS float* t2 = t1 + 4096; LAS float* t3 = t2 + 4096; LAS float* tagg = t3 + 4096;
    const int tt = C.tid >> 1, hh = C.tid & 1;
    if (P.kind == 1) {
        f32x4 acc[2][2]; const bf16_t* const Bp[2] = {P.Bt + (size_t)c0 * P.K, P.Bt + (size_t)(1024 + c0) * P.K};
        const f32x4 b0 = *(const f32x4*)(P.bias + c0 + 4 * fq), b1 = *(const f32x4*)(P.bias + 1024 + c0 + 4 * fq);
        const CtxSS ssv[2] = {ctx_ss_load(P.sspi, 32 * C.wave + fr, fq), ctx_ss_load(P.sspi, 32 * C.wave + 16 + fr, fq)};
        ctx_mm<2, 16, 1024>(acc, P.A, P.lda, Bp, C.wave, C.lane, C.tid, C.lds);
        const CtxCW<4> cwv = ctx_cw_load<4>(P.cw, D, P.cb, c0 + 8 * hh);
#pragma unroll
        for (int g = 0; g < 2; ++g) { const int t = 32 * C.wave + 16 * g + fr; const float rs = ctx_rstd_fin(ssv[g], fr, fq);
            *(LAS f32x4*)(t0 + t * 16 + 4 * fq) = acc[g][0] * rs + b0;
            const f32x4 gp = acc[g][1] * rs + b1; u32x2 w; w.x = cvt_pk_bf16(gelu_t(gp[0]), gelu_t(gp[1])); w.y = cvt_pk_bf16(gelu_t(gp[2]), gelu_t(gp[3]));
            *(u32x2*)(P.o2 + (size_t)t * D + c0 + 4 * fq) = w; }
        __syncthreads();
        float o[8]; ctx_conv_rows<4, 2>(o, t0, tt, hh, cwv);
        u32x4 w; w.x = cvt_pk_bf16(o[0], o[1]); w.y = cvt_pk_bf16(o[2], o[3]); w.z = cvt_pk_bf16(o[4], o[5]); w.w = cvt_pk_bf16(o[6], o[7]);
        *(u32x4*)(P.o1 + cf_off(tt, c0 + 8 * hh, D)) = w;
        __syncthreads();
    } else if (P.kind == 2) {
        f32x4 acc[2][4]; const int q = c0 >> 7, cl = c0 & 127, h = c0 >> 8;
        const bf16_t* const Bp[4] = {P.Bt + (size_t)((0 * 8 + q) * 256 + cl) * 256, P.Bt + (size_t)((0 * 8 + q) * 256 + 128 + cl) * 256, P.Bt + (size_t)((1 * 8 + q) * 256 + cl) * 256, P.Bt + (size_t)((1 * 8 + q) * 256 + 128 + cl) * 256};
        const u32x2 uw2[2] = {*(const u32x2*)(P.A + cf_off(32 * C.wave + fr, c0 + 4 * fq, D)), *(const u32x2*)(P.A + cf_off(32 * C.wave + 16 + fr, c0 + 4 * fq, D))};
        f32x4 brv2[2], biv2[2], lav2[2];
#pragma unroll
        for (int d = 0; d < 2; ++d) { brv2[d] = *(const f32x4*)(P.br + d * D + c0 + 4 * fq); biv2[d] = *(const f32x4*)(P.bi + d * D + c0 + 4 * fq); lav2[d] = *(const f32x4*)(P.la8 + d * D + c0 + 4 * fq); }
        ctx_mm<4, 8, 256>(acc, P.A + h * 256 * 16, P.lda, Bp, C.wave, C.lane, C.tid, C.lds);
#pragma unroll
        for (int g = 0; g < 2; ++g) { const int t = 32 * C.wave + 16 * g + fr; const f32x4 uu = bf4_to_f4(uw2[g]);
#pragma unroll
            for (int d = 0; d < 2; ++d) { const f32x4 brv = brv2[d], biv = biv2[d], lav = lav2[d];
                f32x4 av, bv;
#pragma unroll
                for (int j = 0; j < 4; ++j) { const float r = sigm(acc[g][2 * d][j] + brv[j]), ig = sigm(acc[g][2 * d + 1][j] + biv[j]); const float a = __builtin_amdgcn_exp2f(r * lav[j]), e = 1.0f - a; av[j] = a; bv[j] = __builtin_amdgcn_sqrtf(e * (1.0f + a)) * ig * uu[j]; }
                *(LAS f32x4*)((d ? t2 : t0) + t * 16 + 4 * fq) = av; *(LAS f32x4*)((d ? t3 : t1) + t * 16 + 4 * fq) = bv; } }
        __syncthreads();
        { const int c = C.tid & 15, d = (C.tid >> 4) & 1, chk = C.tid >> 5; const LAS float* ta = d ? t2 : t0; LAS float* tb = d ? t3 : t1;
            float Pp = 1.f, Qq = 0.f;
#pragma unroll
            for (int i = 0; i < 16; ++i) { const int t = 16 * chk + (d ? 15 - i : i); const float a = ta[t * 16 + c], b = tb[t * 16 + c]; Qq = a * Qq + b; Pp *= a; }
            tagg[((d * 16 + chk) * 16 + c) * 2] = Pp; tagg[((d * 16 + chk) * 16 + c) * 2 + 1] = Qq;
            __syncthreads();
            float hcar = 0.f; const int n = d ? 15 - chk : chk;
            for (int i = 0; i < n; ++i) { const int cc = d ? 15 - i : i; hcar = tagg[((d * 16 + cc) * 16 + c) * 2] * hcar + tagg[((d * 16 + cc) * 16 + c) * 2 + 1]; }
#pragma unroll
            for (int i = 0; i < 16; ++i) { const int t = 16 * chk + (d ? 15 - i : i); hcar = ta[t * 16 + c] * hcar + tb[t * 16 + c]; tb[t * 16 + c] = hcar; }
            if ((d == 0 && chk == 15) || (d == 1 && chk == 0)) P.h0[d * D + c0 + c] = hcar; }
        __syncthreads();
        if (P.o1) { const f32x4 f0 = *(const LAS f32x4*)(t1 + tt * 16 + 8 * hh), f1 = *(const LAS f32x4*)(t1 + tt * 16 + 8 * hh + 4), r0 = *(const LAS f32x4*)(t3 + tt * 16 + 8 * hh), r1 = *(const LAS f32x4*)(t3 + tt * 16 + 8 * hh + 4);
            const u32x4 gw = *(const u32x4*)(P.o2 + (size_t)tt * D + c0 + 8 * hh);
            const f32x4 s0 = f0 + r0, s1 = f1 + r1;
            u32x4 w; w.x = cvt_pk_bf16(bf2f(gw.x & 0xffffu) * s0[0], bf2f(gw.x >> 16) * s0[1]); w.y = cvt_pk_bf16(bf2f(gw.y & 0xffffu) * s0[2], bf2f(gw.y >> 16) * s0[3]);
            w.z = cvt_pk_bf16(bf2f(gw.z & 0xffffu) * s1[0], bf2f(gw.z >> 16) * s1[1]); w.w = cvt_pk_bf16(bf2f(gw.w & 0xffffu) * s1[2], bf2f(gw.w >> 16) * s1[3]);
            *(u32x4*)(P.o1 + cf_off(tt, c0 + 8 * hh, D)) = w; }
        __syncthreads();
    } else if (P.kind == 4) {
        const int cg = item & 63, c4 = 16 * cg, t = 128 * (item >> 6) + 16 * C.wave + fr; const size_t off = (size_t)t * D + c4 + 4 * fq;
        const f32x4 gv = *(const f32x4*)(P.gate + c4 + 4 * fq); const f32x4 gs = *(const f32x4*)(P.ng + c4 + 4 * fq) * (*(const f32x4*)(P.sc + c4 + 4 * fq) + 1.0f);
        const f32x4 hold = *(const f32x4*)(P.hin + off);
        f32x4 acc;
        if (P.K == D) ctx_mm1<32, 1024>(acc, P.A, P.lda, P.Bt + (size_t)c4 * 1024, 128 * (item >> 6) + 16 * C.wave, C.lane, C.tid, C.lds);
        else ctx_mm1<22, 2816>(acc, P.A, P.lda, P.Bt + (size_t)c4 * 2816, 128 * (item >> 6) + 16 * C.wave, C.lane, C.tid, C.lds);
        const f32x4 hn = hold + gv * acc;
        *(f32x4*)(P.hout + off) = hn;
        float ss = (hn[0] * hn[0] + hn[1] * hn[1]) + (hn[2] * hn[2] + hn[3] * hn[3]); ss = add_x16(ss); ss = add_x32(ss, XL32(fr, fq));
        if (fq == 0) P.sspo[(size_t)t * 64 + cg] = ss;
        const f32x4 y = hn * gs; u32x2 w; w.x = cvt_pk_bf16(y[0], y[1]); w.y = cvt_pk_bf16(y[2], y[3]); *(u32x2*)(P.xbo + cf_off(t, c4 + 4 * fq, D)) = w;
    } else if (P.kind == 5) {
        f32x4 acc[2][2]; const int q = c0 >> 7, cl = c0 & 127, nb0 = q * 256 + cl;
        const bf16_t* const Bp[2] = {P.Bt + (size_t)nb0 * P.K, P.Bt + (size_t)(nb0 + 128) * P.K};
        const f32x4 b0 = *(const f32x4*)(P.bias + nb0 + 4 * fq), b1 = *(const f32x4*)(P.bias + nb0 + 128 + 4 * fq);
        const CtxSS ssv[2] = {ctx_ss_load(P.sspi, 32 * C.wave + fr, fq), ctx_ss_load(P.sspi, 32 * C.wave + 16 + fr, fq)};
        ctx_mm<2, 16, 1024>(acc, P.A, P.lda, Bp, C.wave, C.lane, C.tid, C.lds);
        const CtxCW<3> cwv = ctx_cw_load<3>(P.cw, DFF, P.cb, c0 + 8 * hh);
#pragma unroll
        for (int g = 0; g < 2; ++g) { const int t = 32 * C.wave + 16 * g + fr; const float rs = ctx_rstd_fin(ssv[g], fr, fq);
            *(LAS f32x4*)(t0 + t * 16 + 4 * fq) = acc[g][0] * rs + b0; *(LAS f32x4*)(t1 + t * 16 + 4 * fq) = acc[g][1] * rs + b1; }
        __syncthreads();
        float o[8]; ctx_conv_rows<3, 1>(o, t0, tt, hh, cwv);
        const f32x4 v0 = *(const LAS f32x4*)(t1 + tt * 16 + 8 * hh), v1 = *(const LAS f32x4*)(t1 + tt * 16 + 8 * hh + 4);
        u32x4 w; w.x = cvt_pk_bf16(silu_f(o[0]) * v0[0], silu_f(o[1]) * v0[1]); w.y = cvt_pk_bf16(silu_f(o[2]) * v0[2], silu_f(o[3]) * v0[3]);
        w.z = cvt_pk_bf16(silu_f(o[4]) * v1[0], silu_f(o[5]) * v1[1]); w.w = cvt_pk_bf16(silu_f(o[6]) * v1[2], silu_f(o[7]) * v1[3]);
        *(u32x4*)(P.o1 + cf_off(tt, c0 + 8 * hh, DFF)) = w;
        __syncthreads();
    } else {
        f32x4 acc[2][3]; const int q = c0 >> 7, cl = c0 & 127, nb1 = 1024 + q * 256 + cl;
        const bf16_t* const Bp[3] = {P.Bt + (size_t)c0 * P.K, P.Bt + (size_t)nb1 * P.K, P.Bt + (size_t)(nb1 + 128) * P.K};
        const f32x4 b0 = *(const f32x4*)(P.bias + c0 + 4 * fq), b1 = *(const f32x4*)(P.bias + nb1 + 4 * fq), b2 = *(const f32x4*)(P.bias + nb1 + 128 + 4 * fq);
        const CtxSS ssv[2] = {ctx_ss_load(P.sspi, 32 * C.wave + fr, fq), ctx_ss_load(P.sspi, 32 * C.wave + 16 + fr, fq)};
        ctx_mm<3, 16, 1024>(acc, P.A, P.lda, Bp, C.wave, C.lane, C.tid, C.lds);
        const CtxCW<3> cwv = ctx_cw_load<3>(P.cw, D, P.cb, c0 + 8 * hh);
#pragma unroll
        for (int g = 0; g < 2; ++g) { const int t = 32 * C.wave + 16 * g + fr; const float rs = ctx_rstd_fin(ssv[g], fr, fq);
            *(LAS f32x4*)(t0 + t * 16 + 4 * fq) = (acc[g][1] * rs + b1) * (acc[g][2] * rs + b2); *(LAS f32x4*)(t1 + t * 16 + 4 * fq) = acc[g][0] * rs + b0; }
        __syncthreads();
        float o[8]; ctx_conv_rows<3, 1>(o, t0, tt, hh, cwv);
        const f32x4 v0 = *(const LAS f32x4*)(t1 + tt * 16 + 8 * hh), v1 = *(const LAS f32x4*)(t1 + tt * 16 + 8 * hh + 4);
        u32x4 w; w.x = cvt_pk_bf16(o[0] * v0[0], o[1] * v0[1]); w.y = cvt_pk_bf16(o[2] * v0[2], o[3] * v0[3]); w.z = cvt_pk_bf16(o[4] * v1[0], o[5] * v1[1]); w.w = cvt_pk_bf16(o[6] * v1[2], o[7] * v1[3]);
        *(u32x4*)(P.o1 + cf_off(tt, c0 + 8 * hh, D)) = w;
        __syncthreads();
    }
}
__device__ __forceinline__ int ctx_step(const Ctx& C, int ph, CtxP& P) {
    const float* mods = WSP(float, WS_MODS);
#define CMOD(l, chunk) (mods + (size_t)((l) * 2 + 1) * NMOD + (chunk) * 1024)
#define CXB(i) (WSP(bf16_t, CX_XB) + (size_t)(i) * CT * D)
#define CSSP(i) (WSP(float, CX_SSP) + (size_t)(i) * CT * 64)
    P.kind = 0; P.A = nullptr; P.lda = D; P.K = D; P.Bt = nullptr; P.sspi = nullptr; P.bias = nullptr; P.hin = nullptr; P.hout = nullptr; P.xbo = nullptr; P.gate = nullptr; P.ng = nullptr; P.sc = nullptr; P.sspo = nullptr;
    P.o1 = nullptr; P.o2 = nullptr; P.cw = nullptr; P.cb = nullptr; P.br = nullptr; P.bi = nullptr; P.la8 = nullptr; P.h0 = nullptr;
    int sid; switch (ph) { case 2: sid = 2; break; case 3: sid = 3; break; case 4: sid = 4; break; case 5: sid = 5; break; case 8: sid = 6; break; case 9: sid = 7; break; case 10: sid = 8; break;
                           case 11: sid = 9; break; case 13: sid = 10; break; case 14: sid = 11; break; case 15: sid = 12; break; default: sid = 0; }
    switch (sid) {
    case 2: case 11: { const int j = sid == 2 ? 0 : 1, l = 2 * j, xi = sid == 2 ? 0 : 4;
        P.kind = 1; P.A = CXB(xi); P.lda = D; P.K = D; P.Bt = WSP(bf16_t, W_A1 + j * SZ_A1); P.sspi = CSSP(xi); P.bias = WSP(float, WS_BIASM) + (size_t)(l * 2 + 1) * 3072;
        P.o1 = WSP(bf16_t, CX_U) + (size_t)j * CT * D; P.o2 = WSP(bf16_t, CX_G); P.cw = INP(IX_ACW) + (size_t)j * 4 * D; P.cb = INP(IX_ACB) + (size_t)j * D; return 64; }
    case 3: case 12: { const int j = sid == 3 ? 0 : 1;
        P.kind = 2; P.A = WSP(bf16_t, CX_U) + (size_t)j * CT * D; P.lda = D; P.K = 256; P.Bt = WSP(bf16_t, W_A2 + j * SZ_A2);
        P.br = INP(IX_ABR) + (size_t)j * 2 * D; P.bi = INP(IX_ABI) + (size_t)j * 2 * D; P.la8 = WSP(float, WS_LA8) + (size_t)j * 2 * D; P.h0 = WSP(float, WS_H0) + (size_t)j * 2 * D;
        P.o1 = j == 0 ? WSP(bf16_t, CX_GS) : nullptr; P.o2 = WSP(bf16_t, CX_G); return 64; }
    case 4: P.kind = 4; P.A = WSP(bf16_t, CX_GS); P.lda = D; P.K = D; P.Bt = WSP(bf16_t, W_A3); P.hin = INP(IX_CTX); P.hout = WSP(float, CX_H); P.xbo = CXB(1); P.gate = CMOD(0, 2); P.ng = INP(IX_NFG); P.sc = CMOD(0, 4); P.sspo = CSSP(1); return 128;
    case 5: case 9: { const int l = sid == 5 ? 0 : 1, xi = sid == 5 ? 1 : 3;
        P.kind = 5; P.A = CXB(xi); P.lda = D; P.K = D; P.Bt = WSP(bf16_t, W_F1 + l * SZ_F1); P.sspi = CSSP(xi); P.bias = WSP(float, WS_BIASF) + (size_t)(l * 2 + 1) * 5632;
        P.o1 = WSP(bf16_t, CX_Y + l * 1536 * KiB); P.cw = INP(IX_FCW) + (size_t)l * 3 * DFF; P.cb = INP(IX_FCB) + (size_t)l * DFF; return 176; }
    case 6: case 10: { const int l = sid == 6 ? 0 : 1, xo = sid == 6 ? 2 : 4;
        P.kind = 4; P.A = WSP(bf16_t, CX_Y + l * 1536 * KiB); P.lda = DFF; P.K = DFF; P.Bt = WSP(bf16_t, W_F2 + l * SZ_F2); P.hin = WSP(float, CX_H); P.hout = WSP(float, CX_H); P.xbo = CXB(xo);
        P.gate = CMOD(l, 5); P.ng = INP(IX_NMG) + (size_t)(l + 1) * D; P.sc = CMOD(l + 1, 1); P.sspo = CSSP(xo); return 128; }
    case 7: P.kind = 7; P.A = CXB(2); P.lda = D; P.K = D; P.Bt = WSP(bf16_t, W_B1); P.sspi = CSSP(2); P.bias = WSP(float, WS_BIASM) + (size_t)(1 * 2 + 1) * 3072;
        P.o1 = WSP(bf16_t, CX_Q); P.cw = INP(IX_BCW); P.cb = INP(IX_BCB); return 64;
    case 8: P.kind = 4; P.A = WSP(bf16_t, CX_Q); P.lda = D; P.K = D; P.Bt = WSP(bf16_t, W_B2); P.hin = WSP(float, CX_H); P.hout = WSP(float, CX_H); P.xbo = CXB(3); P.gate = CMOD(1, 2); P.ng = INP(IX_NFG) + D; P.sc = CMOD(1, 4); P.sspo = CSSP(3); return 128;
    default: return 0;
    }
#undef CMOD
#undef CXB
#undef CSSP
}

__global__ void __launch_bounds__(512, 2) mega_fwd(Args args) {
    extern __shared__ __attribute__((aligned(16))) unsigned char lds_raw[];
    Ctx C;
    C.in = args.in; C.out = args.out; C.ws = args.ws; C.lds = (LAS unsigned char*)lds_raw;
    C.tid = threadIdx.x; C.lane = C.tid & 63; C.wave = __builtin_amdgcn_readfirstlane(C.tid >> 6); C.G = gridDim.x; C.bid = blockIdx.x;
    volatile LAS unsigned* MISC = (volatile LAS unsigned*)(C.lds + MISC_OFF);
    for (int u = C.tid; u < (LDS_BYTES - LDSCTL_OFF) / 4; u += 512) ((LAS unsigned*)(C.lds + LDSCTL_OFF))[u] = 0u;
    __syncthreads();
    XcdBarrier bar; bar.bar = (unsigned*)(C.ws + WS_CTL) + 4096; bar.x = 0; bar.st = nullptr;
#if !MK_PER_PHASE
    bar = xcd_barrier_post((unsigned*)(C.ws + WS_CTL) + 4096, MISC + 8);
#endif
    const int lo = args.ph_lo, hi = args.ph_hi;
#define REFRESH_LANE() do { C.lane = lane_id(); asm volatile("" : "+v"(C.lane)); C.tid = C.wave * 64 + C.lane; } while (0)
#define IN(k) (lo <= (k) && (k) < hi)
#ifndef MK_BAR_REPS
#define MK_BAR_REPS 1
#endif
#define SEAM(k) do { if (IN(k) && IN((k) + 1)) { for (int br_ = 0; br_ < MK_BAR_REPS; ++br_) xcd_barrier(bar); } } while (0)
    const float* mods = WSP(float, WS_MODS);
#define LMOD(l, chunk) (mods + (size_t)((l) * 2) * NMOD + (chunk) * 1024)
#define SLOTP(type, i) WSP(type, WS_SLOT + (size_t)(i) * SLOT)
#define SSPA(i) (WSP(float, WS_SSP) + (size_t)(i) * T * 16)
    int ph = 0;
    if (IN(ph)) { REFRESH_LANE(); phase_p0(C); }
    SEAM(ph); ++ph;
    if (IN(ph)) { REFRESH_LANE(); phase_p1(C); }
    SEAM(ph); ++ph;
    for (ph = 2; ph < 28; ++ph) {
        if (IN(ph)) {
            asm volatile("" : "+s"(C.wave), "+s"(C.bid), "+s"(C.G));
            { size_t zz = 0; asm volatile("" : "+s"(zz)); C.ws = args.ws + zz; C.out = args.out + zz; }
            REFRESH_LANE();
            { CtxP cp; const int nci = ctx_step(C, ph, cp); const int coff = (ph == 8 || ph == 13) ? (C.G >> 1) : 0;
              for (int it = C.bid - coff; it < nci; it += C.G) if (it >= 0) ctx_item(C, cp, it); }
            int p = ph - 2, l = 0;
            if (p >= 13) { p -= 13; l = 2; }
            int kind;
            if (p < 8) kind = p; else { l += 1; p -= 8; kind = p == 0 ? 8 : p == 1 ? 9 : p + 3; }
            const int j = l >> 1;
            if (kind == 0) {
                pg8::Gemm g{SLOTP(bf16_t, 0), WSP(bf16_t, W_A1 + j * SZ_A1), D, D, 64, 8, 0, 0}; pg8::StaticOrder S; S.init(64, 8, C.G, C.bid);
                EpiA1 E{SLOTP(bf16_t, 1), SLOTP(bf16_t, 4), WSP(float, WS_BIASM) + (size_t)(l * 2) * 3072, SSPA(2 * l)};
                pg8::gemm_phase(C.lds, g, S, E, C.wave);
            } else if (kind == 1) {
                REFRESH_LANE();
                phase_conv4(C, SLOTP(bf16_t, 1), SLOTP(bf16_t, 5), INP(IX_ACW) + (size_t)j * 4 * D, INP(IX_ACB) + (size_t)j * D);
            } else if (kind == 2) {
                int kk = 256; asm volatile("" : "+s"(kk));
                pg8::Gemm g{SLOTP(bf16_t, 5), WSP(bf16_t, W_A2 + j * SZ_A2), D, kk, 64, 16, 1, 3}; pg8::StaticOrder S; S.init(64, 16, C.G, C.bid);
                EpiA2 E{SLOTP(bf16_t, 5), SLOTP(h16, 0), INP(IX_ABR) + (size_t)j * 2 * D, INP(IX_ABI) + (size_t)j * 2 * D, WSP(float, WS_LA8) + (size_t)j * 2 * D};
                pg8::gemm_phase<EpiA2, false>(C.lds, g, S, E, C.wave);
            } else if (kind == 3) {
                REFRESH_LANE();
                phase_scan1(C, SLOTP(h16, 0));
            } else if (kind == 4) {
                REFRESH_LANE();
                phase_scan2(C, SLOTP(h16, 0), SLOTP(bf16_t, 4), SLOTP(bf16_t, 5), WSP(float, WS_H0) + (size_t)j * 2 * D);
            } else if (kind == 5) {
                const bf16_t* bt = (l & 1) ? WSP(bf16_t, W_B2 + j * SZ_B2) : WSP(bf16_t, W_A3 + j * SZ_A3);
                pg8::Gemm g{(l & 1) ? SLOTP(bf16_t, 3) : SLOTP(bf16_t, 5), bt, D, D, 64, 4, 0, 0}; pg8::StaticOrder S; S.init(64, 4, C.G, C.bid);
                EpiRes E{WSP(bf16_t, WS_XRES), SLOTP(bf16_t, 0), LMOD(l, 2), INP(IX_NFG) + (size_t)l * D, LMOD(l, 4), SSPA(2 * l + 1)};
                pg8::gemm_phase(C.lds, g, S, E, C.wave);
            } else if (kind == 6) {
                pg8::Gemm g{SLOTP(bf16_t, 0), WSP(bf16_t, W_F1 + l * SZ_F1), D, D, 64, 22, 0, 0}; pg8::StaticOrder S; S.init(64, 22, C.G, C.bid, ph > 13);
                EpiF1 E{SLOTP(bf16_t, 1), WSP(float, WS_BIASF) + (size_t)(l * 2) * 5632, SSPA(2 * l + 1), INP(IX_FCW) + (size_t)l * 3 * DFF, INP(IX_FCB) + (size_t)l * DFF};
                pg8::gemm_phase(C.lds, g, S, E, C.wave);
            } else if (kind == 7) {
                pg8::Gemm g{SLOTP(bf16_t, 1), WSP(bf16_t, W_F2 + l * SZ_F2), DFF, DFF, 64, 4, 0, 0}; pg8::StaticOrder S; S.init(64, 4, C.G, C.bid);
                EpiRes E{WSP(bf16_t, WS_XRES), SLOTP(bf16_t, 0), LMOD(l, 5), l < 3 ? INP(IX_NMG) + (size_t)(l + 1) * D : nullptr, l < 3 ? LMOD(l + 1, 1) : nullptr, SSPA(2 * l + 2)};
                pg8::gemm_phase(C.lds, g, S, E, C.wave);
            } else if (kind == 8) {
                pg8::Gemm g{SLOTP(bf16_t, 0), WSP(bf16_t, W_B1 + j * SZ_B1), D, D, 64, 12, 0, 0}; pg8::StaticOrder S; S.init(64, 12, C.G, C.bid);
                EpiB1 E{SLOTP(bf16_t, 1), SLOTP(bf16_t, 2), WSP(float, WS_BIASM) + (size_t)(l * 2) * 3072, SSPA(2 * l)};
                pg8::gemm_phase(C.lds, g, S, E, C.wave);
            } else {
                REFRESH_LANE();
                phase_vconv(C, SLOTP(bf16_t, 1), SLOTP(bf16_t, 2), SLOTP(bf16_t, 3), INP(IX_BCW) + (size_t)j * 3 * D, INP(IX_BCB) + (size_t)j * D);
            }
        }
        SEAM(ph);
    }
    if (IN(ph)) { REFRESH_LANE(); phase_final(C, SSPA(8)); }
}
constexpr int N_PHASES = 29;

extern "C" void kernel_launch(void* const* d_in, const int* in_sizes, int n_in, void* d_out, int out_size, void* d_ws, size_t ws_size, hipStream_t stream) {
    static int grid = 0;
    if (grid == 0) {
        if (n_in != N_IN || in_sizes[0] != T * D || out_size != T * D || ws_size < WS_END) { fprintf(stderr, "kernel_launch: unexpected problem shape (n_in %d, in0 %d, out %d, ws %zu < %zu)\n", n_in, n_in > 0 ? in_sizes[0] : -1, out_size, ws_size, (size_t)WS_END); grid = -1; return; }
        int dev = 0, cus = 0, per_cu = 0;
        if (hipGetDevice(&dev) != hipSuccess || hipDeviceGetAttribute(&cus, hipDeviceAttributeMultiprocessorCount, dev) != hipSuccess) { grid = -1; return; }
        if (hipFuncSetAttribute((const void*)mega_fwd, hipFuncAttributeMaxDynamicSharedMemorySize, LDS_BYTES) != hipSuccess) { fprintf(stderr, "kernel_launch: hipFuncSetAttribute failed\n"); grid = -1; return; }
        if (hipOccupancyMaxActiveBlocksPerMultiprocessor(&per_cu, (const void*)mega_fwd, 512, LDS_BYTES) != hipSuccess || per_cu < 1) fprintf(stderr, "kernel_launch: occupancy query reports %d\n", per_cu);
        (void)hipGetLastError();
        grid = cus;
    }
    if (grid < 0) return;
    (void)hipMemsetAsync((char*)d_ws + WS_CTL, 0, CTL_ZERO_BYTES, stream);
    Args a{};
    for (int i = 0; i < N_IN; ++i) a.in[i] = (const float*)d_in[i];
    a.out = (float*)d_out; a.ws = (unsigned char*)d_ws;
#if MK_PER_PHASE
    for (int p = 0; p < N_PHASES; ++p) {
        const bool dup = (MK_DUP_MASK >> p) & 1u;
        bool inplace = false;
        if (p >= 2 && p < 28) { int q = p - 2, l = 0; if (q >= 13) { q -= 13; l = 2; } int kind; if (q < 8) kind = q; else { l += 1; q -= 8; kind = q == 0 ? 8 : q == 1 ? 9 : q + 3; } inplace = kind == 5 || kind == 7; }
        const bool cin = (p == 6 || p == 8 || p == 10);
        char* xbk = (char*)d_ws + WS_SLOT + 4 * SLOT; char* cbk = (char*)d_ws + WS_END;
        if (dup && inplace) (void)hipMemcpyAsync(xbk, (char*)d_ws + WS_XRES, (size_t)T * D * 2, hipMemcpyDeviceToDevice, stream);
        if (dup && cin) (void)hipMemcpyAsync(cbk, (char*)d_ws + CX_H, (size_t)CT * D * 4, hipMemcpyDeviceToDevice, stream);
        a.ph_lo = p; a.ph_hi = p + 1; hipLaunchKernelGGL(mega_fwd, dim3(grid), dim3(512), LDS_BYTES, stream, a);
        if (dup) {
            if (inplace) (void)hipMemcpyAsync((char*)d_ws + WS_XRES, xbk, (size_t)T * D * 2, hipMemcpyDeviceToDevice, stream);
            if (cin) (void)hipMemcpyAsync((char*)d_ws + CX_H, cbk, (size_t)CT * D * 4, hipMemcpyDeviceToDevice, stream);
            hipLaunchKernelGGL(mega_fwd, dim3(grid), dim3(512), LDS_BYTES, stream, a);
        }
    }
#else
    a.ph_lo = 0; a.ph_hi = N_PHASES;
    hipLaunchKernelGGL(mega_fwd, dim3(grid), dim3(512), LDS_BYTES, stream, a);
#endif
}
```

```cpp
#include <hip/hip_runtime.h>
#include <cstdio>
#include <cstdint>

#ifndef MK_DUP_MASK
#define MK_DUP_MASK 0u
#endif
#ifndef MK_PER_PHASE
#define MK_PER_PHASE 0
#endif

#define LAS __attribute__((address_space(3)))
typedef unsigned short bf16_t;
typedef short bf16x8 __attribute__((ext_vector_type(8)));
typedef float f32x4 __attribute__((ext_vector_type(4)));
typedef float f32x2 __attribute__((ext_vector_type(2)));
typedef unsigned u32x4 __attribute__((ext_vector_type(4)));
typedef unsigned u32x2 __attribute__((ext_vector_type(2)));
typedef _Float16 h16;
typedef _Float16 h16x2 __attribute__((ext_vector_type(2)));
typedef _Float16 h16x4 __attribute__((ext_vector_type(4)));

constexpr int T = 16384, D = 1024, CT = 256, DFF = 2816, NMOD = 6144;
constexpr float EPS = 1e-6f;

enum { IX_X = 0, IX_C, IX_CTX, IX_CCTX, IX_ADAW, IX_ADAB, IX_NMG, IX_NFG, IX_AWX, IX_AWG, IX_ACW, IX_ACB, IX_AWR, IX_ABR, IX_AWI, IX_ABI, IX_ALAM, IX_AWO,
       IX_BWIN, IX_BCW, IX_BCB, IX_BWO, IX_FWU, IX_FCW, IX_FCB, IX_FWD, IX_FG, N_IN };

constexpr size_t MiB = 1u << 20, KiB = 1u << 10;
constexpr size_t WS_CTL = 0, CTL_ZERO_BYTES = 64 * KiB;
constexpr size_t WS_MODS = 1 * MiB;
constexpr size_t WS_BIASM = 1 * MiB + 256 * KiB;
constexpr size_t WS_BIASF = 1 * MiB + 512 * KiB;
constexpr size_t WS_LA8 = 1 * MiB + 768 * KiB;
constexpr size_t WS_H0 = WS_LA8 + 16 * KiB;
constexpr size_t WS_SSP = 2 * MiB;
constexpr size_t WS_AGGT = 11 * MiB;
constexpr size_t WS_AGG32 = 12 * MiB;
constexpr size_t WS_CTXR = 20 * MiB;
constexpr size_t CX_H = WS_CTXR;
constexpr size_t CX_XB = WS_CTXR + 1 * MiB;
constexpr size_t CX_U = WS_CTXR + 4 * MiB;
constexpr size_t CX_G = WS_CTXR + 5 * MiB;
constexpr size_t CX_GS = CX_G + 512 * KiB;
constexpr size_t CX_Q = WS_CTXR + 6 * MiB;
constexpr size_t CX_Y = CX_Q + 512 * KiB;
constexpr size_t CX_SSP = WS_CTXR + 10 * MiB;
constexpr size_t WS_W = 32 * MiB;
constexpr size_t W_A1 = WS_W, W_A2 = WS_W + 8 * MiB, W_A3 = WS_W + 12 * MiB, W_B1 = WS_W + 16 * MiB, W_B2 = WS_W + 28 * MiB, W_F1 = WS_W + 32 * MiB, W_F2 = WS_W + 76 * MiB;
constexpr size_t SZ_A1 = 4 * MiB, SZ_A2 = 2 * MiB, SZ_A3 = 2 * MiB, SZ_B1 = 6 * MiB, SZ_B2 = 2 * MiB, SZ_F1 = 11 * MiB, SZ_F2 = 5632 * KiB;
constexpr size_t WS_SLOT = 130 * MiB, SLOT = 32 * MiB;
constexpr size_t WS_XRES = WS_SLOT + 6 * SLOT;
constexpr size_t WS_END = WS_XRES + SLOT;
static_assert(W_F2 + 4 * SZ_F2 <= WS_SLOT, "weights fit");

constexpr int RING_BYTES = 131072, LDSCTL_OFF = RING_BYTES, MISC_OFF = LDSCTL_OFF + 320, LDS_BYTES = 147456;

__device__ __forceinline__ float bf2f(unsigned b) { return __uint_as_float(b << 16); }
__device__ __forceinline__ unsigned cvt_pk_bf16(float lo, float hi) { unsigned r; asm volatile("v_cvt_pk_bf16_f32 %0, %1, %2" : "=v"(r) : "v"(lo), "v"(hi)); return r; }
__device__ __forceinline__ float sigm(float x) { return __builtin_amdgcn_rcpf(1.f + __builtin_amdgcn_exp2f(-1.4426950409f * x)); }
__device__ __forceinline__ float silu_f(float x) { return x * sigm(x); }
__device__ __forceinline__ float gelu_t(float x) { const float u = x + 0.044715f * x * x * x; return x * __builtin_amdgcn_rcpf(1.f + __builtin_amdgcn_exp2f(-2.3022081986f * u)); }
__device__ __forceinline__ float one_minus_exp(float x) {
    float p = 1.f / 720.f; p = p * x + 1.f / 120.f; p = p * x + 1.f / 24.f; p = p * x + 1.f / 6.f; p = p * x + 0.5f; p = p * x + 1.f;
    const float small = -(p * x);
    const float big = 1.f - __builtin_amdgcn_exp2f(1.4426950409f * x);
    return x < -0.25f ? big : small;
}
__device__ __forceinline__ int lane_id() { return (int)__builtin_amdgcn_mbcnt_hi(~0u, __builtin_amdgcn_mbcnt_lo(~0u, 0u)); }
#define SWZ_X4 0x101F
#define SWZ_X8 0x201F
#define SWZ_X16 0x401F
__device__ __forceinline__ float add_x16(float v) { return v + __builtin_bit_cast(float, __builtin_amdgcn_ds_swizzle(__builtin_bit_cast(int, v), SWZ_X16)); }
__device__ __forceinline__ float add_x32(float v, int xl) { return v + __builtin_bit_cast(float, __builtin_amdgcn_ds_bpermute(xl, __builtin_bit_cast(int, v))); }
#define XL32(fr, fq) ((((fr) + 16 * (fq)) ^ 32) << 2)
__device__ __forceinline__ float wave_sum(float v) {
    v += __builtin_bit_cast(float, __builtin_amdgcn_update_dpp(0, __builtin_bit_cast(int, v), 0xB1, 0xf, 0xf, false));
    v += __builtin_bit_cast(float, __builtin_amdgcn_update_dpp(0, __builtin_bit_cast(int, v), 0x4E, 0xf, 0xf, false));
    v += __builtin_bit_cast(float, __builtin_amdgcn_ds_swizzle(__builtin_bit_cast(int, v), SWZ_X4));
    v += __builtin_bit_cast(float, __builtin_amdgcn_ds_swizzle(__builtin_bit_cast(int, v), SWZ_X8));
    v = add_x16(v);
    return __builtin_bit_cast(float, __builtin_amdgcn_readlane(__builtin_bit_cast(int, v), 0)) + __builtin_bit_cast(float, __builtin_amdgcn_readlane(__builtin_bit_cast(int, v), 32));
}
__device__ __forceinline__ float dpp_ror1(float x) { return __builtin_bit_cast(float, __builtin_amdgcn_update_dpp(0, __builtin_bit_cast(int, x), 0x121, 0xf, 0xf, false)); }
__device__ __forceinline__ float dpp_ror15(float x) { return __builtin_bit_cast(float, __builtin_amdgcn_update_dpp(0, __builtin_bit_cast(int, x), 0x12F, 0xf, 0xf, false)); }
__device__ __forceinline__ unsigned pk_h2(float a, float b) { h16x2 v = {(h16)a, (h16)b}; return __builtin_bit_cast(unsigned, v); }
__device__ __forceinline__ f32x4 h4_to_f4(u32x2 w) { h16x4 h = __builtin_bit_cast(h16x4, w); return (f32x4){(float)h[0], (float)h[1], (float)h[2], (float)h[3]}; }
__device__ __forceinline__ f32x4 bf4_to_f4(u32x2 w) { return (f32x4){bf2f(w.x & 0xffffu), bf2f(w.x >> 16), bf2f(w.y & 0xffffu), bf2f(w.y >> 16)}; }

namespace pg8 {
constexpr int BM = 256, BK = 64, HALF = 128, HTB = HALF * BK * 2, STAGE_BYTES = 8 * HTB, NXCD = 8, WGM = 4;
__host__ __device__ __forceinline__ int lds_byte(int r, int c) { const int st = (r >> 4) * 2 + (c >> 5), rr = r & 15, cc = c & 31, ob = rr * 64 + cc * 2; return st * 1024 + (ob ^ (((ob >> 9) & 1) << 5)); }
__host__ __device__ __forceinline__ void stage_rc(int b, int& R, int& C) { const int st = b / 1024, sb = b % 1024, swz = sb ^ (((sb >> 9) & 1) << 5); R = (st >> 1) * 16 + swz / 64; C = (st & 1) * 32 + (swz % 64) / 2; }
__host__ __device__ __forceinline__ int perm32(int rho) { const int n = rho >> 4, i = rho & 15; return 8 * (i >> 2) + 4 * n + (i & 3); }
struct Unit { int pm, pn, hrow, nai; };
struct Gemm { const bf16_t* A; const bf16_t* Bt; int lda, K, nM, nN, acs, acm; };
struct StaticOrder {
    int nM, nN, nwg, G, c; bool halves;
    __device__ void init(int nM_, int nN_, int G_, int c_, bool halves_ = false) { nM = nM_; nN = nN_; nwg = nM * nN; G = G_; c = c_; halves = halves_; }
    __device__ bool next(int i, Unit& u) const {
        const int fullr = nwg / G, rem = nwg - fullr * G; const bool split = halves && (rem * 2 == G);
        long L; u.hrow = 0; u.nai = 2;
        if (i < fullr) L = (long)i * G + c;
        else if (i == fullr && split) { L = (long)fullr * G + (c >> 1); u.hrow = (c & 1) * 128; u.nai = 1; }
        else if (i == fullr && c < rem) L = (long)i * G + c;
        else return false;
        int wgid = (int)L; { const int q = nwg / NXCD, r = nwg % NXCD, xcd = wgid % NXCD, off = wgid / NXCD; wgid = (xcd < r ? xcd * (q + 1) : r * (q + 1) + (xcd - r) * q) + off; }
        const int nig = WGM * nN, gid = wgid / nig, fm = gid * WGM, gsz = (nM - fm) < WGM ? (nM - fm) : WGM;
        u.pm = fm + ((wgid % nig) % gsz); u.pn = (wgid % nig) / gsz; return true;
    }
};

template <class Epi, bool PERM = true>
__device__ __forceinline__ void gemm_phase(LAS unsigned char* lds, const Gemm g, const StaticOrder& S, const Epi& E, int wid_) {
    int lane_ = lane_id(); asm volatile("" : "+v"(lane_));
    const int wid = wid_, lane = lane_, tid = wid * 64 + lane, wr = wid >> 2, wc = wid & 3, fr = lane & 15, fq = lane >> 4;
    const int K = g.K, nt = K / BK;
    unsigned voffA[2], voffB[2];
#pragma unroll
    for (int i = 0; i < 2; ++i) { int R, C; stage_rc(tid * 16 + i * 8192, R, C); const int Rb = PERM ? (R & ~31) + perm32(R & 31) : R;
        voffA[i] = (unsigned)(R * g.lda + C) * 2u; voffB[i] = (unsigned)(Rb * K + C) * 2u; }
    const unsigned kstep = (unsigned)(BK * 2);
    const unsigned hstepA = (unsigned)HALF * (unsigned)g.lda * 2u, tstepA = 2u * hstepA;
    const unsigned hstepB = (unsigned)HALF * (unsigned)K * 2u, tstepB = 2u * hstepB;
    const unsigned ldsw = (unsigned)wid * 1024u;
    const int aoff = lds_byte(wr * 64 + fr, fq * 8), boff = lds_byte(wc * 32 + fr, fq * 8);
    const __amdgpu_buffer_rsrc_t rsA = __builtin_amdgcn_make_buffer_rsrc((void*)g.A, 0, 0x7fffffff, 0x00020000);
    const __amdgpu_buffer_rsrc_t rsB = __builtin_amdgcn_make_buffer_rsrc((void*)g.Bt, 0, 0x7fffffff, 0x00020000);
#define PG8_UA(u) ((unsigned)(u).pm * tstepA + ((u).hrow ? hstepA : 0u) + (unsigned)((((u).pn >> g.acs) & g.acm) * 512))
#define PG8_UB(u) ((unsigned)(u).pn * tstepB)
#define PG8_SA(b, h) (((b) * 2 + (h)) * HTB)
#define PG8_SB(b, h) ((4 + (b) * 2 + (h)) * HTB)
#define PG8_STAGE(bufoff, rs, soff, voff) do { _Pragma("unroll") for (int _i = 0; _i < 2; ++_i) \
        __builtin_amdgcn_raw_ptr_buffer_load_lds(rs, (LAS void*)(lds + (bufoff) + ldsw + _i * 8192), 16, (int)(voff)[_i], (int)(soff), 0, 0); } while (0)
#define PG8_LDA(dst, b, h) do { _Pragma("unroll") for (int m = 0; m < 4; ++m) _Pragma("unroll") for (int k = 0; k < 2; ++k) dst[m][k] = *(const LAS bf16x8*)(lds + PG8_SA(b, h) + aoff + m * 2048 + k * 1024); } while (0)
#define PG8_LDB(dst, b, h) do { _Pragma("unroll") for (int n = 0; n < 2; ++n) _Pragma("unroll") for (int k = 0; k < 2; ++k) dst[n][k] = *(const LAS bf16x8*)(lds + PG8_SB(b, h) + boff + n * 2048 + k * 1024); } while (0)
#define PG8_MMA(ai, bj, At, Bt) do { __builtin_amdgcn_s_setprio(1); _Pragma("unroll") for (int m = 0; m < 4; ++m) _Pragma("unroll") for (int n = 0; n < 2; ++n) _Pragma("unroll") for (int k = 0; k < 2; ++k) \
        acc[ai][bj][m][n] = __builtin_amdgcn_mfma_f32_16x16x32_bf16(Bt[n][k], At[m][k], acc[ai][bj][m][n], 0, 0, 0); __builtin_amdgcn_s_setprio(0); } while (0)
#define PG8_WAIT_V(n) asm volatile("s_waitcnt vmcnt(" #n ")" ::: "memory")
#define PG8_WAIT_L(n) asm volatile("s_waitcnt lgkmcnt(" #n ")" ::: "memory")
#define PG8_BAR __builtin_amdgcn_s_barrier()
#define PG8_SCHED __builtin_amdgcn_sched_barrier(0)
    Unit cur, nxt; int ui = 0;
    if (!S.next(0, cur)) return;
    f32x4 acc[2][2][4][2];
#pragma unroll
    for (int a = 0; a < 2; ++a)
#pragma unroll
        for (int b = 0; b < 2; ++b)
#pragma unroll
            for (int m = 0; m < 4; ++m)
#pragma unroll
                for (int n = 0; n < 2; ++n) acc[a][b][m][n] = (f32x4){0.f, 0.f, 0.f, 0.f};
    bf16x8 At[4][2], B0[2][2], B1[2][2];
    unsigned cA = PG8_UA(cur), cB = PG8_UB(cur);
    PG8_STAGE(PG8_SB(0, 0), rsB, cB, voffB); PG8_STAGE(PG8_SB(0, 1), rsB, cB + hstepB, voffB); PG8_STAGE(PG8_SA(0, 0), rsA, cA, voffA); PG8_STAGE(PG8_SA(0, 1), rsA, cA + hstepA, voffA);
    if (wr == 1) PG8_BAR;
    PG8_WAIT_V(2); PG8_BAR;
    PG8_STAGE(PG8_SB(1, 0), rsB, cB + kstep, voffB); PG8_STAGE(PG8_SA(1, 0), rsA, cA + kstep, voffA); PG8_STAGE(PG8_SB(1, 1), rsB, cB + hstepB + kstep, voffB);
    PG8_WAIT_V(6); PG8_BAR;
    for (;;) {
        const bool has_next = S.next(ui + 1, nxt);
        const unsigned nA = has_next ? PG8_UA(nxt) : cA, nB = has_next ? PG8_UB(nxt) : cB;
        for (int t = 0; t < nt; t += 2) {
            const bool last = (t == nt - 2);
            const unsigned a1 = cA + (unsigned)(t + 1) * kstep;
            const unsigned a2 = last ? nA : cA + (unsigned)(t + 2) * kstep, b2 = last ? nB : cB + (unsigned)(t + 2) * kstep;
            const unsigned a3 = a2 + kstep, b3 = b2 + kstep;
            PG8_LDB(B0, 0, 0); PG8_LDB(B1, 0, 1); PG8_SCHED; PG8_LDA(At, 0, 0); PG8_STAGE(PG8_SA(1, 1), rsA, a1 + hstepA, voffA);
            PG8_WAIT_V(8); PG8_WAIT_L(0); PG8_BAR; PG8_MMA(0, 0, At, B0); PG8_MMA(0, 1, At, B1); PG8_BAR; PG8_SCHED;
            PG8_LDA(At, 0, 1); PG8_STAGE(PG8_SB(0, 0), rsB, b2, voffB); PG8_STAGE(PG8_SB(0, 1), rsB, b2 + hstepB, voffB); PG8_STAGE(PG8_SA(0, 0), rsA, a2, voffA);
            PG8_WAIT_V(8); PG8_WAIT_L(0); PG8_BAR; if (cur.nai == 2) { PG8_MMA(1, 0, At, B0); PG8_MMA(1, 1, At, B1); } PG8_BAR; PG8_SCHED;
            PG8_LDB(B0, 1, 0); PG8_LDB(B1, 1, 1); PG8_SCHED; PG8_LDA(At, 1, 0); PG8_STAGE(PG8_SA(0, 1), rsA, a2 + hstepA, voffA);
            PG8_WAIT_V(8); PG8_WAIT_L(0); PG8_BAR; PG8_MMA(0, 0, At, B0); PG8_MMA(0, 1, At, B1); PG8_BAR; PG8_SCHED;
            PG8_LDA(At, 1, 1); PG8_STAGE(PG8_SB(1, 0), rsB, b3, voffB); PG8_STAGE(PG8_SB(1, 1), rsB, b3 + hstepB, voffB); PG8_STAGE(PG8_SA(1, 0), rsA, a3, voffA);
            PG8_WAIT_V(8); PG8_WAIT_L(0); PG8_BAR; if (cur.nai == 2) { PG8_MMA(1, 0, At, B0); PG8_MMA(1, 1, At, B1); } PG8_BAR; PG8_SCHED;
        }
        if (wr == 0) PG8_BAR;
        { int lnE = lane_id(); asm volatile("" : "+v"(lnE)); int frE = lnE & 15, fqE = lnE >> 4, wrE = wr, wcE = wc; asm volatile("" : "+s"(wrE), "+s"(wcE));
          E(acc, cur, wrE, wcE, frE, fqE); }
        if (!has_next) break;
#pragma unroll
        for (int a = 0; a < 2; ++a)
#pragma unroll
            for (int b = 0; b < 2; ++b)
#pragma unroll
                for (int m = 0; m < 4; ++m)
#pragma unroll
                    for (int n = 0; n < 2; ++n) acc[a][b][m][n] = (f32x4){0.f, 0.f, 0.f, 0.f};
        cur = nxt; cA = nA; cB = nB; ++ui;
        if (wr == 1) PG8_BAR;
    }
    PG8_WAIT_V(0);
    PG8_BAR;
#undef PG8_UA
#undef PG8_UB
#undef PG8_SA
#undef PG8_SB
#undef PG8_STAGE
#undef PG8_LDA
#undef PG8_LDB
#undef PG8_MMA
#undef PG8_WAIT_V
#undef PG8_WAIT_L
#undef PG8_BAR
#undef PG8_SCHED
}
}

typedef f32x4 Acc[2][2][4][2];

__device__ __forceinline__ void load_rstd(float (&rs)[2][4], const float* ssp, int row0, int fr, int fq) {
#pragma unroll
    for (int ai = 0; ai < 2; ++ai)
#pragma unroll
        for (int m = 0; m < 4; ++m) {
            const f32x4 p = *(const f32x4*)(ssp + (size_t)(row0 + ai * 128 + m * 16) * 16 + fq * 4);
            float s = (p.x + p.y) + (p.z + p.w);
            s = add_x16(s); s = add_x32(s, XL32(fr, fq));
            rs[ai][m] = __builtin_amdgcn_rsqf(s * (1.0f / D) + EPS);
        }
}

struct EpiA1 {
    bf16_t* UPRE; bf16_t* G; const float* bias; const float* ssp;
    __device__ __forceinline__ void operator()(const Acc& acc, const pg8::Unit& u, int wr, int wc, int fr, int fq) const {
        const int row0 = u.pm * 256 + wr * 64 + fr;
        float rs[2][4]; load_rstd(rs, ssp, row0, fr, fq);
        const bool isg = u.pn >= 4; bf16_t* out = isg ? G : UPRE;
        const int oc0 = (u.pn & 3) * 256 + wc * 32 + 8 * fq, bc0 = u.pn * 256 + wc * 32 + 8 * fq;
        f32x4 bv[2][2];
#pragma unroll
        for (int bj = 0; bj < 2; ++bj)
#pragma unroll
            for (int n = 0; n < 2; ++n) bv[bj][n] = *(const f32x4*)(bias + bc0 + bj * 128 + 4 * n);
#pragma unroll
        for (int ai = 0; ai < 2; ++ai)
#pragma unroll
            for (int m = 0; m < 4; ++m) { bf16_t* rowp = out + (size_t)(row0 + ai * 128 + m * 16) * D + oc0; const float r = rs[ai][m];
#pragma unroll
                for (int bj = 0; bj < 2; ++bj) { f32x4 v0 = acc[ai][bj][m][0] * r + bv[bj][0], v1 = acc[ai][bj][m][1] * r + bv[bj][1];
                    if (isg) { v0 = (f32x4){gelu_t(v0[0]), gelu_t(v0[1]), gelu_t(v0[2]), gelu_t(v0[3])}; v1 = (f32x4){gelu_t(v1[0]), gelu_t(v1[1]), gelu_t(v1[2]), gelu_t(v1[3])}; }
                    u32x4 w; w.x = cvt_pk_bf16(v0[0], v0[1]); w.y = cvt_pk_bf16(v0[2], v0[3]); w.z = cvt_pk_bf16(v1[0], v1[1]); w.w = cvt_pk_bf16(v1[2], v1[3]);
                    *(u32x4*)(rowp + bj * 128) = w; } }
    }
};

struct EpiA2 {
    const bf16_t* U; h16* EB; const float* br; const float* bi; const float* la8;
    __device__ __forceinline__ void operator()(const Acc& acc, const pg8::Unit& u, int wr, int wc, int fr, int fq) const {
        const int row0 = u.pm * 256 + wr * 64 + fr, d = u.pn >> 3, q = u.pn & 7, c0 = q * 128 + wc * 32 + 4 * fq;
        h16* Ed = EB + (size_t)d * T * D * 2;
        u32x2 uw[2][4][2];
#pragma unroll
        for (int ai = 0; ai < 2; ++ai)
#pragma unroll
            for (int m = 0; m < 4; ++m)
#pragma unroll
                for (int n = 0; n < 2; ++n) uw[ai][m][n] = *(const u32x2*)(U + (size_t)(row0 + ai * 128 + m * 16) * D + c0 + 16 * n);
        f32x4 brv2[2], biv2[2], lav2[2];
#pragma unroll
        for (int n = 0; n < 2; ++n) { brv2[n] = *(const f32x4*)(br + d * D + c0 + 16 * n); biv2[n] = *(const f32x4*)(bi + d * D + c0 + 16 * n); lav2[n] = *(const f32x4*)(la8 + d * D + c0 + 16 * n); }
#pragma unroll
        for (int ai = 0; ai < 2; ++ai)
#pragma unroll
            for (int m = 0; m < 4; ++m)
#pragma unroll
                for (int n = 0; n < 2; ++n) { const size_t off = (size_t)(row0 + ai * 128 + m * 16) * D + c0 + 16 * n;
                    const f32x4 uu = bf4_to_f4(uw[ai][m][n]); const f32x4 brv = brv2[n], biv = biv2[n], lav = lav2[n];
                    unsigned w[4];
#pragma unroll
                    for (int j = 0; j < 4; ++j) { const float r = sigm(acc[ai][0][m][n][j] + brv[j]), ig = sigm(acc[ai][1][m][n][j] + biv[j]);
                        const float a = __builtin_amdgcn_exp2f(r * lav[j]), e = 1.0f - a; w[j] = pk_h2(e, __builtin_amdgcn_sqrtf(e * (1.0f + a)) * ig * uu[j]); }
                    *(u32x4*)(Ed + off * 2) = (u32x4){w[0], w[1], w[2], w[3]}; }
    }
};

struct EpiRes {
    bf16_t* xres; bf16_t* xb; const float* gate; const float* ng; const float* sc; float* sspo;
    __device__ __forceinline__ void operator()(const Acc& acc, const pg8::Unit& u, int wr, int wc, int fr, int fq) const {
        const int row0 = u.pm * 256 + wr * 64 + fr, c0 = u.pn * 256 + wc * 32 + 8 * fq;
        f32x4 gv[2][2], gs[2][2];
#pragma unroll
        for (int bj = 0; bj < 2; ++bj)
#pragma unroll
            for (int n = 0; n < 2; ++n) { gv[bj][n] = *(const f32x4*)(gate + c0 + bj * 128 + 4 * n);
                if (ng) { const f32x4 a = *(const f32x4*)(ng + c0 + bj * 128 + 4 * n), b = *(const f32x4*)(sc + c0 + bj * 128 + 4 * n); gs[bj][n] = a * (b + 1.0f); } else gs[bj][n] = (f32x4){0.f, 0.f, 0.f, 0.f}; }
#pragma unroll
        for (int ai = 0; ai < 2; ++ai) {
            u32x4 xo[1][4][2];
#pragma unroll
            for (int m = 0; m < 4; ++m)
#pragma unroll
                for (int bj = 0; bj < 2; ++bj) xo[0][m][bj] = *(const u32x4*)(xres + (size_t)(row0 + ai * 128 + m * 16) * D + c0 + bj * 128);
#pragma unroll
            for (int m = 0; m < 4; ++m) { const int row = row0 + ai * 128 + m * 16; const size_t off = (size_t)row * D + c0; float ss = 0.f;
#pragma unroll
                for (int bj = 0; bj < 2; ++bj) { const u32x4 w0 = xo[0][m][bj];
                    const f32x4 o0 = (f32x4){bf2f(w0.x & 0xffffu), bf2f(w0.x >> 16), bf2f(w0.y & 0xffffu), bf2f(w0.y >> 16)}, o1 = (f32x4){bf2f(w0.z & 0xffffu), bf2f(w0.z >> 16), bf2f(w0.w & 0xffffu), bf2f(w0.w >> 16)};
                    const f32x4 x0 = o0 + gv[bj][0] * acc[ai][bj][m][0], x1 = o1 + gv[bj][1] * acc[ai][bj][m][1];
                    u32x4 wx; wx.x = cvt_pk_bf16(x0[0], x0[1]); wx.y = cvt_pk_bf16(x0[2], x0[3]); wx.z = cvt_pk_bf16(x1[0], x1[1]); wx.w = cvt_pk_bf16(x1[2], x1[3]);
                    *(u32x4*)(xres + off + bj * 128) = wx;
                    ss += (x0[0] * x0[0] + x0[1] * x0[1]) + (x0[2] * x0[2] + x0[3] * x0[3]) + (x1[0] * x1[0] + x1[1] * x1[1]) + (x1[2] * x1[2] + x1[3] * x1[3]);
                    if (ng) { const f32x4 y0 = x0 * gs[bj][0], y1 = x1 * gs[bj][1]; u32x4 w; w.x = cvt_pk_bf16(y0[0], y0[1]); w.y = cvt_pk_bf16(y0[2], y0[3]); w.z = cvt_pk_bf16(y1[0], y1[1]); w.w = cvt_pk_bf16(y1[2], y1[3]);
                        *(u32x4*)(xb + off + bj * 128) = w; } }
                ss = add_x16(ss); ss = add_x32(ss, XL32(fr, fq));
                if (fq == 0) sspo[(size_t)row * 16 + u.pn * 4 + wc] = ss; }
        }
    }
};

struct EpiB1 {
    bf16_t* GB; bf16_t* Z; const float* bias; const float* ssp;
    __device__ __forceinline__ void operator()(const Acc& acc, const pg8::Unit& u, int wr, int wc, int fr, int fq) const {
        const int row0 = u.pm * 256 + wr * 64 + fr;
        float rs[2][4]; load_rstd(rs, ssp, row0, fr, fq);
        const int bc0 = u.pn * 256 + wc * 32 + 8 * fq;
        f32x4 bv[2][2];
#pragma unroll
        for (int bj = 0; bj < 2; ++bj)
#pragma unroll
            for (int n = 0; n < 2; ++n) bv[bj][n] = *(const f32x4*)(bias + bc0 + bj * 128 + 4 * n);
        if (u.pn < 4) {
#pragma unroll
            for (int ai = 0; ai < 2; ++ai)
#pragma unroll
                for (int m = 0; m < 4; ++m) { bf16_t* rowp = GB + (size_t)(row0 + ai * 128 + m * 16) * D + bc0; const float r = rs[ai][m];
#pragma unroll
                    for (int bj = 0; bj < 2; ++bj) { const f32x4 v0 = acc[ai][bj][m][0] * r + bv[bj][0], v1 = acc[ai][bj][m][1] * r + bv[bj][1];
                        u32x4 w; w.x = cvt_pk_bf16(v0[0], v0[1]); w.y = cvt_pk_bf16(v0[2], v0[3]); w.z = cvt_pk_bf16(v1[0], v1[1]); w.w = cvt_pk_bf16(v1[2], v1[3]);
                        *(u32x4*)(rowp + bj * 128) = w; } }
        } else {
            const int c0 = (u.pn - 4) * 128 + wc * 32 + 8 * fq;
#pragma unroll
            for (int ai = 0; ai < 2; ++ai)
#pragma unroll
                for (int m = 0; m < 4; ++m) { const float r = rs[ai][m];
                    const f32x4 z0 = (acc[ai][0][m][0] * r + bv[0][0]) * (acc[ai][1][m][0] * r + bv[1][0]), z1 = (acc[ai][0][m][1] * r + bv[0][1]) * (acc[ai][1][m][1] * r + bv[1][1]);
                    u32x4 w; w.x = cvt_pk_bf16(z0[0], z0[1]); w.y = cvt_pk_bf16(z0[2], z0[3]); w.z = cvt_pk_bf16(z1[0], z1[1]); w.w = cvt_pk_bf16(z1[2], z1[3]);
                    *(u32x4*)(Z + (size_t)(row0 + ai * 128 + m * 16) * D + c0) = w; }
        }
    }
};

struct EpiF1 {
    bf16_t* Y; const float* bias; const float* ssp; const float* cw; const float* cb;
    __device__ __forceinline__ void operator()(const Acc& acc, const pg8::Unit& u, int wr, int wc, int fr, int fq) const {
        const int row0 = u.pm * 256 + u.hrow + wr * 64 + fr;
        const int bc0 = u.pn * 256 + wc * 32 + 8 * fq, c0 = u.pn * 128 + wc * 32 + 8 * fq;
        f32x4 bg[2], bvv[2], w0[2], w1[2], w2[2], cbv[2];
#pragma unroll
        for (int n = 0; n < 2; ++n) { bg[n] = *(const f32x4*)(bias + bc0 + 4 * n); bvv[n] = *(const f32x4*)(bias + bc0 + 128 + 4 * n);
            w0[n] = *(const f32x4*)(cw + c0 + 4 * n); w1[n] = *(const f32x4*)(cw + DFF + c0 + 4 * n); w2[n] = *(const f32x4*)(cw + 2 * DFF + c0 + 4 * n); cbv[n] = *(const f32x4*)(cb + c0 + 4 * n); }
        float rs[2][4]; load_rstd(rs, ssp, row0, fr, fq);
        const bool first = (fr == 0), lastl = (fr == 15);
#pragma unroll
        for (int ai = 0; ai < 2; ++ai) {
            if (ai >= u.nai) break;
            unsigned pk0[4][2];
#pragma unroll
            for (int n = 0; n < 2; ++n) {
                f32x4 gq[4];
#pragma unroll
                for (int m = 0; m < 4; ++m) gq[m] = acc[ai][0][m][n] * rs[ai][m] + bg[n];
#pragma unroll
                for (int m = 0; m < 4; ++m) {
#define ROR1V(v) ((f32x4){dpp_ror1((v)[0]), dpp_ror1((v)[1]), dpp_ror1((v)[2]), dpp_ror1((v)[3])})
#define ROR15V(v) ((f32x4){dpp_ror15((v)[0]), dpp_ror15((v)[1]), dpp_ror15((v)[2]), dpp_ror15((v)[3])})
                    const f32x4 ls = ROR1V(gq[m]), rsm = ROR15V(gq[m]);
                    f32x4 lf, rt;
                    if (m == 0) lf = first ? (f32x4){0.f, 0.f, 0.f, 0.f} : ls; else { const f32x4 lp = ROR1V(gq[m > 0 ? m - 1 : 0]); lf = first ? lp : ls; }
                    if (m == 3) rt = lastl ? (f32x4){0.f, 0.f, 0.f, 0.f} : rsm; else { const f32x4 rn = ROR15V(gq[m < 3 ? m + 1 : 3]); rt = lastl ? rn : rsm; }
                    const f32x4 gc = cbv[n] + w0[n] * lf + w1[n] * gq[m] + w2[n] * rt;
                    const f32x4 vv = acc[ai][1][m][n] * rs[ai][m] + bvv[n];
                    const f32x4 y = (f32x4){silu_f(gc[0]) * vv[0], silu_f(gc[1]) * vv[1], silu_f(gc[2]) * vv[2], silu_f(gc[3]) * vv[3]};
                    const unsigned p0 = cvt_pk_bf16(y[0], y[1]), p1 = cvt_pk_bf16(y[2], y[3]);
                    if (n == 0) { pk0[m][0] = p0; pk0[m][1] = p1; }
                    else *(u32x4*)(Y + (size_t)(row0 + ai * 128 + m * 16) * DFF + c0) = (u32x4){pk0[m][0], pk0[m][1], p0, p1}; }
            }
        }
    }
};

#define XB_TMO      128
#define XB_XCNT(j)  (256  + 64 * (j))
#define XB_XSUB(j)  (1280 + 64 * (j))
#define XB_XGEN(j)  (2304 + 64 * (j))
#define XB_TOP      3328
#define XB_TOPGEN   3392
#define XCD_BAR_WORDS 3456
#define XB_SPIN_CAP (1u << 18)
__device__ __forceinline__ unsigned xb_ld(unsigned* p)              { return __hip_atomic_load(p, __ATOMIC_RELAXED, __HIP_MEMORY_SCOPE_AGENT); }
__device__ __forceinline__ unsigned xb_add(unsigned* p, unsigned v) { return __hip_atomic_fetch_add(p, v, __ATOMIC_RELAXED, __HIP_MEMORY_SCOPE_AGENT); }
__device__ __forceinline__ unsigned xb_xcc_id() { return (unsigned)__builtin_amdgcn_s_getreg((3 << 11) | 20) & 0xFu; }
#define XB_SPIN(cond, bar) do { unsigned _sp = 0; while (cond) { __builtin_amdgcn_s_sleep(1); \
    if ((++_sp & 255u) == 0u) { if (xb_ld(&(bar)[XB_TMO])) break; if (_sp > XB_SPIN_CAP) { atomicAdd(&(bar)[XB_TMO], 1u); break; } } } } while (0)
struct XcdBarrier { unsigned* bar; unsigned x; volatile LAS unsigned* st; };
__device__ __forceinline__ XcdBarrier xcd_barrier_post(unsigned* bar, volatile LAS unsigned* st) {
    XcdBarrier b; b.bar = bar; b.x = xb_xcc_id(); b.st = st;
    if (threadIdx.x == 0) (void)xb_add(&bar[XB_XCNT(b.x)], 1u);
    return b;
}
__device__ __forceinline__ void xcd_barrier_complete(unsigned* bar, unsigned x, unsigned& nloc, unsigned& nx) {
    const unsigned G = gridDim.x * gridDim.y * gridDim.z;
    unsigned sum, cnt, mine, sp = 0u;
    for (;;) {
        sum = 0u; cnt = 0u; mine = 0u;
#pragma unroll
        for (unsigned j = 0; j < 16; ++j) { const unsigned c = xb_ld(&bar[XB_XCNT(j)]); sum += c; cnt += (c > 0u) ? 1u : 0u; mine = (j == x) ? c : mine; }
        if (sum == G) break;
        __builtin_amdgcn_s_sleep(1);
        if ((++sp & 255u) == 0u) { if (xb_ld(&bar[XB_TMO])) break; if (sp > XB_SPIN_CAP) { atomicAdd(&bar[XB_TMO], 1u); break; } }
    }
    nloc = mine > 0u ? mine : 1u; nx = cnt > 0u ? cnt : 1u;
}
__device__ __forceinline__ void xcd_barrier(const XcdBarrier& b) {
    asm volatile("s_waitcnt vmcnt(0)" ::: "memory");
    __syncthreads();
    if (threadIdx.x == 0) {
        unsigned* bar = b.bar;
        __builtin_amdgcn_s_waitcnt(0);
        unsigned nloc = b.st[0], nx = b.st[1];
        if (nloc == 0u) { xcd_barrier_complete(bar, b.x, nloc, nx); b.st[0] = nloc; b.st[1] = nx; }
        const unsigned old = xb_add(&bar[XB_XSUB(b.x)], 1u);
        const unsigned gen = old / nloc;
        if (old + 1u == (gen + 1u) * nloc) {
            __builtin_amdgcn_fence(__ATOMIC_RELEASE, "agent");
            asm volatile("s_waitcnt vmcnt(0)" ::: "memory");
            const unsigned og = xb_add(&bar[XB_TOP], 1u);
            const unsigned tg = og / nx;
            if (og + 1u == (tg + 1u) * nx) xb_add(&bar[XB_TOPGEN], 1u);
            else XB_SPIN(xb_ld(&bar[XB_TOPGEN]) == tg, bar);
            __builtin_amdgcn_fence(__ATOMIC_ACQUIRE, "agent");
            xb_add(&bar[XB_XGEN(b.x)], 1u);
            asm volatile("s_waitcnt vmcnt(0)" ::: "memory");
        } else {
            XB_SPIN(xb_ld(&bar[XB_XGEN(b.x)]) == gen, bar);
            __builtin_amdgcn_fence(__ATOMIC_ACQUIRE, "agent");
            asm volatile("s_waitcnt vmcnt(0)" ::: "memory");
        }
    }
    __syncthreads();
}

struct Args { const float* in[N_IN]; float* out; unsigned char* ws; int ph_lo, ph_hi; };
struct Ctx {
    const float* const* in; float* out; unsigned char* ws; LAS unsigned char* lds;
    int tid, lane, wave, G, bid;
};
#define WSP(type, off) ((type*)(C.ws + (off)))
#define INP(i) (C.in[i])
#define LDS_WAIT() asm volatile("s_waitcnt lgkmcnt(0)" ::: "memory")

__device__ __forceinline__ void p0_adaln(const Ctx& C, int item) {
    LAS float* sv = (LAS float*)C.lds;
    LAS float* red = (LAS float*)(C.lds + 8192);
    const int l = item / 48, cbk = item % 48;
    for (int i = C.tid; i < 2048; i += 512) { const float v = i < 1024 ? INP(IX_C)[i] : INP(IX_CCTX)[i - 1024]; sv[i] = silu_f(v); }
    __syncthreads();
    const float* W = INP(IX_ADAW) + (size_t)l * D * NMOD + cbk * 128 + 2 * C.lane;
    const int k0 = C.wave * 128;
    f32x2 a0 = {0.f, 0.f}, a1 = {0.f, 0.f};
#pragma unroll 16
    for (int k = 0; k < 128; ++k) { const f32x2 w = *(const f32x2*)(W + (size_t)(k0 + k) * NMOD); const float s0 = sv[k0 + k], s1 = sv[1024 + k0 + k]; a0 += w * s0; a1 += w * s1; }
    red[(C.wave * 2 + 0) * 128 + 2 * C.lane] = a0.x; red[(C.wave * 2 + 0) * 128 + 2 * C.lane + 1] = a0.y;
    red[(C.wave * 2 + 1) * 128 + 2 * C.lane] = a1.x; red[(C.wave * 2 + 1) * 128 + 2 * C.lane + 1] = a1.y;
    __syncthreads();
    if (C.tid < 256) { const int s = C.tid >> 7, c = C.tid & 127; float v = INP(IX_ADAB)[l * NMOD + cbk * 128 + c];
#pragma unroll
        for (int w = 0; w < 8; ++w) v += red[(w * 2 + s) * 128 + c];
        WSP(float, WS_MODS)[(size_t)(l * 2 + s) * NMOD + cbk * 128 + c] = v; }
    __syncthreads();
}
struct WBlk { const float* src; int ld, c0, K; bf16_t* dst; };
__device__ __forceinline__ WBlk get_wblk(const Ctx& C, int cls, int vb) {
    WBlk w;
    if (cls == 0) {
        w.K = 1024;
        if (vb < 48) { const int j = vb / 24, r = vb % 24;
            if (r < 16) { w.src = (r < 8 ? INP(IX_AWX) : INP(IX_AWG)) + (size_t)j * D * D; w.ld = D; w.c0 = (r & 7) * 128; w.dst = WSP(bf16_t, W_A1 + j * SZ_A1) + (size_t)r * 128 * 1024; }
            else { const int rr = r - 16; w.src = INP(IX_AWO) + (size_t)j * D * D; w.ld = D; w.c0 = rr * 128; w.dst = WSP(bf16_t, W_A3 + j * SZ_A3) + (size_t)rr * 128 * 1024; }
        } else if (vb < 112) { const int bb = vb - 48, j = bb / 32, r = bb % 32;
            if (r < 24) { int c0; if (r < 8) c0 = r * 128; else { const int rr = r - 8; c0 = 1024 + (rr & 1) * 1024 + (rr >> 1) * 128; }
                w.src = INP(IX_BWIN) + (size_t)j * D * 3072; w.ld = 3072; w.c0 = c0; w.dst = WSP(bf16_t, W_B1 + j * SZ_B1) + (size_t)r * 128 * 1024; }
            else { const int rr = r - 24; w.src = INP(IX_BWO) + (size_t)j * D * D; w.ld = D; w.c0 = rr * 128; w.dst = WSP(bf16_t, W_B2 + j * SZ_B2) + (size_t)rr * 128 * 1024; }
        } else { const int bb = vb - 112, l = bb / 44, r = bb % 44;
            w.src = INP(IX_FWU) + (size_t)l * D * 2 * DFF; w.ld = 2 * DFF; w.c0 = (r & 1) * DFF + (r >> 1) * 128; w.dst = WSP(bf16_t, W_F1 + l * SZ_F1) + (size_t)r * 128 * 1024; }
    } else if (cls == 1) {
        const int j = vb / 32, rr = vb % 32, pn = rr >> 1, mem = rr & 1, d = pn >> 3, q = pn & 7, h = q >> 1, half = q & 1;
        w.K = 256; w.src = (mem ? INP(IX_AWI) : INP(IX_AWR)) + (size_t)(((j * 2 + d) * 4 + h)) * 65536; w.ld = 256; w.c0 = half * 128;
        w.dst = WSP(bf16_t, W_A2 + j * SZ_A2) + (size_t)(pn * 256 + mem * 128) * 256;
    } else {
        const int l = vb / 8, rr = vb % 8;
        w.K = DFF; w.src = INP(IX_FWD) + (size_t)l * DFF * D; w.ld = D; w.c0 = rr * 128; w.dst = WSP(bf16_t, W_F2 + l * SZ_F2) + (size_t)rr * 128 * DFF;
    }
    return w;
}
__device__ __forceinline__ void p0_transpose(const WBlk& w, int rg, int kb, LAS float* scr, int lane) {
    const int k0 = 64 * kb, n0 = 32 * rg;
    { const int r8 = lane >> 3, c4 = lane & 7; f32x4 v[8];
#pragma unroll
        for (int i = 0; i < 8; ++i) v[i] = *(const f32x4*)(w.src + (size_t)(k0 + 8 * i + r8) * w.ld + w.c0 + n0 + 4 * c4);
#pragma unroll
        for (int i = 0; i < 8; ++i) { LAS float* d = scr + (8 * i + r8) * 33 + 4 * c4; d[0] = v[i].x; d[1] = v[i].y; d[2] = v[i].z; d[3] = v[i].w; } }
    LDS_WAIT(); asm volatile("" ::: "memory");
    const int c = lane & 7;
#pragma unroll
    for (int j = 0; j < 4; ++j) { const int n = (lane >> 3) + 8 * j; const LAS float* s = scr + (8 * c) * 33 + n;
        u32x4 o; o.x = cvt_pk_bf16(s[0 * 33], s[1 * 33]); o.y = cvt_pk_bf16(s[2 * 33], s[3 * 33]); o.z = cvt_pk_bf16(s[4 * 33], s[5 * 33]); o.w = cvt_pk_bf16(s[6 * 33], s[7 * 33]);
        *(u32x4*)(w.dst + (size_t)(n0 + n) * w.K + k0 + 8 * c) = o; }
    LDS_WAIT(); asm volatile("" ::: "memory");
}
__device__ __forceinline__ void phase_p0(const Ctx& C) {
    for (int it = C.bid; it < 192; it += C.G) p0_adaln(C, it);
    LAS float* scr = (LAS float*)(C.lds + C.wave * 16384);
    const int gw = C.bid * 8 + C.wave, NGW = C.G * 8;
    constexpr int N0 = 288 * 16, N1 = 64 * 4, N2 = 32 * 44;
    for (int it = gw; it < N0 + N1 + N2; it += NGW) {
        int cls, vb, rg, kc;
        if (it < N0) { cls = 0; vb = it >> 4; rg = (it >> 2) & 3; kc = it & 3; }
        else if (it < N0 + N1) { const int r = it - N0; cls = 1; vb = r >> 2; rg = r & 3; kc = 0; }
        else { const int r = it - N0 - N1; cls = 2; vb = r / 44; const int rem = r % 44; rg = rem / 11; kc = rem % 11; }
        const WBlk w = get_wblk(C, cls, vb);
        for (int kb = 4 * kc; kb < 4 * kc + 4; ++kb) p0_transpose(w, rg, kb, scr, C.lane);
    }
}

__device__ __forceinline__ size_t cf_off(int t, int c, int K) { return ((size_t)((t >> 4) * (K >> 5) + (c >> 5)) << 9) + (size_t)((((c >> 3) & 3) << 4) + (t & 15)) * 8 + (c & 7); }
__device__ __forceinline__ void p1_rows4(const float* __restrict__ xbase, bf16_t* __restrict__ obase, bf16_t* __restrict__ rbase, float* __restrict__ ssbase, int nss, const f32x4 (&gs)[4], int r0, int lane, bool frag) {
    f32x4 v[4][4];
#pragma unroll
    for (int q = 0; q < 4; ++q)
#pragma unroll
        for (int j = 0; j < 4; ++j) v[q][j] = ((const f32x4*)(xbase + (size_t)(r0 + q) * D) + lane)[64 * j];
#pragma unroll
    for (int q = 0; q < 4; ++q) { float s = 0.f;
#pragma unroll
        for (int j = 0; j < 4; ++j) s += (v[q][j].x * v[q][j].x + v[q][j].y * v[q][j].y) + (v[q][j].z * v[q][j].z + v[q][j].w * v[q][j].w);
        s = wave_sum(s);
        if (lane < nss) ssbase[(size_t)(r0 + q) * nss + lane] = lane == 0 ? s : 0.f;
#pragma unroll
        for (int j = 0; j < 4; ++j) { const f32x4 y = v[q][j] * gs[j]; u32x2 w; w.x = cvt_pk_bf16(y.x, y.y); w.y = cvt_pk_bf16(y.z, y.w); *(u32x2*)(obase + (frag ? cf_off(r0 + q, 4 * lane + 256 * j, D) : (size_t)(r0 + q) * D + 4 * lane + 256 * j)) = w;
            if (rbase) { u32x2 r; r.x = cvt_pk_bf16(v[q][j].x, v[q][j].y); r.y = cvt_pk_bf16(v[q][j].z, v[q][j].w); ((u32x2*)(rbase + (size_t)(r0 + q) * D) + lane)[64 * j] = r; } } }
}
__device__ __forceinline__ void phase_p1(const Ctx& C) {
    const int gw = C.bid * 8 + C.wave, NGW = C.G * 8;
    const float* __restrict__ mods = WSP(float, WS_MODS);
    for (int s = 0; s < 2; ++s) {
        f32x4 gs[4];
#pragma unroll
        for (int j = 0; j < 4; ++j) gs[j] = *((const f32x4*)INP(IX_NMG) + C.lane + 64 * j) * (*((const f32x4*)(mods + (size_t)s * NMOD + 1024) + C.lane + 64 * j) + 1.0f);
        const int nrow = s ? CT : T;
        for (int r0 = gw * 4; r0 < nrow; r0 += NGW * 4)
            p1_rows4(s ? INP(IX_CTX) : INP(IX_X), s ? WSP(bf16_t, CX_XB) : WSP(bf16_t, WS_SLOT), s ? nullptr : WSP(bf16_t, WS_XRES), s ? WSP(float, CX_SSP) : WSP(float, WS_SSP), s ? 64 : 16, gs, r0, C.lane, s != 0);
    }
    for (int rb = gw; rb < 2048; rb += NGW) {
        const int r = rb * 16; const bf16_t* __restrict__ bt; int l, shoff; float* __restrict__ outp; int ostride;
        if (r < 4096) { const int j = r / 2048, n = r % 2048; bt = WSP(bf16_t, W_A1 + j * SZ_A1) + (size_t)n * 1024; l = 2 * j; shoff = 0; outp = WSP(float, WS_BIASM) + (size_t)(l * 2) * 3072 + n; ostride = 3072; }
        else if (r < 10240) { const int rr = r - 4096, j = rr / 3072, n = rr % 3072; bt = WSP(bf16_t, W_B1 + j * SZ_B1) + (size_t)n * 1024; l = 2 * j + 1; shoff = 0; outp = WSP(float, WS_BIASM) + (size_t)(l * 2) * 3072 + n; ostride = 3072; }
        else { const int rr = r - 10240; l = rr / 5632; const int n = rr % 5632; bt = WSP(bf16_t, W_F1 + l * SZ_F1) + (size_t)n * 1024; shoff = 3072; outp = WSP(float, WS_BIASF) + (size_t)(l * 2) * 5632 + n; ostride = 5632; }
        f32x4 sh[2][2][2];
#pragma unroll
        for (int st = 0; st < 2; ++st)
#pragma unroll
            for (int h = 0; h < 2; ++h) { const float* p = mods + (size_t)(l * 2 + st) * NMOD + shoff + h * 512 + 8 * C.lane; sh[st][h][0] = *(const f32x4*)p; sh[st][h][1] = *(const f32x4*)(p + 4); }
#pragma unroll 1
        for (int b4 = 0; b4 < 4; ++b4) {
            u32x4 wv[4][2];
#pragma unroll
            for (int q = 0; q < 4; ++q)
#pragma unroll
                for (int h = 0; h < 2; ++h) wv[q][h] = *(const u32x4*)(bt + (size_t)(b4 * 4 + q) * 1024 + h * 512 + 8 * C.lane);
#pragma unroll
            for (int q = 0; q < 4; ++q) { float a0 = 0.f, a1 = 0.f;
#pragma unroll
                for (int h = 0; h < 2; ++h) { const u32x4 w = wv[q][h];
                    const f32x4 lo = (f32x4){bf2f(w.x & 0xffffu), bf2f(w.x >> 16), bf2f(w.y & 0xffffu), bf2f(w.y >> 16)}, hi = (f32x4){bf2f(w.z & 0xffffu), bf2f(w.z >> 16), bf2f(w.w & 0xffffu), bf2f(w.w >> 16)};
                    const f32x4 p0 = lo * sh[0][h][0] + hi * sh[0][h][1], p1 = lo * sh[1][h][0] + hi * sh[1][h][1];
                    a0 += (p0.x + p0.y) + (p0.z + p0.w); a1 += (p1.x + p1.y) + (p1.z + p1.w); }
                a0 = wave_sum(a0); a1 = wave_sum(a1);
                if (C.lane == 0) { outp[b4 * 4 + q] = a0; outp[ostride + b4 * 4 + q] = a1; } }
        }
    }
    for (int i = C.bid * 512 + C.tid; i < 4096; i += C.G * 512) { const float x = INP(IX_ALAM)[i]; const float ls = fminf(x, 0.f) - log1pf(expf(-fabsf(x))); WSP(float, WS_LA8)[i] = 8.0f * 1.4426950409f * ls; }
}

__device__ __forceinline__ void phase_conv4(const Ctx& C, const bf16_t* __restrict__ UPRE, bf16_t* __restrict__ U, const float* __restrict__ cw, const float* __restrict__ cb) {
    const int cg = C.tid & 127, sub = C.tid >> 7, c0 = cg * 8;
    float w[4][8], b[8];
#pragma unroll
    for (int k = 0; k < 4; ++k)
#pragma unroll
        for (int e = 0; e < 8; ++e) w[k][e] = cw[k * D + c0 + e];
#pragma unroll
    for (int e = 0; e < 8; ++e) b[e] = cb[c0 + e];
    for (int it = C.bid; it < T / 64; it += C.G) {
        const int t0 = it * 64 + sub * 16;
        float win[3][8];
#pragma unroll
        for (int r = 0; r < 3; ++r) { const int t = t0 - 2 + r; u32x4 v = *(const u32x4*)(UPRE + (size_t)(t >= 0 ? t : 0) * D + c0); if (t < 0) v = (u32x4){0u, 0u, 0u, 0u};
            win[r][0] = bf2f(v.x & 0xffffu); win[r][1] = bf2f(v.x >> 16); win[r][2] = bf2f(v.y & 0xffffu); win[r][3] = bf2f(v.y >> 16); win[r][4] = bf2f(v.z & 0xffffu); win[r][5] = bf2f(v.z >> 16); win[r][6] = bf2f(v.w & 0xffffu); win[r][7] = bf2f(v.w >> 16); }
#pragma unroll
        for (int i = 0; i < 16; ++i) { const int t = t0 + i; u32x4 v = *(const u32x4*)(UPRE + (size_t)(t + 1 < T ? t + 1 : T - 1) * D + c0); if (t + 1 >= T) v = (u32x4){0u, 0u, 0u, 0u};
            const float nx[8] = {bf2f(v.x & 0xffffu), bf2f(v.x >> 16), bf2f(v.y & 0xffffu), bf2f(v.y >> 16), bf2f(v.z & 0xffffu), bf2f(v.z >> 16), bf2f(v.w & 0xffffu), bf2f(v.w >> 16)};
            float o[8];
#pragma unroll
            for (int e = 0; e < 8; ++e) { o[e] = b[e] + w[0][e] * win[0][e] + w[1][e] * win[1][e] + w[2][e] * win[2][e] + w[3][e] * nx[e]; win[0][e] = win[1][e]; win[1][e] = win[2][e]; win[2][e] = nx[e]; }
            u32x4 ow; ow.x = cvt_pk_bf16(o[0], o[1]); ow.y = cvt_pk_bf16(o[2], o[3]); ow.z = cvt_pk_bf16(o[4], o[5]); ow.w = cvt_pk_bf16(o[6], o[7]);
            *(u32x4*)(U + (size_t)t * D + c0) = ow; }
    }
}
__device__ __forceinline__ void phase_vconv(const Ctx& C, const bf16_t* __restrict__ GB, const bf16_t* __restrict__ Z, bf16_t* __restrict__ Q, const float* __restrict__ cw, const float* __restrict__ cb) {
    const int cg = C.tid & 127, sub = C.tid >> 7, c0 = cg * 8;
    float w[3][8], b[8];
#pragma unroll
    for (int k = 0; k < 3; ++k)
#pragma unroll
        for (int e = 0; e < 8; ++e) w[k][e] = cw[k * D + c0 + e];
#pragma unroll
    for (int e = 0; e < 8; ++e) b[e] = cb[c0 + e];
    const int vb = (C.G & 7) == 0 ? (C.bid & 7) * (C.G >> 3) + (C.bid >> 3) : C.bid;
    for (int it = vb; it < T / 64; it += C.G) {
        const int t0 = it * 64 + sub * 16;
        const bool lo_ok = it > 0, hi_ok = it < T / 64 - 1;
        const long om = lo_ok ? -(long)64 * D : 0, op = hi_ok ? (long)64 * D : 0; const float ml = lo_ok ? 1.f : 0.f, mh = hi_ok ? 1.f : 0.f;
#pragma unroll 8
        for (int i = 0; i < 16; ++i) { const int t = t0 + i; const size_t off = (size_t)t * D + c0;
            const u32x4 g = *(const u32x4*)(GB + off), z1 = *(const u32x4*)(Z + off);
            const u32x4 z0 = *(const u32x4*)(Z + (long)off + om), z2 = *(const u32x4*)(Z + (long)off + op);
            const unsigned gw[4] = {g.x, g.y, g.z, g.w}, a0[4] = {z0.x, z0.y, z0.z, z0.w}, a1[4] = {z1.x, z1.y, z1.z, z1.w}, a2[4] = {z2.x, z2.y, z2.z, z2.w};
            unsigned ow[4];
#pragma unroll
            for (int p = 0; p < 4; ++p) {
                const float lo = bf2f(gw[p] & 0xffffu) * (b[2 * p] + ml * w[0][2 * p] * bf2f(a0[p] & 0xffffu) + w[1][2 * p] * bf2f(a1[p] & 0xffffu) + mh * w[2][2 * p] * bf2f(a2[p] & 0xffffu));
                const float hi = bf2f(gw[p] >> 16) * (b[2 * p + 1] + ml * w[0][2 * p + 1] * bf2f(a0[p] >> 16) + w[1][2 * p + 1] * bf2f(a1[p] >> 16) + mh * w[2][2 * p + 1] * bf2f(a2[p] >> 16));
                ow[p] = cvt_pk_bf16(lo, hi); }
            *(u32x4*)(Q + off) = (u32x4){ow[0], ow[1], ow[2], ow[3]}; }
    }
}

typedef _Float16 h16x8 __attribute__((ext_vector_type(8)));
__device__ __forceinline__ void eb_unpack(u32x4 w, f32x4& a, f32x4& b) {
    const h16x8 h = __builtin_bit_cast(h16x8, w);
    a = (f32x4){1.0f - (float)h[0], 1.0f - (float)h[2], 1.0f - (float)h[4], 1.0f - (float)h[6]}; b = (f32x4){(float)h[1], (float)h[3], (float)h[5], (float)h[7]};
}
__device__ __forceinline__ void phase_scan1(const Ctx& C, const h16* __restrict__ EB) {
    LAS float* lagg = (LAS float*)C.lds;
    for (int task = C.bid; task < 256; task += C.G) {
        const int j = task >> 2, cbk = task & 3, ch = cbk * 256 + 4 * C.lane, r0 = j * 256 + 32 * C.wave;
#pragma unroll
        for (int d = 0; d < 2; ++d) {
            const h16* e = EB + (((size_t)d * T + r0) * D + ch) * 2;
            f32x4 P = {1.f, 1.f, 1.f, 1.f}, Q = {0.f, 0.f, 0.f, 0.f};
            u32x4 ev[32];
#pragma unroll
            for (int i = 0; i < 32; ++i) ev[i] = *(const u32x4*)(e + (size_t)i * D * 2);
#pragma unroll
            for (int i = 0; i < 32; ++i) { const int ii = d ? 31 - i : i; f32x4 a, bb; eb_unpack(ev[ii], a, bb); P = P * a; Q = a * Q + bb; }
            float* ag = WSP(float, WS_AGG32) + (((size_t)d * 512 + j * 8 + C.wave) * D + ch) * 2;
            *(f32x4*)ag = (f32x4){P[0], Q[0], P[1], Q[1]}; *(f32x4*)(ag + 4) = (f32x4){P[2], Q[2], P[3], Q[3]};
            LAS float* la = lagg + ((d * 8 + C.wave) * 256 + 4 * C.lane) * 2;
            *(LAS f32x4*)la = (f32x4){P[0], Q[0], P[1], Q[1]}; *(LAS f32x4*)(la + 4) = (f32x4){P[2], Q[2], P[3], Q[3]};
        }
        __syncthreads();
        { const int d = C.tid >> 8, c = C.tid & 255; float P = 1.f, Q = 0.f;
#pragma unroll
            for (int i = 0; i < 8; ++i) { const int w = d ? 7 - i : i; const f32x2 pq = *(const LAS f32x2*)(lagg + ((d * 8 + w) * 256 + c) * 2); Q = pq.x * Q + pq.y; P *= pq.x; }
            *(f32x2*)(WSP(float, WS_AGGT) + (((size_t)d * 64 + j) * D + cbk * 256 + c) * 2) = (f32x2){P, Q}; }
        __syncthreads();
    }
}
__device__ __forceinline__ void phase_scan2(const Ctx& C, const h16* __restrict__ EB, const bf16_t* __restrict__ Gt, bf16_t* __restrict__ GS, const float* __restrict__ h0) {
    LAS float* cin = (LAS float*)(C.lds + RING_BYTES + 1024);
    LAS unsigned char* hbw = C.lds + C.wave * 16384 + 8 * C.lane;
    for (int task = C.bid; task < 256; task += C.G) {
        const int j = task >> 2, cbk = task & 3;
        const int ch = cbk * 256 + 4 * C.lane, r0 = j * 256 + 32 * C.wave;
        u32x4 ev[32];
        { const h16* e = EB + (((size_t)T + r0) * D + ch) * 2;
#pragma unroll
            for (int i = 0; i < 32; ++i) ev[i] = *(const u32x4*)(e + (size_t)i * D * 2); }
        { int tid_ = C.tid; asm volatile("" : "+v"(tid_));
            const int d = tid_ >> 8, c = tid_ & 255, chn = cbk * 256 + c; float h = h0[d * D + chn];
            const int n = d ? 63 - j : j; const float* base = WSP(float, WS_AGGT) + ((size_t)d * 64 * D + chn) * 2;
            for (int i = 0; i < n; i += 16) { f32x2 pq[16];
#pragma unroll
                for (int u = 0; u < 16; ++u) { const int ii = i + u; const int im = ii < n ? ii : n - 1; const int jj = d ? 63 - im : im; pq[u] = *(const f32x2*)(base + (size_t)jj * D * 2); if (ii >= n) pq[u] = (f32x2){1.f, 0.f}; }
#pragma unroll
                for (int u = 0; u < 16; ++u) h = pq[u].x * h + pq[u].y; }
            cin[d * 256 + c] = h; }
        __syncthreads();
        f32x4 hc[2];
#pragma unroll
        for (int d = 0; d < 2; ++d) { f32x4 h = *(const LAS f32x4*)(cin + d * 256 + 4 * C.lane); const int n = d ? 7 - C.wave : C.wave;
            f32x4 pq[7][2];
#pragma unroll
            for (int u = 0; u < 7; ++u) { const int im = u < n ? u : (n > 0 ? n - 1 : 0); const int w = d ? 7 - im : im; const float* ag = WSP(float, WS_AGG32) + (((size_t)d * 512 + j * 8 + w) * D + ch) * 2; pq[u][0] = *(const f32x4*)ag; pq[u][1] = *(const f32x4*)(ag + 4); }
#pragma unroll
            for (int u = 0; u < 7; ++u) if (u < n) { h[0] = pq[u][0][0] * h[0] + pq[u][0][1]; h[1] = pq[u][0][2] * h[1] + pq[u][0][3]; h[2] = pq[u][1][0] * h[2] + pq[u][1][1]; h[3] = pq[u][1][2] * h[3] + pq[u][1][3]; }
            hc[d] = h; }
        { f32x4 h = hc[1];
#pragma unroll
            for (int i = 31; i >= 0; --i) { f32x4 a, bb; eb_unpack(ev[i], a, bb); h = a * h + bb;
                u32x2 w; w.x = cvt_pk_bf16(h[0], h[1]); w.y = cvt_pk_bf16(h[2], h[3]); *(LAS u32x2*)(hbw + i * 512) = w; } }
        { f32x4 h = hc[0]; const h16* e = EB + ((size_t)r0 * D + ch) * 2;
#pragma unroll
            for (int hb2 = 0; hb2 < 2; ++hb2) { u32x2 gv[16];
#pragma unroll
                for (int i = 0; i < 16; ++i) { ev[i] = *(const u32x4*)(e + (size_t)(16 * hb2 + i) * D * 2); gv[i] = *(const u32x2*)(Gt + (size_t)(r0 + 16 * hb2 + i) * D + ch); }
#pragma unroll
                for (int i = 0; i < 16; ++i) { f32x4 a, bb; eb_unpack(ev[i], a, bb); h = a * h + bb;
                    const f32x4 hb = bf4_to_f4(*(const LAS u32x2*)(hbw + (16 * hb2 + i) * 512)); const f32x4 o = bf4_to_f4(gv[i]) * (h + hb);
                    u32x2 w; w.x = cvt_pk_bf16(o[0], o[1]); w.y = cvt_pk_bf16(o[2], o[3]); *(u32x2*)(GS + (size_t)(r0 + 16 * hb2 + i) * D + ch) = w; } } }
        __syncthreads();
    }
}
__device__ __forceinline__ void phase_final(const Ctx& C, const float* __restrict__ ssp) {
    const int gw = C.bid * 8 + C.wave, NGW = C.G * 8;
    const bf16_t* __restrict__ xres = WSP(bf16_t, WS_XRES); float* __restrict__ out = C.out; const float* __restrict__ fg = INP(IX_FG);
    f32x4 g[4];
#pragma unroll
    for (int j = 0; j < 4; ++j) g[j] = *((const f32x4*)fg + C.lane + 64 * j);
    for (int r0 = gw * 4; r0 < T; r0 += NGW * 4) {
        u32x2 xv[4][4]; float sv[4];
#pragma unroll
        for (int q = 0; q < 4; ++q) { { const float v_ = ssp[(size_t)(r0 + q) * 16 + (C.lane & 15)]; sv[q] = C.lane < 16 ? v_ : 0.f; }
#pragma unroll
            for (int j = 0; j < 4; ++j) xv[q][j] = ((const u32x2*)(xres + (size_t)(r0 + q) * D) + C.lane)[64 * j]; }
#pragma unroll
        for (int q = 0; q < 4; ++q) { const float rstd = 1.0f / sqrtf(wave_sum(sv[q]) * (1.0f / D) + EPS); f32x4* orow = (f32x4*)(out + (size_t)(r0 + q) * D) + C.lane;
#pragma unroll
            for (int j = 0; j < 4; ++j) orow[64 * j] = bf4_to_f4(xv[q][j]) * rstd * g[j]; }
    }
}
template <int NB, int UNR, int K>
__device__ __forceinline__ void ctx_mm(f32x4 (&acc)[2][NB], const bf16_t* A, int lda, const bf16_t* const (&Bp)[NB], int wave, int lane, int tid, LAS unsigned char* lds) {
    const int fr = lane & 15, fq = lane >> 4;
    constexpr int ROWB = K * 2 + 16, PPT = K / 256, NK = K / 32;
    const bf16_t* a0 = A + (size_t)(2 * wave) * lda * 16 + lane * 8; const bf16_t* a1 = a0 + (size_t)lda * 16;
    bf16x8 af[UNR][2];
    {   u32x4 stg[NB][PPT];
#pragma unroll
        for (int nb = 0; nb < NB; ++nb)
#pragma unroll
            for (int q = 0; q < PPT; ++q) { const int p = tid + 512 * q, r = p / (K / 8), kc = p % (K / 8); stg[nb][q] = *(const u32x4*)(Bp[nb] + (size_t)r * K + kc * 8); }
        __builtin_amdgcn_sched_barrier(0);
#pragma unroll
        for (int u = 0; u < UNR; ++u) { af[u][0] = *(const bf16x8*)(a0 + u * 512); af[u][1] = *(const bf16x8*)(a1 + u * 512); }
        __builtin_amdgcn_sched_barrier(0);
#pragma unroll
        for (int nb = 0; nb < NB; ++nb)
#pragma unroll
            for (int q = 0; q < PPT; ++q) { const int p = tid + 512 * q, r = p / (K / 8), kc = p % (K / 8); *(LAS u32x4*)(lds + (nb * 16 + r) * ROWB + kc * 16) = stg[nb][q]; } }
#pragma unroll
    for (int nb = 0; nb < NB; ++nb) { acc[0][nb] = (f32x4){0.f, 0.f, 0.f, 0.f}; acc[1][nb] = (f32x4){0.f, 0.f, 0.f, 0.f}; }
    __syncthreads();
    const LAS unsigned char* bl = lds + fr * ROWB + fq * 16;
#pragma unroll
    for (int kk = 0; kk < NK; ++kk) { constexpr int dummy = 0; (void)dummy; const int u = kk % UNR;
#pragma unroll
        for (int nb = 0; nb < NB; ++nb) { const bf16x8 bf = *(const LAS bf16x8*)(bl + nb * 16 * ROWB + kk * 64);
            acc[0][nb] = __builtin_amdgcn_mfma_f32_16x16x32_bf16(bf, af[u][0], acc[0][nb], 0, 0, 0); acc[1][nb] = __builtin_amdgcn_mfma_f32_16x16x32_bf16(bf, af[u][1], acc[1][nb], 0, 0, 0); }
        __builtin_amdgcn_sched_barrier(0);
        if (kk + UNR < NK) { af[u][0] = *(const bf16x8*)(a0 + (kk + UNR) * 512); af[u][1] = *(const bf16x8*)(a1 + (kk + UNR) * 512); }
        __builtin_amdgcn_sched_barrier(0);
    }
    __syncthreads();
}
template <int UNR, int K>
__device__ __forceinline__ void ctx_mm1(f32x4& acc, const bf16_t* A, int lda, const bf16_t* Bp, int row0, int lane, int tid, LAS unsigned char* lds) {
    const int fr = lane & 15, fq = lane >> 4;
    constexpr int ROWB = K * 2 + 16, PPT = K / 256, NK = K / 32;
    const bf16_t* a0 = A + (size_t)(row0 >> 4) * lda * 16 + lane * 8;
    bf16x8 af[UNR];
    {   u32x4 stg[PPT];
#pragma unroll
        for (int q = 0; q < PPT; ++q) { const int p = tid + 512 * q, r = p / (K / 8), kc = p % (K / 8); stg[q] = *(const u32x4*)(Bp + (size_t)r * K + kc * 8); }
        __builtin_amdgcn_sched_barrier(0);
#pragma unroll
        for (int u = 0; u < UNR; ++u) af[u] = *(const bf16x8*)(a0 + u * 512);
        __builtin_amdgcn_sched_barrier(0);
#pragma unroll
        for (int q = 0; q < PPT; ++q) { const int p = tid + 512 * q, r = p / (K / 8), kc = p % (K / 8); *(LAS u32x4*)(lds + r * ROWB + kc * 16) = stg[q]; } }
    acc = (f32x4){0.f, 0.f, 0.f, 0.f};
    __syncthreads();
    const LAS unsigned char* bl = lds + fr * ROWB + fq * 16;
#pragma unroll
    for (int kk = 0; kk < NK; ++kk) { const int u = kk % UNR;
        { const bf16x8 bf = *(const LAS bf16x8*)(bl + kk * 64); acc = __builtin_amdgcn_mfma_f32_16x16x32_bf16(bf, af[u], acc, 0, 0, 0); }
        __builtin_amdgcn_sched_barrier(0);
        if (kk + UNR < NK) af[u] = *(const bf16x8*)(a0 + (kk + UNR) * 512);
        __builtin_amdgcn_sched_barrier(0);
    }
    __syncthreads();
}
struct CtxSS { f32x4 a, b, c, d; };
__device__ __forceinline__ CtxSS ctx_ss_load(const float* sspc, int row, int fq) { const float* p = sspc + (size_t)row * 64 + fq * 16; CtxSS r; r.a = *(const f32x4*)p; r.b = *(const f32x4*)(p + 4); r.c = *(const f32x4*)(p + 8); r.d = *(const f32x4*)(p + 12); return r; }
__device__ __forceinline__ float ctx_rstd_fin(const CtxSS& v, int fr, int fq) {
    float s = ((v.a.x + v.a.y) + (v.a.z + v.a.w)) + ((v.b.x + v.b.y) + (v.b.z + v.b.w)) + ((v.c.x + v.c.y) + (v.c.z + v.c.w)) + ((v.d.x + v.d.y) + (v.d.z + v.d.w));
    s = add_x16(s); s = add_x32(s, XL32(fr, fq));
    return 1.0f / sqrtf(s * (1.0f / D) + EPS);
}
struct CtxP {
    int kind;
    const bf16_t* A; int lda, K; const bf16_t* Bt; const float* sspi; const float* bias;
    const float* hin; float* hout; bf16_t* xbo; const float* gate; const float* ng; const float* sc; float* sspo;
    bf16_t* o1; bf16_t* o2;
    const float* cw; const float* cb; const float* br; const float* bi; const float* la8; float* h0;
};
template <int KW> struct CtxCW { f32x4 w[KW][2]; f32x4 b[2]; };
template <int KW>
__device__ __forceinline__ CtxCW<KW> ctx_cw_load(const float* cw, int cstride, const float* cb, int c) {
    CtxCW<KW> r;
#pragma unroll
    for (int k = 0; k < KW; ++k) { r.w[k][0] = *(const f32x4*)(cw + (size_t)k * cstride + c); r.w[k][1] = *(const f32x4*)(cw + (size_t)k * cstride + c + 4); }
    r.b[0] = *(const f32x4*)(cb + c); r.b[1] = *(const f32x4*)(cb + c + 4);
    return r;
}
template <int KW, int PAD>
__device__ __forceinline__ void ctx_conv_rows(float (&o)[8], const LAS float* tile, int t, int hh, const CtxCW<KW>& cwv) {
    f32x4 o0 = cwv.b[0], o1 = cwv.b[1];
#pragma unroll
    for (int k = 0; k < KW; ++k) { const int tt = t + k - PAD; if (tt >= 0 && tt < CT) {
        const f32x4 a = *(const LAS f32x4*)(tile + tt * 16 + 8 * hh), b = *(const LAS f32x4*)(tile + tt * 16 + 8 * hh + 4);
        o0 += cwv.w[k][0] * a; o1 += cwv.w[k][1] * b; } }
    o[0] = o0[0]; o[1] = o0[1]; o[2] = o0[2]; o[3] = o0[3]; o[4] = o1[0]; o[5] = o1[1]; o[6] = o1[2]; o[7] = o1[3];
}
__device__ __forceinline__ void ctx_item(const Ctx& C0, const CtxP& P, int item) {
    Ctx C = C0; asm volatile("" : "+v"(C.lane)); C.tid = C.wave * 64 + C.lane;
    const int fr = C.lane & 15, fq = C.lane >> 4, c0 = 16 * item;
    LAS float* t0 = (LAS float*)C.lds; LAS float* t1 = t0 + 4096; LAS float* t2 = t1 + 4096; LAS float* t3 = t2 + 4096; LAS float* tagg = t3 + 4096;
    const int tt = C.tid >> 1, hh = C.tid & 1;
    if (P.kind == 1) {
        f32x4 acc[2][2]; const bf16_t* const Bp[2] = {P.Bt + (size_t)c0 * P.K, P.Bt + (size_t)(1024 + c0) * P.K};
        const f32x4 b0 = *(const f32x4*)(P.bias + c0 + 4 * fq), b1 = *(const f32x4*)(P.bias + 1024 + c0 + 4 * fq);
        const CtxSS ssv[2] = {ctx_ss_load(P.sspi, 32 * C.wave + fr, fq), ctx_ss_load(P.sspi, 32 * C.wave + 16 + fr, fq)};
        ctx_mm<2, 16, 1024>(acc, P.A, P.lda, Bp, C.wave, C.lane, C.tid, C.lds);
        const CtxCW<4> cwv = ctx_cw_load<4>(P.cw, D, P.cb, c0 + 8 * hh);
#pragma unroll
        for (int g = 0; g < 2; ++g) { const int t = 32 * C.wave + 16 * g + fr; const float rs = ctx_rstd_fin(ssv[g], fr, fq);
            *(LAS f32x4*)(t0 + t * 16 + 4 * fq) = acc[g][0] * rs + b0;
            const f32x4 gp = acc[g][1] * rs + b1; u32x2 w; w.x = cvt_pk_bf16(gelu_t(gp[0]), gelu_t(gp[1])); w.y = cvt_pk_bf16(gelu_t(gp[2]), gelu_t(gp[3]));
            *(u32x2*)(P.o2 + (size_t)t * D + c0 + 4 * fq) = w; }
        __syncthreads();
        float o[8]; ctx_conv_rows<4, 2>(o, t0, tt, hh, cwv);
        u32x4 w; w.x = cvt_pk_bf16(o[0], o[1]); w.y = cvt_pk_bf16(o[2], o[3]); w.z = cvt_pk_bf16(o[4], o[5]); w.w = cvt_pk_bf16(o[6], o[7]);
        *(u32x4*)(P.o1 + cf_off(tt, c0 + 8 * hh, D)) = w;
        __syncthreads();
    } else if (P.kind == 2) {
        f32x4 acc[2][4]; const int q = c0 >> 7, cl = c0 & 127, h = c0 >> 8;
        const bf16_t* const Bp[4] = {P.Bt + (size_t)((0 * 8 + q) * 256 + cl) * 256, P.Bt + (size_t)((0 * 8 + q) * 256 + 128 + cl) * 256, P.Bt + (size_t)((1 * 8 + q) * 256 + cl) * 256, P.Bt + (size_t)((1 * 8 + q) * 256 + 128 + cl) * 256};
        const u32x2 uw2[2] = {*(const u32x2*)(P.A + cf_off(32 * C.wave + fr, c0 + 4 * fq, D)), *(const u32x2*)(P.A + cf_off(32 * C.wave + 16 + fr, c0 + 4 * fq, D))};
        f32x4 brv2[2], biv2[2], lav2[2];
#pragma unroll
        for (int d = 0; d < 2; ++d) { brv2[d] = *(const f32x4*)(P.br + d * D + c0 + 4 * fq); biv2[d] = *(const f32x4*)(P.bi + d * D + c0 + 4 * fq); lav2[d] = *(const f32x4*)(P.la8 + d * D + c0 + 4 * fq); }
        ctx_mm<4, 8, 256>(acc, P.A + h * 256 * 16, P.lda, Bp, C.wave, C.lane, C.tid, C.lds);
#pragma unroll
        for (int g = 0; g < 2; ++g) { const int t = 32 * C.wave + 16 * g + fr; const f32x4 uu = bf4_to_f4(uw2[g]);
#pragma unroll
            for (int d = 0; d < 2; ++d) { const f32x4 brv = brv2[d], biv = biv2[d], lav = lav2[d];
                f32x4 av, bv;
#pragma unroll
                for (int j = 0; j < 4; ++j) { const float r = sigm(acc[g][2 * d][j] + brv[j]), ig = sigm(acc[g][2 * d + 1][j] + biv[j]); const float a = __builtin_amdgcn_exp2f(r * lav[j]), e = 1.0f - a; av[j] = a; bv[j] = __builtin_amdgcn_sqrtf(e * (1.0f + a)) * ig * uu[j]; }
                *(LAS f32x4*)((d ? t2 : t0) + t * 16 + 4 * fq) = av; *(LAS f32x4*)((d ? t3 : t1) + t * 16 + 4 * fq) = bv; } }
        __syncthreads();
        { const int c = C.tid & 15, d = (C.tid >> 4) & 1, chk = C.tid >> 5; const LAS float* ta = d ? t2 : t0; LAS float* tb = d ? t3 : t1;
            float Pp = 1.f, Qq = 0.f;
#pragma unroll
            for (int i = 0; i < 16; ++i) { const int t = 16 * chk + (d ? 15 - i : i); const float a = ta[t * 16 + c], b = tb[t * 16 + c]; Qq = a * Qq + b; Pp *= a; }
            tagg[((d * 16 + chk) * 16 + c) * 2] = Pp; tagg[((d * 16 + chk) * 16 + c) * 2 + 1] = Qq;
            __syncthreads();
            float hcar = 0.f; const int n = d ? 15 - chk : chk;
            for (int i = 0; i < n; ++i) { const int cc = d ? 15 - i : i; hcar = tagg[((d * 16 + cc) * 16 + c) * 2] * hcar + tagg[((d * 16 + cc) * 16 + c) * 2 + 1]; }
#pragma unroll
            for (int i = 0; i < 16; ++i) { const int t = 16 * chk + (d ? 15 - i : i); hcar = ta[t * 16 + c] * hcar + tb[t * 16 + c]; tb[t * 16 + c] = hcar; }
            if ((d == 0 && chk == 15) || (d == 1 && chk == 0)) P.h0[d * D + c0 + c] = hcar; }
        __syncthreads();
        if (P.o1) { const f32x4 f0 = *(const LAS f32x4*)(t1 + tt * 16 + 8 * hh), f1 = *(const LAS f32x4*)(t1 + tt * 16 + 8 * hh + 4), r0 = *(const LAS f32x4*)(t3 + tt * 16 + 8 * hh), r1 = *(const LAS f32x4*)(t3 + tt * 16 + 8 * hh + 4);
            const u32x4 gw = *(const u32x4*)(P.o2 + (size_t)tt * D + c0 + 8 * hh);
            const f32x4 s0 = f0 + r0, s1 = f1 + r1;
            u32x4 w; w.x = cvt_pk_bf16(bf2f(gw.x & 0xffffu) * s0[0], bf2f(gw.x >> 16) * s0[1]); w.y = cvt_pk_bf16(bf2f(gw.y & 0xffffu) * s0[2], bf2f(gw.y >> 16) * s0[3]);
            w.z = cvt_pk_bf16(bf2f(gw.z & 0xffffu) * s1[0], bf2f(gw.z >> 16) * s1[1]); w.w = cvt_pk_bf16(bf2f(gw.w & 0xffffu) * s1[2], bf2f(gw.w >> 16) * s1[3]);
            *(u32x4*)(P.o1 + cf_off(tt, c0 + 8 * hh, D)) = w; }
        __syncthreads();
    } else if (P.kind == 4) {
        const int cg = item & 63, c4 = 16 * cg, t = 128 * (item >> 6) + 16 * C.wave + fr; const size_t off = (size_t)t * D + c4 + 4 * fq;
        const f32x4 gv = *(const f32x4*)(P.gate + c4 + 4 * fq); const f32x4 gs = *(const f32x4*)(P.ng + c4 + 4 * fq) * (*(const f32x4*)(P.sc + c4 + 4 * fq) + 1.0f);
        const f32x4 hold = *(const f32x4*)(P.hin + off);
        f32x4 acc;
        if (P.K == D) ctx_mm1<32, 1024>(acc, P.A, P.lda, P.Bt + (size_t)c4 * 1024, 128 * (item >> 6) + 16 * C.wave, C.lane, C.tid, C.lds);
        else ctx_mm1<22, 2816>(acc, P.A, P.lda, P.Bt + (size_t)c4 * 2816, 128 * (item >> 6) + 16 * C.wave, C.lane, C.tid, C.lds);
        const f32x4 hn = hold + gv * acc;
        *(f32x4*)(P.hout + off) = hn;
        float ss = (hn[0] * hn[0] + hn[1] * hn[1]) + (hn[2] * hn[2] + hn[3] * hn[3]); ss = add_x16(ss); ss = add_x32(ss, XL32(fr, fq));
        if (fq == 0) P.sspo[(size_t)t * 64 + cg] = ss;
        const f32x4 y = hn * gs; u32x2 w; w.x = cvt_pk_bf16(y[0], y[1]); w.y = cvt_pk_bf16(y[2], y[3]); *(u32x2*)(P.xbo + cf_off(t, c4 + 4 * fq, D)) = w;
    } else if (P.kind == 5) {
        f32x4 acc[2][2]; const int q = c0 >> 7, cl = c0 & 127, nb0 = q * 256 + cl;
        const bf16_t* const Bp[2] = {P.Bt + (size_t)nb0 * P.K, P.Bt + (size_t)(nb0 + 128) * P.K};
        const f32x4 b0 = *(const f32x4*)(P.bias + nb0 + 4 * fq), b1 = *(const f32x4*)(P.bias + nb0 + 128 + 4 * fq);
        const CtxSS ssv[2] = {ctx_ss_load(P.sspi, 32 * C.wave + fr, fq), ctx_ss_load(P.sspi, 32 * C.wave + 16 + fr, fq)};
        ctx_mm<2, 16, 1024>(acc, P.A, P.lda, Bp, C.wave, C.lane, C.tid, C.lds);
        const CtxCW<3> cwv = ctx_cw_load<3>(P.cw, DFF, P.cb, c0 + 8 * hh);
#pragma unroll
        for (int g = 0; g < 2; ++g) { const int t = 32 * C.wave + 16 * g + fr; const float rs = ctx_rstd_fin(ssv[g], fr, fq);
            *(LAS f32x4*)(t0 + t * 16 + 4 * fq) = acc[g][0] * rs + b0; *(LAS f32x4*)(t1 + t * 16 + 4 * fq) = acc[g][1] * rs + b1; }
        __syncthreads();
        float o[8]; ctx_conv_rows<3, 1>(o, t0, tt, hh, cwv);
        const f32x4 v0 = *(const LAS f32x4*)(t1 + tt * 16 + 8 * hh), v1 = *(const LAS f32x4*)(t1 + tt * 16 + 8 * hh + 4);
        u32x4 w; w.x = cvt_pk_bf16(silu_f(o[0]) * v0[0], silu_f(o[1]) * v0[1]); w.y = cvt_pk_bf16(silu_f(o[2]) * v0[2], silu_f(o[3]) * v0[3]);
        w.z = cvt_pk_bf16(silu_f(o[4]) * v1[0], silu_f(o[5]) * v1[1]); w.w = cvt_pk_bf16(silu_f(o[6]) * v1[2], silu_f(o[7]) * v1[3]);
        *(u32x4*)(P.o1 + cf_off(tt, c0 + 8 * hh, DFF)) = w;
        __syncthreads();
    } else {
        f32x4 acc[2][3]; const int q = c0 >> 7, cl = c0 & 127, nb1 = 1024 + q * 256 + cl;
        const bf16_t* const Bp[3] = {P.Bt + (size_t)c0 * P.K, P.Bt + (size_t)nb1 * P.K, P.Bt + (size_t)(nb1 + 128) * P.K};
        const f32x4 b0 = *(const f32x4*)(P.bias + c0 + 4 * fq), b1 = *(const f32x4*)(P.bias + nb1 + 4 * fq), b2 = *(const f32x4*)(P.bias + nb1 + 128 + 4 * fq);
        const CtxSS ssv[2] = {ctx_ss_load(P.sspi, 32 * C.wave + fr, fq), ctx_ss_load(P.sspi, 32 * C.wave + 16 + fr, fq)};
        ctx_mm<3, 8, 1024>(acc, P.A, P.lda, Bp, C.wave, C.lane, C.tid, C.lds);
        const CtxCW<3> cwv = ctx_cw_load<3>(P.cw, D, P.cb, c0 + 8 * hh);
#pragma unroll
        for (int g = 0; g < 2; ++g) { const int t = 32 * C.wave + 16 * g + fr; const float rs = ctx_rstd_fin(ssv[g], fr, fq);
            *(LAS f32x4*)(t0 + t * 16 + 4 * fq) = (acc[g][1] * rs + b1) * (acc[g][2] * rs + b2); *(LAS f32x4*)(t1 + t * 16 + 4 * fq) = acc[g][0] * rs + b0; }
        __syncthreads();
        float o[8]; ctx_conv_rows<3, 1>(o, t0, tt, hh, cwv);
        const f32x4 v0 = *(const LAS f32x4*)(t1 + tt * 16 + 8 * hh), v1 = *(const LAS f32x4*)(t1 + tt * 16 + 8 * hh + 4);
        u32x4 w; w.x = cvt_pk_bf16(o[0] * v0[0], o[1] * v0[1]); w.y = cvt_pk_bf16(o[2] * v0[2], o[3] * v0[3]); w.z = cvt_pk_bf16(o[4] * v1[0], o[5] * v1[1]); w.w = cvt_pk_bf16(o[6] * v1[2], o[7] * v1[3]);
        *(u32x4*)(P.o1 + cf_off(tt, c0 + 8 * hh, D)) = w;
        __syncthreads();
    }
}
__device__ __forceinline__ int ctx_step(const Ctx& C, int ph, CtxP& P) {
    const float* mods = WSP(float, WS_MODS);
#define CMOD(l, chunk) (mods + (size_t)((l) * 2 + 1) * NMOD + (chunk) * 1024)
#define CXB(i) (WSP(bf16_t, CX_XB) + (size_t)(i) * CT * D)
#define CSSP(i) (WSP(float, CX_SSP) + (size_t)(i) * CT * 64)
    P.kind = 0; P.A = nullptr; P.lda = D; P.K = D; P.Bt = nullptr; P.sspi = nullptr; P.bias = nullptr; P.hin = nullptr; P.hout = nullptr; P.xbo = nullptr; P.gate = nullptr; P.ng = nullptr; P.sc = nullptr; P.sspo = nullptr;
    P.o1 = nullptr; P.o2 = nullptr; P.cw = nullptr; P.cb = nullptr; P.br = nullptr; P.bi = nullptr; P.la8 = nullptr; P.h0 = nullptr;
    int sid; switch (ph) { case 2: sid = 2; break; case 3: sid = 3; break; case 4: sid = 4; break; case 5: sid = 5; break; case 8: sid = 6; break; case 9: sid = 7; break; case 10: sid = 8; break;
                           case 11: sid = 9; break; case 13: sid = 10; break; case 14: sid = 11; break; case 15: sid = 12; break; default: sid = 0; }
    switch (sid) {
    case 2: case 11: { const int j = sid == 2 ? 0 : 1, l = 2 * j, xi = sid == 2 ? 0 : 4;
        P.kind = 1; P.A = CXB(xi); P.lda = D; P.K = D; P.Bt = WSP(bf16_t, W_A1 + j * SZ_A1); P.sspi = CSSP(xi); P.bias = WSP(float, WS_BIASM) + (size_t)(l * 2 + 1) * 3072;
        P.o1 = WSP(bf16_t, CX_U) + (size_t)j * CT * D; P.o2 = WSP(bf16_t, CX_G); P.cw = INP(IX_ACW) + (size_t)j * 4 * D; P.cb = INP(IX_ACB) + (size_t)j * D; return 64; }
    case 3: case 12: { const int j = sid == 3 ? 0 : 1;
        P.kind = 2; P.A = WSP(bf16_t, CX_U) + (size_t)j * CT * D; P.lda = D; P.K = 256; P.Bt = WSP(bf16_t, W_A2 + j * SZ_A2);
        P.br = INP(IX_ABR) + (size_t)j * 2 * D; P.bi = INP(IX_ABI) + (size_t)j * 2 * D; P.la8 = WSP(float, WS_LA8) + (size_t)j * 2 * D; P.h0 = WSP(float, WS_H0) + (size_t)j * 2 * D;
        P.o1 = j == 0 ? WSP(bf16_t, CX_GS) : nullptr; P.o2 = WSP(bf16_t, CX_G); return 64; }
    case 4: P.kind = 4; P.A = WSP(bf16_t, CX_GS); P.lda = D; P.K = D; P.Bt = WSP(bf16_t, W_A3); P.hin = INP(IX_CTX); P.hout = WSP(float, CX_H); P.xbo = CXB(1); P.gate = CMOD(0, 2); P.ng = INP(IX_NFG); P.sc = CMOD(0, 4); P.sspo = CSSP(1); return 128;
    case 5: case 9: { const int l = sid == 5 ? 0 : 1, xi = sid == 5 ? 1 : 3;
        P.kind = 5; P.A = CXB(xi); P.lda = D; P.K = D; P.Bt = WSP(bf16_t, W_F1 + l * SZ_F1); P.sspi = CSSP(xi); P.bias = WSP(float, WS_BIASF) + (size_t)(l * 2 + 1) * 5632;
        P.o1 = WSP(bf16_t, CX_Y + l * 1536 * KiB); P.cw = INP(IX_FCW) + (size_t)l * 3 * DFF; P.cb = INP(IX_FCB) + (size_t)l * DFF; return 176; }
    case 6: case 10: { const int l = sid == 6 ? 0 : 1, xo = sid == 6 ? 2 : 4;
        P.kind = 4; P.A = WSP(bf16_t, CX_Y + l * 1536 * KiB); P.lda = DFF; P.K = DFF; P.Bt = WSP(bf16_t, W_F2 + l * SZ_F2); P.hin = WSP(float, CX_H); P.hout = WSP(float, CX_H); P.xbo = CXB(xo);
        P.gate = CMOD(l, 5); P.ng = INP(IX_NMG) + (size_t)(l + 1) * D; P.sc = CMOD(l + 1, 1); P.sspo = CSSP(xo); return 128; }
    case 7: P.kind = 7; P.A = CXB(2); P.lda = D; P.K = D; P.Bt = WSP(bf16_t, W_B1); P.sspi = CSSP(2); P.bias = WSP(float, WS_BIASM) + (size_t)(1 * 2 + 1) * 3072;
        P.o1 = WSP(bf16_t, CX_Q); P.cw = INP(IX_BCW); P.cb = INP(IX_BCB); return 64;
    case 8: P.kind = 4; P.A = WSP(bf16_t, CX_Q); P.lda = D; P.K = D; P.Bt = WSP(bf16_t, W_B2); P.hin = WSP(float, CX_H); P.hout = WSP(float, CX_H); P.xbo = CXB(3); P.gate = CMOD(1, 2); P.ng = INP(IX_NFG) + D; P.sc = CMOD(1, 4); P.sspo = CSSP(3); return 128;
    default: return 0;
    }
#undef CMOD
#undef CXB
#undef CSSP
}

__global__ void __launch_bounds__(512, 2) mega_fwd(Args args) {
    extern __shared__ __attribute__((aligned(16))) unsigned char lds_raw[];
    Ctx C;
    C.in = args.in; C.out = args.out; C.ws = args.ws; C.lds = (LAS unsigned char*)lds_raw;
    C.tid = threadIdx.x; C.lane = C.tid & 63; C.wave = __builtin_amdgcn_readfirstlane(C.tid >> 6); C.G = gridDim.x; C.bid = blockIdx.x;
    volatile LAS unsigned* MISC = (volatile LAS unsigned*)(C.lds + MISC_OFF);
    for (int u = C.tid; u < (LDS_BYTES - LDSCTL_OFF) / 4; u += 512) ((LAS unsigned*)(C.lds + LDSCTL_OFF))[u] = 0u;
    __syncthreads();
    XcdBarrier bar; bar.bar = (unsigned*)(C.ws + WS_CTL) + 4096; bar.x = 0; bar.st = nullptr;
#if !MK_PER_PHASE
    bar = xcd_barrier_post((unsigned*)(C.ws + WS_CTL) + 4096, MISC + 8);
#endif
    const int lo = args.ph_lo, hi = args.ph_hi;
#define REFRESH_LANE() do { C.lane = lane_id(); asm volatile("" : "+v"(C.lane)); C.tid = C.wave * 64 + C.lane; } while (0)
#define IN(k) (lo <= (k) && (k) < hi)
#ifndef MK_BAR_REPS
#define MK_BAR_REPS 1
#endif
#define SEAM(k) do { if (IN(k) && IN((k) + 1)) { for (int br_ = 0; br_ < MK_BAR_REPS; ++br_) xcd_barrier(bar); } } while (0)
    const float* mods = WSP(float, WS_MODS);
#define LMOD(l, chunk) (mods + (size_t)((l) * 2) * NMOD + (chunk) * 1024)
#define SLOTP(type, i) WSP(type, WS_SLOT + (size_t)(i) * SLOT)
#define SSPA(i) (WSP(float, WS_SSP) + (size_t)(i) * T * 16)
    int ph = 0;
    if (IN(ph)) { REFRESH_LANE(); phase_p0(C); }
    SEAM(ph); ++ph;
    if (IN(ph)) { REFRESH_LANE(); phase_p1(C); }
    SEAM(ph); ++ph;
    for (ph = 2; ph < 28; ++ph) {
        if (IN(ph)) {
            asm volatile("" : "+s"(C.wave), "+s"(C.bid), "+s"(C.G));
            { size_t zz = 0; asm volatile("" : "+s"(zz)); C.ws = args.ws + zz; C.out = args.out + zz; }
            REFRESH_LANE();
            { CtxP cp; const int nci = ctx_step(C, ph, cp); const int coff = (ph == 8 || ph == 13) ? (C.G >> 1) : 0;
              for (int it = C.bid - coff; it < nci; it += C.G) if (it >= 0) ctx_item(C, cp, it); }
            int p = ph - 2, l = 0;
            if (p >= 13) { p -= 13; l = 2; }
            int kind;
            if (p < 8) kind = p; else { l += 1; p -= 8; kind = p == 0 ? 8 : p == 1 ? 9 : p + 3; }
            const int j = l >> 1;
            if (kind == 0) {
                pg8::Gemm g{SLOTP(bf16_t, 0), WSP(bf16_t, W_A1 + j * SZ_A1), D, D, 64, 8, 0, 0}; pg8::StaticOrder S; S.init(64, 8, C.G, C.bid);
                EpiA1 E{SLOTP(bf16_t, 1), SLOTP(bf16_t, 4), WSP(float, WS_BIASM) + (size_t)(l * 2) * 3072, SSPA(2 * l)};
                pg8::gemm_phase(C.lds, g, S, E, C.wave);
            } else if (kind == 1) {
                REFRESH_LANE();
                phase_conv4(C, SLOTP(bf16_t, 1), SLOTP(bf16_t, 5), INP(IX_ACW) + (size_t)j * 4 * D, INP(IX_ACB) + (size_t)j * D);
            } else if (kind == 2) {
                int kk = 256; asm volatile("" : "+s"(kk));
                pg8::Gemm g{SLOTP(bf16_t, 5), WSP(bf16_t, W_A2 + j * SZ_A2), D, kk, 64, 16, 1, 3}; pg8::StaticOrder S; S.init(64, 16, C.G, C.bid);
                EpiA2 E{SLOTP(bf16_t, 5), SLOTP(h16, 0), INP(IX_ABR) + (size_t)j * 2 * D, INP(IX_ABI) + (size_t)j * 2 * D, WSP(float, WS_LA8) + (size_t)j * 2 * D};
                pg8::gemm_phase<EpiA2, false>(C.lds, g, S, E, C.wave);
            } else if (kind == 3) {
                REFRESH_LANE();
                phase_scan1(C, SLOTP(h16, 0));
            } else if (kind == 4) {
                REFRESH_LANE();
                phase_scan2(C, SLOTP(h16, 0), SLOTP(bf16_t, 4), SLOTP(bf16_t, 5), WSP(float, WS_H0) + (size_t)j * 2 * D);
            } else if (kind == 5) {
                const bf16_t* bt = (l & 1) ? WSP(bf16_t, W_B2 + j * SZ_B2) : WSP(bf16_t, W_A3 + j * SZ_A3);
                pg8::Gemm g{(l & 1) ? SLOTP(bf16_t, 3) : SLOTP(bf16_t, 5), bt, D, D, 64, 4, 0, 0}; pg8::StaticOrder S; S.init(64, 4, C.G, C.bid);
                EpiRes E{WSP(bf16_t, WS_XRES), SLOTP(bf16_t, 0), LMOD(l, 2), INP(IX_NFG) + (size_t)l * D, LMOD(l, 4), SSPA(2 * l + 1)};
                pg8::gemm_phase(C.lds, g, S, E, C.wave);
            } else if (kind == 6) {
                pg8::Gemm g{SLOTP(bf16_t, 0), WSP(bf16_t, W_F1 + l * SZ_F1), D, D, 64, 22, 0, 0}; pg8::StaticOrder S; S.init(64, 22, C.G, C.bid, ph > 13);
                EpiF1 E{SLOTP(bf16_t, 1), WSP(float, WS_BIASF) + (size_t)(l * 2) * 5632, SSPA(2 * l + 1), INP(IX_FCW) + (size_t)l * 3 * DFF, INP(IX_FCB) + (size_t)l * DFF};
                pg8::gemm_phase(C.lds, g, S, E, C.wave);
            } else if (kind == 7) {
                pg8::Gemm g{SLOTP(bf16_t, 1), WSP(bf16_t, W_F2 + l * SZ_F2), DFF, DFF, 64, 4, 0, 0}; pg8::StaticOrder S; S.init(64, 4, C.G, C.bid);
                EpiRes E{WSP(bf16_t, WS_XRES), SLOTP(bf16_t, 0), LMOD(l, 5), l < 3 ? INP(IX_NMG) + (size_t)(l + 1) * D : nullptr, l < 3 ? LMOD(l + 1, 1) : nullptr, SSPA(2 * l + 2)};
                pg8::gemm_phase(C.lds, g, S, E, C.wave);
            } else if (kind == 8) {
                pg8::Gemm g{SLOTP(bf16_t, 0), WSP(bf16_t, W_B1 + j * SZ_B1), D, D, 64, 12, 0, 0}; pg8::StaticOrder S; S.init(64, 12, C.G, C.bid);
                EpiB1 E{SLOTP(bf16_t, 1), SLOTP(bf16_t, 2), WSP(float, WS_BIASM) + (size_t)(l * 2) * 3072, SSPA(2 * l)};
                pg8::gemm_phase(C.lds, g, S, E, C.wave);
            } else {
                REFRESH_LANE();
                phase_vconv(C, SLOTP(bf16_t, 1), SLOTP(bf16_t, 2), SLOTP(bf16_t, 3), INP(IX_BCW) + (size_t)j * 3 * D, INP(IX_BCB) + (size_t)j * D);
            }
        }
        SEAM(ph);
    }
    if (IN(ph)) { REFRESH_LANE(); phase_final(C, SSPA(8)); }
}
constexpr int N_PHASES = 29;

extern "C" void kernel_launch(void* const* d_in, const int* in_sizes, int n_in, void* d_out, int out_size, void* d_ws, size_t ws_size, hipStream_t stream) {
    static int grid = 0;
    if (grid == 0) {
        if (n_in != N_IN || in_sizes[0] != T * D || out_size != T * D || ws_size < WS_END) { fprintf(stderr, "kernel_launch: unexpected problem shape (n_in %d, in0 %d, out %d, ws %zu < %zu)\n", n_in, n_in > 0 ? in_sizes[0] : -1, out_size, ws_size, (size_t)WS_END); grid = -1; return; }
        int dev = 0, cus = 0, per_cu = 0;
        if (hipGetDevice(&dev) != hipSuccess || hipDeviceGetAttribute(&cus, hipDeviceAttributeMultiprocessorCount, dev) != hipSuccess) { grid = -1; return; }
        if (hipFuncSetAttribute((const void*)mega_fwd, hipFuncAttributeMaxDynamicSharedMemorySize, LDS_BYTES) != hipSuccess) { fprintf(stderr, "kernel_launch: hipFuncSetAttribute failed\n"); grid = -1; return; }
        if (hipOccupancyMaxActiveBlocksPerMultiprocessor(&per_cu, (const void*)mega_fwd, 512, LDS_BYTES) != hipSuccess || per_cu < 1) fprintf(stderr, "kernel_launch: occupancy query reports %d\n", per_cu);
        (void)hipGetLastError();
        grid = cus;
    }
    if (grid < 0) return;
    (void)hipMemsetAsync((char*)d_ws + WS_CTL, 0, CTL_ZERO_BYTES, stream);
    Args a{};
    for (int i = 0; i < N_IN; ++i) a.in[i] = (const float*)d_in[i];
    a.out = (float*)d_out; a.ws = (unsigned char*)d_ws;
#if MK_PER_PHASE
    for (int p = 0; p < N_PHASES; ++p) {
        const bool dup = (MK_DUP_MASK >> p) & 1u;
        bool inplace = false;
        if (p >= 2 && p < 28) { int q = p - 2, l = 0; if (q >= 13) { q -= 13; l = 2; } int kind; if (q < 8) kind = q; else { l += 1; q -= 8; kind = q == 0 ? 8 : q == 1 ? 9 : q + 3; } inplace = kind == 5 || kind == 7; }
        const bool cin = (p == 6 || p == 8 || p == 10);
        char* xbk = (char*)d_ws + WS_SLOT + 4 * SLOT; char* cbk = (char*)d_ws + WS_END;
        if (dup && inplace) (void)hipMemcpyAsync(xbk, (char*)d_ws + WS_XRES, (size_t)T * D * 2, hipMemcpyDeviceToDevice, stream);
        if (dup && cin) (void)hipMemcpyAsync(cbk, (char*)d_ws + CX_H, (size_t)CT * D * 4, hipMemcpyDeviceToDevice, stream);
        a.ph_lo = p; a.ph_hi = p + 1; hipLaunchKernelGGL(mega_fwd, dim3(grid), dim3(512), LDS_BYTES, stream, a);
        if (dup) {
            if (inplace) (void)hipMemcpyAsync((char*)d_ws + WS_XRES, xbk, (size_t)T * D * 2, hipMemcpyDeviceToDevice, stream);
            if (cin) (void)hipMemcpyAsync((char*)d_ws + CX_H, cbk, (size_t)CT * D * 4, hipMemcpyDeviceToDevice, stream);
            hipLaunchKernelGGL(mega_fwd, dim3(grid), dim3(512), LDS_BYTES, stream, a);
        }
    }
#else
    a.ph_lo = 0; a.ph_hi = N_PHASES;
    hipLaunchKernelGGL(mega_fwd, dim3(grid), dim3(512), LDS_BYTES, stream, a);
#endif
}
```

```cpp
#include <hip/hip_runtime.h>
#include <cstdio>
#include <cstdint>

#ifndef MK_DUP_MASK
#define MK_DUP_MASK 0u
#endif
#ifndef MK_PER_PHASE
#define MK_PER_PHASE 0
#endif

#define LAS __attribute__((address_space(3)))
typedef unsigned short bf16_t;
typedef short bf16x8 __attribute__((ext_vector_type(8)));
typedef float f32x4 __attribute__((ext_vector_type(4)));
typedef float f32x2 __attribute__((ext_vector_type(2)));
typedef unsigned u32x4 __attribute__((ext_vector_type(4)));
typedef unsigned u32x2 __attribute__((ext_vector_type(2)));
typedef _Float16 h16;
typedef _Float16 h16x2 __attribute__((ext_vector_type(2)));
typedef _Float16 h16x4 __attribute__((ext_vector_type(4)));

constexpr int T = 16384, D = 1024, CT = 256, DFF = 2816, NMOD = 6144;
constexpr float EPS = 1e-6f;

enum { IX_X = 0, IX_C, IX_CTX, IX_CCTX, IX_ADAW, IX_ADAB, IX_NMG, IX_NFG, IX_AWX, IX_AWG, IX_ACW, IX_ACB, IX_AWR, IX_ABR, IX_AWI, IX_ABI, IX_ALAM, IX_AWO,
       IX_BWIN, IX_BCW, IX_BCB, IX_BWO, IX_FWU, IX_FCW, IX_FCB, IX_FWD, IX_FG, N_IN };

constexpr size_t MiB = 1u << 20, KiB = 1u << 10;
constexpr size_t WS_CTL = 0, CTL_ZERO_BYTES = 64 * KiB;
constexpr size_t WS_MODS = 1 * MiB;
constexpr size_t WS_BIASM = 1 * MiB + 256 * KiB;
constexpr size_t WS_BIASF = 1 * MiB + 512 * KiB;
constexpr size_t WS_LA8 = 1 * MiB + 768 * KiB;
constexpr size_t WS_H0 = WS_LA8 + 16 * KiB;
constexpr size_t WS_SSP = 2 * MiB;
constexpr size_t WS_AGGT = 11 * MiB;
constexpr size_t WS_AGG32 = 12 * MiB;
constexpr size_t WS_CTXR = 20 * MiB;
constexpr size_t CX_H = WS_CTXR;
constexpr size_t CX_XB = WS_CTXR + 1 * MiB;
constexpr size_t CX_U = WS_CTXR + 4 * MiB;
constexpr size_t CX_G = WS_CTXR + 5 * MiB;
constexpr size_t CX_GS = CX_G + 512 * KiB;
constexpr size_t CX_Q = WS_CTXR + 6 * MiB;
constexpr size_t CX_Y = CX_Q + 512 * KiB;
constexpr size_t CX_SSP = WS_CTXR + 10 * MiB;
constexpr size_t WS_W = 32 * MiB;
constexpr size_t W_A1 = WS_W, W_A2 = WS_W + 8 * MiB, W_A3 = WS_W + 12 * MiB, W_B1 = WS_W + 16 * MiB, W_B2 = WS_W + 28 * MiB, W_F1 = WS_W + 32 * MiB, W_F2 = WS_W + 76 * MiB;
constexpr size_t SZ_A1 = 4 * MiB, SZ_A2 = 2 * MiB, SZ_A3 = 2 * MiB, SZ_B1 = 6 * MiB, SZ_B2 = 2 * MiB, SZ_F1 = 11 * MiB, SZ_F2 = 5632 * KiB;
constexpr size_t WS_SLOT = 130 * MiB, SLOT = 32 * MiB;
constexpr size_t WS_XRES = WS_SLOT + 6 * SLOT;
constexpr size_t WS_END = WS_XRES + SLOT;
static_assert(W_F2 + 4 * SZ_F2 <= WS_SLOT, "weights fit");

constexpr int RING_BYTES = 131072, LDSCTL_OFF = RING_BYTES, MISC_OFF = LDSCTL_OFF + 320, LDS_BYTES = 147456;
constexpr int A2_BLK_OFF = RING_BYTES + 4096, A2_BLK_BYTES = 1280, A2_CNT_OFF = A2_BLK_OFF + 8 * A2_BLK_BYTES;
static_assert(A2_CNT_OFF + 16 <= LDS_BYTES, "LDS map");

__device__ __forceinline__ float bf2f(unsigned b) { return __uint_as_float(b << 16); }
__device__ __forceinline__ unsigned cvt_pk_bf16(float lo, float hi) { unsigned r; asm volatile("v_cvt_pk_bf16_f32 %0, %1, %2" : "=v"(r) : "v"(lo), "v"(hi)); return r; }
__device__ __forceinline__ float sigm(float x) { return __builtin_amdgcn_rcpf(1.f + __builtin_amdgcn_exp2f(-1.4426950409f * x)); }
__device__ __forceinline__ float silu_f(float x) { return x * sigm(x); }
__device__ __forceinline__ float gelu_t(float x) { const float u = x + 0.044715f * x * x * x; return x * __builtin_amdgcn_rcpf(1.f + __builtin_amdgcn_exp2f(-2.3022081986f * u)); }
__device__ __forceinline__ float one_minus_exp(float x) {
    float p = 1.f / 720.f; p = p * x + 1.f / 120.f; p = p * x + 1.f / 24.f; p = p * x + 1.f / 6.f; p = p * x + 0.5f; p = p * x + 1.f;
    const float small = -(p * x);
    const float big = 1.f - __builtin_amdgcn_exp2f(1.4426950409f * x);
    return x < -0.25f ? big : small;
}
__device__ __forceinline__ int lane_id() { return (int)__builtin_amdgcn_mbcnt_hi(~0u, __builtin_amdgcn_mbcnt_lo(~0u, 0u)); }
#define SWZ_X4 0x101F
#define SWZ_X8 0x201F
#define SWZ_X16 0x401F
__device__ __forceinline__ float add_x16(float v) { return v + __builtin_bit_cast(float, __builtin_amdgcn_ds_swizzle(__builtin_bit_cast(int, v), SWZ_X16)); }
__device__ __forceinline__ float add_x32(float v, int xl) { return v + __builtin_bit_cast(float, __builtin_amdgcn_ds_bpermute(xl, __builtin_bit_cast(int, v))); }
#define XL32(fr, fq) ((((fr) + 16 * (fq)) ^ 32) << 2)
__device__ __forceinline__ float wave_sum(float v) {
    v += __builtin_bit_cast(float, __builtin_amdgcn_update_dpp(0, __builtin_bit_cast(int, v), 0xB1, 0xf, 0xf, false));
    v += __builtin_bit_cast(float, __builtin_amdgcn_update_dpp(0, __builtin_bit_cast(int, v), 0x4E, 0xf, 0xf, false));
    v += __builtin_bit_cast(float, __builtin_amdgcn_ds_swizzle(__builtin_bit_cast(int, v), SWZ_X4));
    v += __builtin_bit_cast(float, __builtin_amdgcn_ds_swizzle(__builtin_bit_cast(int, v), SWZ_X8));
    v = add_x16(v);
    return __builtin_bit_cast(float, __builtin_amdgcn_readlane(__builtin_bit_cast(int, v), 0)) + __builtin_bit_cast(float, __builtin_amdgcn_readlane(__builtin_bit_cast(int, v), 32));
}
__device__ __forceinline__ float dpp_ror1(float x) { return __builtin_bit_cast(float, __builtin_amdgcn_update_dpp(0, __builtin_bit_cast(int, x), 0x121, 0xf, 0xf, false)); }
__device__ __forceinline__ float dpp_ror15(float x) { return __builtin_bit_cast(float, __builtin_amdgcn_update_dpp(0, __builtin_bit_cast(int, x), 0x12F, 0xf, 0xf, false)); }
__device__ __forceinline__ unsigned pk_h2(float a, float b) { h16x2 v = {(h16)a, (h16)b}; return __builtin_bit_cast(unsigned, v); }
__device__ __forceinline__ f32x4 h4_to_f4(u32x2 w) { h16x4 h = __builtin_bit_cast(h16x4, w); return (f32x4){(float)h[0], (float)h[1], (float)h[2], (float)h[3]}; }
__device__ __forceinline__ f32x4 bf4_to_f4(u32x2 w) { return (f32x4){bf2f(w.x & 0xffffu), bf2f(w.x >> 16), bf2f(w.y & 0xffffu), bf2f(w.y >> 16)}; }

namespace pg8 {
constexpr int BM = 256, BK = 64, HALF = 128, HTB = HALF * BK * 2, STAGE_BYTES = 8 * HTB, NXCD = 8, WGM = 4;
__host__ __device__ __forceinline__ int lds_byte(int r, int c) { const int st = (r >> 4) * 2 + (c >> 5), rr = r & 15, cc = c & 31, ob = rr * 64 + cc * 2; return st * 1024 + (ob ^ (((ob >> 9) & 1) << 5)); }
__host__ __device__ __forceinline__ void stage_rc(int b, int& R, int& C) { const int st = b / 1024, sb = b % 1024, swz = sb ^ (((sb >> 9) & 1) << 5); R = (st >> 1) * 16 + swz / 64; C = (st & 1) * 32 + (swz % 64) / 2; }
__host__ __device__ __forceinline__ int perm32(int rho) { const int n = rho >> 4, i = rho & 15; return 8 * (i >> 2) + 4 * n + (i & 3); }
struct Unit { int pm, pn, hrow, nai; };
struct Gemm { const bf16_t* A; const bf16_t* Bt; int lda, K, nM, nN, acs, acm; };
struct StaticOrder {
    int nM, nN, nwg, G, c; bool halves;
    __device__ void init(int nM_, int nN_, int G_, int c_, bool halves_ = false) { nM = nM_; nN = nN_; nwg = nM * nN; G = G_; c = c_; halves = halves_; }
    __device__ bool next(int i, Unit& u) const {
        const int fullr = nwg / G, rem = nwg - fullr * G; const bool split = halves && (rem * 2 == G);
        long L; u.hrow = 0; u.nai = 2;
        if (i < fullr) L = (long)i * G + c;
        else if (i == fullr && split) { L = (long)fullr * G + (c >> 1); u.hrow = (c & 1) * 128; u.nai = 1; }
        else if (i == fullr && c < rem) L = (long)i * G + c;
        else return false;
        int wgid = (int)L; { const int q = nwg / NXCD, r = nwg % NXCD, xcd = wgid % NXCD, off = wgid / NXCD; wgid = (xcd < r ? xcd * (q + 1) : r * (q + 1) + (xcd - r) * q) + off; }
        const int nig = WGM * nN, gid = wgid / nig, fm = gid * WGM, gsz = (nM - fm) < WGM ? (nM - fm) : WGM;
        u.pm = fm + ((wgid % nig) % gsz); u.pn = (wgid % nig) / gsz; return true;
    }
};

template <class Epi, bool PERM = true>
__device__ __forceinline__ void gemm_phase(LAS unsigned char* lds, const Gemm g, const StaticOrder& S, const Epi& E, int wid_) {
    int lane_ = lane_id(); asm volatile("" : "+v"(lane_));
    const int wid = wid_, lane = lane_, tid = wid * 64 + lane, wr = wid >> 2, wc = wid & 3, fr = lane & 15, fq = lane >> 4;
    const int K = g.K, nt = K / BK;
    unsigned voffA[2], voffB[2];
#pragma unroll
    for (int i = 0; i < 2; ++i) { int R, C; stage_rc(tid * 16 + i * 8192, R, C); const int Rb = PERM ? (R & ~31) + perm32(R & 31) : R;
        voffA[i] = (unsigned)(R * g.lda + C) * 2u; voffB[i] = (unsigned)(Rb * K + C) * 2u; }
    const unsigned kstep = (unsigned)(BK * 2);
    const unsigned hstepA = (unsigned)HALF * (unsigned)g.lda * 2u, tstepA = 2u * hstepA;
    const unsigned hstepB = (unsigned)HALF * (unsigned)K * 2u, tstepB = 2u * hstepB;
    const unsigned ldsw = (unsigned)wid * 1024u;
    const int aoff = lds_byte(wr * 64 + fr, fq * 8), boff = lds_byte(wc * 32 + fr, fq * 8);
    const __amdgpu_buffer_rsrc_t rsA = __builtin_amdgcn_make_buffer_rsrc((void*)g.A, 0, 0x7fffffff, 0x00020000);
    const __amdgpu_buffer_rsrc_t rsB = __builtin_amdgcn_make_buffer_rsrc((void*)g.Bt, 0, 0x7fffffff, 0x00020000);
#define PG8_UA(u) ((unsigned)(u).pm * tstepA + ((u).hrow ? hstepA : 0u) + (unsigned)((((u).pn >> g.acs) & g.acm) * 512))
#define PG8_UB(u) ((unsigned)(u).pn * tstepB)
#define PG8_SA(b, h) (((b) * 2 + (h)) * HTB)
#define PG8_SB(b, h) ((4 + (b) * 2 + (h)) * HTB)
#define PG8_STAGE(bufoff, rs, soff, voff) do { _Pragma("unroll") for (int _i = 0; _i < 2; ++_i) \
        __builtin_amdgcn_raw_ptr_buffer_load_lds(rs, (LAS void*)(lds + (bufoff) + ldsw + _i * 8192), 16, (int)(voff)[_i], (int)(soff), 0, 0); } while (0)
#define PG8_LDA(dst, b, h) do { _Pragma("unroll") for (int m = 0; m < 4; ++m) _Pragma("unroll") for (int k = 0; k < 2; ++k) dst[m][k] = *(const LAS bf16x8*)(lds + PG8_SA(b, h) + aoff + m * 2048 + k * 1024); } while (0)
#define PG8_LDB(dst, b, h) do { _Pragma("unroll") for (int n = 0; n < 2; ++n) _Pragma("unroll") for (int k = 0; k < 2; ++k) dst[n][k] = *(const LAS bf16x8*)(lds + PG8_SB(b, h) + boff + n * 2048 + k * 1024); } while (0)
#define PG8_MMA(ai, bj, At, Bt) do { __builtin_amdgcn_s_setprio(1); _Pragma("unroll") for (int m = 0; m < 4; ++m) _Pragma("unroll") for (int n = 0; n < 2; ++n) _Pragma("unroll") for (int k = 0; k < 2; ++k) \
        acc[ai][bj][m][n] = __builtin_amdgcn_mfma_f32_16x16x32_bf16(Bt[n][k], At[m][k], acc[ai][bj][m][n], 0, 0, 0); __builtin_amdgcn_s_setprio(0); } while (0)
#define PG8_WAIT_V(n) asm volatile("s_waitcnt vmcnt(" #n ")" ::: "memory")
#define PG8_WAIT_L(n) asm volatile("s_waitcnt lgkmcnt(" #n ")" ::: "memory")
#define PG8_BAR __builtin_amdgcn_s_barrier()
#define PG8_SCHED __builtin_amdgcn_sched_barrier(0)
    Unit cur, nxt; int ui = 0;
    if (!S.next(0, cur)) return;
    f32x4 acc[2][2][4][2];
#pragma unroll
    for (int a = 0; a < 2; ++a)
#pragma unroll
        for (int b = 0; b < 2; ++b)
#pragma unroll
            for (int m = 0; m < 4; ++m)
#pragma unroll
                for (int n = 0; n < 2; ++n) acc[a][b][m][n] = (f32x4){0.f, 0.f, 0.f, 0.f};
    bf16x8 At[4][2], B0[2][2], B1[2][2];
    unsigned cA = PG8_UA(cur), cB = PG8_UB(cur);
    PG8_STAGE(PG8_SB(0, 0), rsB, cB, voffB); PG8_STAGE(PG8_SB(0, 1), rsB, cB + hstepB, voffB); PG8_STAGE(PG8_SA(0, 0), rsA, cA, voffA); PG8_STAGE(PG8_SA(0, 1), rsA, cA + hstepA, voffA);
    if (wr == 1) PG8_BAR;
    PG8_WAIT_V(2); PG8_BAR;
    PG8_STAGE(PG8_SB(1, 0), rsB, cB + kstep, voffB); PG8_STAGE(PG8_SA(1, 0), rsA, cA + kstep, voffA); PG8_STAGE(PG8_SB(1, 1), rsB, cB + hstepB + kstep, voffB);
    PG8_WAIT_V(6); PG8_BAR;
    for (;;) {
        const bool has_next = S.next(ui + 1, nxt);
        const unsigned nA = has_next ? PG8_UA(nxt) : cA, nB = has_next ? PG8_UB(nxt) : cB;
        for (int t = 0; t < nt; t += 2) {
            const bool last = (t == nt - 2);
            const unsigned a1 = cA + (unsigned)(t + 1) * kstep;
            const unsigned a2 = last ? nA : cA + (unsigned)(t + 2) * kstep, b2 = last ? nB : cB + (unsigned)(t + 2) * kstep;
            const unsigned a3 = a2 + kstep, b3 = b2 + kstep;
            PG8_LDB(B0, 0, 0); PG8_LDB(B1, 0, 1); PG8_SCHED; PG8_LDA(At, 0, 0); PG8_STAGE(PG8_SA(1, 1), rsA, a1 + hstepA, voffA);
            PG8_WAIT_V(8); PG8_WAIT_L(0); PG8_BAR; PG8_MMA(0, 0, At, B0); PG8_MMA(0, 1, At, B1); PG8_BAR; PG8_SCHED;
            PG8_LDA(At, 0, 1); PG8_STAGE(PG8_SB(0, 0), rsB, b2, voffB); PG8_STAGE(PG8_SB(0, 1), rsB, b2 + hstepB, voffB); PG8_STAGE(PG8_SA(0, 0), rsA, a2, voffA);
            PG8_WAIT_V(8); PG8_WAIT_L(0); PG8_BAR; if (cur.nai == 2) { PG8_MMA(1, 0, At, B0); PG8_MMA(1, 1, At, B1); } PG8_BAR; PG8_SCHED;
            PG8_LDB(B0, 1, 0); PG8_LDB(B1, 1, 1); PG8_SCHED; PG8_LDA(At, 1, 0); PG8_STAGE(PG8_SA(0, 1), rsA, a2 + hstepA, voffA);
            PG8_WAIT_V(8); PG8_WAIT_L(0); PG8_BAR; PG8_MMA(0, 0, At, B0); PG8_MMA(0, 1, At, B1); PG8_BAR; PG8_SCHED;
            PG8_LDA(At, 1, 1); PG8_STAGE(PG8_SB(1, 0), rsB, b3, voffB); PG8_STAGE(PG8_SB(1, 1), rsB, b3 + hstepB, voffB); PG8_STAGE(PG8_SA(1, 0), rsA, a3, voffA);
            PG8_WAIT_V(8); PG8_WAIT_L(0); PG8_BAR; if (cur.nai == 2) { PG8_MMA(1, 0, At, B0); PG8_MMA(1, 1, At, B1); } PG8_BAR; PG8_SCHED;
        }
        if (wr == 0) PG8_BAR;
        { int lnE = lane_id(); asm volatile("" : "+v"(lnE)); int frE = lnE & 15, fqE = lnE >> 4, wrE = wr, wcE = wc; asm volatile("" : "+s"(wrE), "+s"(wcE));
          E(acc, cur, wrE, wcE, frE, fqE); }
        if (!has_next) break;
#pragma unroll
        for (int a = 0; a < 2; ++a)
#pragma unroll
            for (int b = 0; b < 2; ++b)
#pragma unroll
                for (int m = 0; m < 4; ++m)
#pragma unroll
                    for (int n = 0; n < 2; ++n) acc[a][b][m][n] = (f32x4){0.f, 0.f, 0.f, 0.f};
        cur = nxt; cA = nA; cB = nB; ++ui;
        if (wr == 1) PG8_BAR;
    }
    PG8_WAIT_V(0);
    PG8_BAR;
#undef PG8_UA
#undef PG8_UB
#undef PG8_SA
#undef PG8_SB
#undef PG8_STAGE
#undef PG8_LDA
#undef PG8_LDB
#undef PG8_MMA
#undef PG8_WAIT_V
#undef PG8_WAIT_L
#undef PG8_BAR
#undef PG8_SCHED
}
}

typedef f32x4 Acc[2][2][4][2];

__device__ __forceinline__ void load_rstd(float (&rs)[2][4], const float* ssp, int row0, int fr, int fq) {
#pragma unroll
    for (int ai = 0; ai < 2; ++ai)
#pragma unroll
        for (int m = 0; m < 4; ++m) {
            const f32x4 p = *(const f32x4*)(ssp + (size_t)(row0 + ai * 128 + m * 16) * 16 + fq * 4);
            float s = (p.x + p.y) + (p.z + p.w);
            s = add_x16(s); s = add_x32(s, XL32(fr, fq));
            rs[ai][m] = __builtin_amdgcn_rsqf(s * (1.0f / D) + EPS);
        }
}

struct EpiA1 {
    bf16_t* UPRE; bf16_t* G; const float* bias; const float* ssp;
    __device__ __forceinline__ void operator()(const Acc& acc, const pg8::Unit& u, int wr, int wc, int fr, int fq) const {
        const int row0 = u.pm * 256 + wr * 64 + fr;
        float rs[2][4]; load_rstd(rs, ssp, row0, fr, fq);
        const bool isg = u.pn >= 4; bf16_t* out = isg ? G : UPRE;
        const int oc0 = (u.pn & 3) * 256 + wc * 32 + 8 * fq, bc0 = u.pn * 256 + wc * 32 + 8 * fq;
        f32x4 bv[2][2];
#pragma unroll
        for (int bj = 0; bj < 2; ++bj)
#pragma unroll
            for (int n = 0; n < 2; ++n) bv[bj][n] = *(const f32x4*)(bias + bc0 + bj * 128 + 4 * n);
#pragma unroll
        for (int ai = 0; ai < 2; ++ai)
#pragma unroll
            for (int m = 0; m < 4; ++m) { bf16_t* rowp = out + (size_t)(row0 + ai * 128 + m * 16) * D + oc0; const float r = rs[ai][m];
#pragma unroll
                for (int bj = 0; bj < 2; ++bj) { f32x4 v0 = acc[ai][bj][m][0] * r + bv[bj][0], v1 = acc[ai][bj][m][1] * r + bv[bj][1];
                    if (isg) { v0 = (f32x4){gelu_t(v0[0]), gelu_t(v0[1]), gelu_t(v0[2]), gelu_t(v0[3])}; v1 = (f32x4){gelu_t(v1[0]), gelu_t(v1[1]), gelu_t(v1[2]), gelu_t(v1[3])}; }
                    u32x4 w; w.x = cvt_pk_bf16(v0[0], v0[1]); w.y = cvt_pk_bf16(v0[2], v0[3]); w.z = cvt_pk_bf16(v1[0], v1[1]); w.w = cvt_pk_bf16(v1[2], v1[3]);
                    *(u32x4*)(rowp + bj * 128) = w; } }
    }
};

struct EpiA2 {
    const bf16_t* U; h16* EB; const float* br; const float* bi; const float* la8; float* agg32; float* aggt; LAS unsigned char* lds;
    __device__ __forceinline__ void operator()(const Acc& acc, const pg8::Unit& u, int wr, int wc, int fr, int fq) const {
        const int row0 = u.pm * 256 + wr * 64 + fr, d = u.pn >> 3, q = u.pn & 7, c0 = q * 128 + wc * 32 + 4 * fq;
        h16* Ed = EB + (size_t)d * T * D * 2;
        u32x2 uw[2][4][2];
#pragma unroll
        for (int ai = 0; ai < 2; ++ai)
#pragma unroll
            for (int m = 0; m < 4; ++m)
#pragma unroll
                for (int n = 0; n < 2; ++n) uw[ai][m][n] = *(const u32x2*)(U + (size_t)(row0 + ai * 128 + m * 16) * D + c0 + 16 * n);
        f32x4 brv2[2], biv2[2], lav2[2];
#pragma unroll
        for (int n = 0; n < 2; ++n) { brv2[n] = *(const f32x4*)(br + d * D + c0 + 16 * n); biv2[n] = *(const f32x4*)(bi + d * D + c0 + 16 * n); lav2[n] = *(const f32x4*)(la8 + d * D + c0 + 16 * n); }
        const int lane = fq * 16 + fr, cl = lane & 15, qt = lane >> 4;
        LAS unsigned char* blk = lds + A2_BLK_OFF + (wr * 4 + wc) * A2_BLK_BYTES;
        LAS unsigned char* wp = blk + ((fr >> 2) * 80 + (fr & 3) * 16 + 4 * fq) * 4;
        const LAS unsigned char* rp = blk + (qt * 80 + cl) * 4 + (d ? 3 * 64 : 0); const int rstep = d ? -64 : 64;
        const bool sec1 = ((qt & 1) ^ d) != 0, sec2 = ((qt >> 1) ^ d) != 0;
        const int plane = (lane ^ 32) * 4;
        float SP[2][2][2], SQ[2][2][2];
#pragma unroll
        for (int ai = 0; ai < 2; ++ai) {
            float BP[2] = {1.f, 1.f}, BQ[2] = {0.f, 0.f};
#pragma unroll
            for (int m = 0; m < 4; ++m) {
#pragma unroll
                for (int n = 0; n < 2; ++n) { const size_t off = (size_t)(row0 + ai * 128 + m * 16) * D + c0 + 16 * n;
                    const f32x4 uu = bf4_to_f4(uw[ai][m][n]); const f32x4 brv = brv2[n], biv = biv2[n], lav = lav2[n];
                    unsigned w[4];
#pragma unroll
                    for (int j = 0; j < 4; ++j) { const float r = sigm(acc[ai][0][m][n][j] + brv[j]), ig = sigm(acc[ai][1][m][n][j] + biv[j]);
                        const float a = __builtin_amdgcn_exp2f(r * lav[j]), e = 1.0f - a; w[j] = pk_h2(e, __builtin_amdgcn_sqrtf(e * (1.0f + a)) * ig * uu[j]); }
                    const u32x4 wv = (u32x4){w[0], w[1], w[2], w[3]};
                    *(u32x4*)(Ed + off * 2) = wv;
                    *(LAS u32x4*)wp = wv;
                    unsigned v[4];
#pragma unroll
                    for (int k = 0; k < 4; ++k) v[k] = *(const LAS unsigned*)(rp + k * rstep);
                    float P = 1.f, Q = 0.f;
#pragma unroll
                    for (int k = 0; k < 4; ++k) { const h16x2 hh = __builtin_bit_cast(h16x2, v[k]); const float a = 1.0f - (float)hh[0], b = (float)hh[1]; P *= a; Q = a * Q + b; }
                    {   const float Pp = __int_as_float(__builtin_amdgcn_ds_swizzle(__float_as_int(P), 0x401F)), Qp = __int_as_float(__builtin_amdgcn_ds_swizzle(__float_as_int(Q), 0x401F));
                        const float fQ = sec1 ? Qp : Q, sP = sec1 ? P : Pp, sQ = sec1 ? Q : Qp; P = P * Pp; Q = sP * fQ + sQ; }
                    {   const float Pp = __int_as_float(__builtin_amdgcn_ds_bpermute(plane, __float_as_int(P))), Qp = __int_as_float(__builtin_amdgcn_ds_bpermute(plane, __float_as_int(Q)));
                        const float fQ = sec2 ? Qp : Q, sP = sec2 ? P : Pp, sQ = sec2 ? Q : Qp; P = P * Pp; Q = sP * fQ + sQ; }
                    if (m & 1) { const float fP = d ? P : BP[n], fQ = d ? Q : BQ[n], sP = d ? BP[n] : P, sQ = d ? BQ[n] : Q;
                        SP[ai][m >> 1][n] = sP * fP; SQ[ai][m >> 1][n] = sP * fQ + sQ; }
                    else { BP[n] = P; BQ[n] = Q; } }
            }
        }
        if (lane < 16) {
#pragma unroll
            for (int ai = 0; ai < 2; ++ai)
#pragma unroll
                for (int mm = 0; mm < 2; ++mm)
#pragma unroll
                    for (int n = 0; n < 2; ++n) { const int sc = ai * 4 + wr * 2 + mm; const f32x2 pq = (f32x2){SP[ai][mm][n], SQ[ai][mm][n]};
                        *(f32x2*)(agg32 + (((size_t)d * 512 + u.pm * 8 + sc) * D + q * 128 + wc * 32 + 16 * n + cl) * 2) = pq;
                        *(LAS f32x2*)(blk + ((((ai * 2 + mm) * 2 + n) * 16 + cl) * 8)) = pq; }
        }
        asm volatile("" ::: "memory");
        unsigned old = 0u; if (lane == 0) old = __hip_atomic_fetch_add((LAS unsigned*)(lds + A2_CNT_OFF) + wc, 1u, __ATOMIC_RELAXED, __HIP_MEMORY_SCOPE_WORKGROUP);
        old = (unsigned)__builtin_amdgcn_readfirstlane((int)old);
        asm volatile("" ::: "memory");
        if (old & 1u) { float P = 1.f, Q = 0.f; const int l32 = lane & 31;
#pragma unroll
            for (int k = 0; k < 8; ++k) { const int sc = d ? 7 - k : k;
                const f32x2 pq = *(const LAS f32x2*)(lds + A2_BLK_OFF + (((sc >> 1) & 1) * 4 + wc) * A2_BLK_BYTES + ((((sc >> 2) * 2 + (sc & 1)) * 32 + l32) * 8)); Q = pq.x * Q + pq.y; P *= pq.x; }
            if (lane < 32) *(f32x2*)(aggt + (((size_t)d * 64 + u.pm) * D + q * 128 + wc * 32 + l32) * 2) = (f32x2){P, Q}; }
    }
};

struct EpiRes {
    bf16_t* xres; bf16_t* xb; const float* gate; const float* ng; const float* sc; float* sspo;
    __device__ __forceinline__ void operator()(const Acc& acc, const pg8::Unit& u, int wr, int wc, int fr, int fq) const {
        const int row0 = u.pm * 256 + wr * 64 + fr, c0 = u.pn * 256 + wc * 32 + 8 * fq;
        f32x4 gv[2][2], gs[2][2];
#pragma unroll
        for (int bj = 0; bj < 2; ++bj)
#pragma unroll
            for (int n = 0; n < 2; ++n) { gv[bj][n] = *(const f32x4*)(gate + c0 + bj * 128 + 4 * n);
                if (ng) { const f32x4 a = *(const f32x4*)(ng + c0 + bj * 128 + 4 * n), b = *(const f32x4*)(sc + c0 + bj * 128 + 4 * n); gs[bj][n] = a * (b + 1.0f); } else gs[bj][n] = (f32x4){0.f, 0.f, 0.f, 0.f}; }
#pragma unroll
        for (int ai = 0; ai < 2; ++ai) {
            u32x4 xo[1][4][2];
#pragma unroll
            for (int m = 0; m < 4; ++m)
#pragma unroll
                for (int bj = 0; bj < 2; ++bj) xo[0][m][bj] = *(const u32x4*)(xres + (size_t)(row0 + ai * 128 + m * 16) * D + c0 + bj * 128);
#pragma unroll
            for (int m = 0; m < 4; ++m) { const int row = row0 + ai * 128 + m * 16; const size_t off = (size_t)row * D + c0; float ss = 0.f;
#pragma unroll
                for (int bj = 0; bj < 2; ++bj) { const u32x4 w0 = xo[0][m][bj];
                    const f32x4 o0 = (f32x4){bf2f(w0.x & 0xffffu), bf2f(w0.x >> 16), bf2f(w0.y & 0xffffu), bf2f(w0.y >> 16)}, o1 = (f32x4){bf2f(w0.z & 0xffffu), bf2f(w0.z >> 16), bf2f(w0.w & 0xffffu), bf2f(w0.w >> 16)};
                    const f32x4 x0 = o0 + gv[bj][0] * acc[ai][bj][m][0], x1 = o1 + gv[bj][1] * acc[ai][bj][m][1];
                    u32x4 wx; wx.x = cvt_pk_bf16(x0[0], x0[1]); wx.y = cvt_pk_bf16(x0[2], x0[3]); wx.z = cvt_pk_bf16(x1[0], x1[1]); wx.w = cvt_pk_bf16(x1[2], x1[3]);
                    *(u32x4*)(xres + off + bj * 128) = wx;
                    ss += (x0[0] * x0[0] + x0[1] * x0[1]) + (x0[2] * x0[2] + x0[3] * x0[3]) + (x1[0] * x1[0] + x1[1] * x1[1]) + (x1[2] * x1[2] + x1[3] * x1[3]);
                    if (ng) { const f32x4 y0 = x0 * gs[bj][0], y1 = x1 * gs[bj][1]; u32x4 w; w.x = cvt_pk_bf16(y0[0], y0[1]); w.y = cvt_pk_bf16(y0[2], y0[3]); w.z = cvt_pk_bf16(y1[0], y1[1]); w.w = cvt_pk_bf16(y1[2], y1[3]);
                        *(u32x4*)(xb + off + bj * 128) = w; } }
                ss = add_x16(ss); ss = add_x32(ss, XL32(fr, fq));
                if (fq == 0) sspo[(size_t)row * 16 + u.pn * 4 + wc] = ss; }
        }
    }
};

struct EpiB1 {
    bf16_t* GB; bf16_t* Z; const float* bias; const float* ssp;
    __device__ __forceinline__ void operator()(const Acc& acc, const pg8::Unit& u, int wr, int wc, int fr, int fq) const {
        const int row0 = u.pm * 256 + wr * 64 + fr;
        float rs[2][4]; load_rstd(rs, ssp, row0, fr, fq);
        const int bc0 = u.pn * 256 + wc * 32 + 8 * fq;
        f32x4 bv[2][2];
#pragma unroll
        for (int bj = 0; bj < 2; ++bj)
#pragma unroll
            for (int n = 0; n < 2; ++n) bv[bj][n] = *(const f32x4*)(bias + bc0 + bj * 128 + 4 * n);
        if (u.pn < 4) {
#pragma unroll
            for (int ai = 0; ai < 2; ++ai)
#pragma unroll
                for (int m = 0; m < 4; ++m) { bf16_t* rowp = GB + (size_t)(row0 + ai * 128 + m * 16) * D + bc0; const float r = rs[ai][m];
#pragma unroll
                    for (int bj = 0; bj < 2; ++bj) { const f32x4 v0 = acc[ai][bj][m][0] * r + bv[bj][0], v1 = acc[ai][bj][m][1] * r + bv[bj][1];
                        u32x4 w; w.x = cvt_pk_bf16(v0[0], v0[1]); w.y = cvt_pk_bf16(v0[2], v0[3]); w.z = cvt_pk_bf16(v1[0], v1[1]); w.w = cvt_pk_bf16(v1[2], v1[3]);
                        *(u32x4*)(rowp + bj * 128) = w; } }
        } else {
            const int c0 = (u.pn - 4) * 128 + wc * 32 + 8 * fq;
#pragma unroll
            for (int ai = 0; ai < 2; ++ai)
#pragma unroll
                for (int m = 0; m < 4; ++m) { const float r = rs[ai][m];
                    const f32x4 z0 = (acc[ai][0][m][0] * r + bv[0][0]) * (acc[ai][1][m][0] * r + bv[1][0]), z1 = (acc[ai][0][m][1] * r + bv[0][1]) * (acc[ai][1][m][1] * r + bv[1][1]);
                    u32x4 w; w.x = cvt_pk_bf16(z0[0], z0[1]); w.y = cvt_pk_bf16(z0[2], z0[3]); w.z = cvt_pk_bf16(z1[0], z1[1]); w.w = cvt_pk_bf16(z1[2], z1[3]);
                    *(u32x4*)(Z + (size_t)(row0 + ai * 128 + m * 16) * D + c0) = w; }
        }
    }
};

struct EpiF1 {
    bf16_t* Y; const float* bias; const float* ssp; const float* cw; const float* cb;
    __device__ __forceinline__ void operator()(const Acc& acc, const pg8::Unit& u, int wr, int wc, int fr, int fq) const {
        const int row0 = u.pm * 256 + u.hrow + wr * 64 + fr;
        const int bc0 = u.pn * 256 + wc * 32 + 8 * fq, c0 = u.pn * 128 + wc * 32 + 8 * fq;
        f32x4 bg[2], bvv[2], w0[2], w1[2], w2[2], cbv[2];
#pragma unroll
        for (int n = 0; n < 2; ++n) { bg[n] = *(const f32x4*)(bias + bc0 + 4 * n); bvv[n] = *(const f32x4*)(bias + bc0 + 128 + 4 * n);
            w0[n] = *(const f32x4*)(cw + c0 + 4 * n); w1[n] = *(const f32x4*)(cw + DFF + c0 + 4 * n); w2[n] = *(const f32x4*)(cw + 2 * DFF + c0 + 4 * n); cbv[n] = *(const f32x4*)(cb + c0 + 4 * n); }
        float rs[2][4]; load_rstd(rs, ssp, row0, fr, fq);
        const bool first = (fr == 0), lastl = (fr == 15);
#pragma unroll
        for (int ai = 0; ai < 2; ++ai) {
            if (ai >= u.nai) break;
            unsigned pk0[4][2];
#pragma unroll
            for (int n = 0; n < 2; ++n) {
                f32x4 gq[4];
#pragma unroll
                for (int m = 0; m < 4; ++m) gq[m] = acc[ai][0][m][n] * rs[ai][m] + bg[n];
#pragma unroll
                for (int m = 0; m < 4; ++m) {
#define ROR1V(v) ((f32x4){dpp_ror1((v)[0]), dpp_ror1((v)[1]), dpp_ror1((v)[2]), dpp_ror1((v)[3])})
#define ROR15V(v) ((f32x4){dpp_ror15((v)[0]), dpp_ror15((v)[1]), dpp_ror15((v)[2]), dpp_ror15((v)[3])})
                    const f32x4 ls = ROR1V(gq[m]), rsm = ROR15V(gq[m]);
                    f32x4 lf, rt;
                    if (m == 0) lf = first ? (f32x4){0.f, 0.f, 0.f, 0.f} : ls; else { const f32x4 lp = ROR1V(gq[m > 0 ? m - 1 : 0]); lf = first ? lp : ls; }
                    if (m == 3) rt = lastl ? (f32x4){0.f, 0.f, 0.f, 0.f} : rsm; else { const f32x4 rn = ROR15V(gq[m < 3 ? m + 1 : 3]); rt = lastl ? rn : rsm; }
                    const f32x4 gc = cbv[n] + w0[n] * lf + w1[n] * gq[m] + w2[n] * rt;
                    const f32x4 vv = acc[ai][1][m][n] * rs[ai][m] + bvv[n];
                    const f32x4 y = (f32x4){silu_f(gc[0]) * vv[0], silu_f(gc[1]) * vv[1], silu_f(gc[2]) * vv[2], silu_f(gc[3]) * vv[3]};
                    const unsigned p0 = cvt_pk_bf16(y[0], y[1]), p1 = cvt_pk_bf16(y[2], y[3]);
                    if (n == 0) { pk0[m][0] = p0; pk0[m][1] = p1; }
                    else *(u32x4*)(Y + (size_t)(row0 + ai * 128 + m * 16) * DFF + c0) = (u32x4){pk0[m][0], pk0[m][1], p0, p1}; }
            }
        }
    }
};

#define XB_TMO      128
#define XB_XCNT(j)  (256  + 64 * (j))
#define XB_XSUB(j)  (1280 + 64 * (j))
#define XB_XGEN(j)  (2304 + 64 * (j))
#define XB_TOP      3328
#define XB_TOPGEN   3392
#define XCD_BAR_WORDS 3456
#define XB_SPIN_CAP (1u << 18)
__device__ __forceinline__ unsigned xb_ld(unsigned* p)              { return __hip_atomic_load(p, __ATOMIC_RELAXED, __HIP_MEMORY_SCOPE_AGENT); }
__device__ __forceinline__ unsigned xb_add(unsigned* p, unsigned v) { return __hip_atomic_fetch_add(p, v, __ATOMIC_RELAXED, __HIP_MEMORY_SCOPE_AGENT); }
__device__ __forceinline__ unsigned xb_xcc_id() { return (unsigned)__builtin_amdgcn_s_getreg((3 << 11) | 20) & 0xFu; }
#define XB_SPIN(cond, bar) do { unsigned _sp = 0; while (cond) { __builtin_amdgcn_s_sleep(1); \
    if ((++_sp & 255u) == 0u) { if (xb_ld(&(bar)[XB_TMO])) break; if (_sp > XB_SPIN_CAP) { atomicAdd(&(bar)[XB_TMO], 1u); break; } } } } while (0)
struct XcdBarrier { unsigned* bar; unsigned x; volatile LAS unsigned* st; };
__device__ __forceinline__ XcdBarrier xcd_barrier_post(unsigned* bar, volatile LAS unsigned* st) {
    XcdBarrier b; b.bar = bar; b.x = xb_xcc_id(); b.st = st;
    if (threadIdx.x == 0) (void)xb_add(&bar[XB_XCNT(b.x)], 1u);
    return b;
}
__device__ __forceinline__ void xcd_barrier_complete(unsigned* bar, unsigned x, unsigned& nloc, unsigned& nx) {
    const unsigned G = gridDim.x * gridDim.y * gridDim.z;
    unsigned sum, cnt, mine, sp = 0u;
    for (;;) {
        sum = 0u; cnt = 0u; mine = 0u;
#pragma unroll
        for (unsigned j = 0; j < 16; ++j) { const unsigned c = xb_ld(&bar[XB_XCNT(j)]); sum += c; cnt += (c > 0u) ? 1u : 0u; mine = (j == x) ? c : mine; }
        if (sum == G) break;
        __builtin_amdgcn_s_sleep(1);
        if ((++sp & 255u) == 0u) { if (xb_ld(&bar[XB_TMO])) break; if (sp > XB_SPIN_CAP) { atomicAdd(&bar[XB_TMO], 1u); break; } }
    }
    nloc = mine > 0u ? mine : 1u; nx = cnt > 0u ? cnt : 1u;
}
__device__ __forceinline__ void xcd_barrier(const XcdBarrier& b) {
    asm volatile("s_waitcnt vmcnt(0)" ::: "memory");
    __syncthreads();
    if (threadIdx.x == 0) {
        unsigned* bar = b.bar;
        __builtin_amdgcn_s_waitcnt(0);
        unsigned nloc = b.st[0], nx = b.st[1];
        if (nloc == 0u) { xcd_barrier_complete(bar, b.x, nloc, nx); b.st[0] = nloc; b.st[1] = nx; }
        const unsigned old = xb_add(&bar[XB_XSUB(b.x)], 1u);
        const unsigned gen = old / nloc;
        if (old + 1u == (gen + 1u) * nloc) {
            __builtin_amdgcn_fence(__ATOMIC_RELEASE, "agent");
            asm volatile("s_waitcnt vmcnt(0)" ::: "memory");
            const unsigned og = xb_add(&bar[XB_TOP], 1u);
            const unsigned tg = og / nx;
            if (og + 1u == (tg + 1u) * nx) xb_add(&bar[XB_TOPGEN], 1u);
            else XB_SPIN(xb_ld(&bar[XB_TOPGEN]) == tg, bar);
            __builtin_amdgcn_fence(__ATOMIC_ACQUIRE, "agent");
            xb_add(&bar[XB_XGEN(b.x)], 1u);
            asm volatile("s_waitcnt vmcnt(0)" ::: "memory");
        } else {
            XB_SPIN(xb_ld(&bar[XB_XGEN(b.x)]) == gen, bar);
            __builtin_amdgcn_fence(__ATOMIC_ACQUIRE, "agent");
            asm volatile("s_waitcnt vmcnt(0)" ::: "memory");
        }
    }
    __syncthreads();
}

struct Args { const float* in[N_IN]; float* out; unsigned char* ws; int ph_lo, ph_hi; };
struct Ctx {
    const float* const* in; float* out; unsigned char* ws; LAS unsigned char* lds;
    int tid, lane, wave, G, bid;
};
#define WSP(type, off) ((type*)(C.ws + (off)))
#define INP(i) (C.in[i])
#define LDS_WAIT() asm volatile("s_waitcnt lgkmcnt(0)" ::: "memory")

__device__ __forceinline__ void p0_adaln(const Ctx& C, int item) {
    LAS float* sv = (LAS float*)C.lds;
    LAS float* red = (LAS float*)(C.lds + 8192);
    const int l = item / 48, cbk = item % 48;
    for (int i = C.tid; i < 2048; i += 512) { const float v = i < 1024 ? INP(IX_C)[i] : INP(IX_CCTX)[i - 1024]; sv[i] = silu_f(v); }
    __syncthreads();
    const float* W = INP(IX_ADAW) + (size_t)l * D * NMOD + cbk * 128 + 2 * C.lane;
    const int k0 = C.wave * 128;
    f32x2 a0 = {0.f, 0.f}, a1 = {0.f, 0.f};
#pragma unroll 16
    for (int k = 0; k < 128; ++k) { const f32x2 w = *(const f32x2*)(W + (size_t)(k0 + k) * NMOD); const float s0 = sv[k0 + k], s1 = sv[1024 + k0 + k]; a0 += w * s0; a1 += w * s1; }
    red[(C.wave * 2 + 0) * 128 + 2 * C.lane] = a0.x; red[(C.wave * 2 + 0) * 128 + 2 * C.lane + 1] = a0.y;
    red[(C.wave * 2 + 1) * 128 + 2 * C.lane] = a1.x; red[(C.wave * 2 + 1) * 128 + 2 * C.lane + 1] = a1.y;
    __syncthreads();
    if (C.tid < 256) { const int s = C.tid >> 7, c = C.tid & 127; float v = INP(IX_ADAB)[l * NMOD + cbk * 128 + c];
#pragma unroll
        for (int w = 0; w < 8; ++w) v += red[(w * 2 + s) * 128 + c];
        WSP(float, WS_MODS)[(size_t)(l * 2 + s) * NMOD + cbk * 128 + c] = v; }
    __syncthreads();
}
struct WBlk { const float* src; int ld, c0, K; bf16_t* dst; };
__device__ __forceinline__ WBlk get_wblk(const Ctx& C, int cls, int vb) {
    WBlk w;
    if (cls == 0) {
        w.K = 1024;
        if (vb < 48) { const int j = vb / 24, r = vb % 24;
            if (r < 16) { w.src = (r < 8 ? INP(IX_AWX) : INP(IX_AWG)) + (size_t)j * D * D; w.ld = D; w.c0 = (r & 7) * 128; w.dst = WSP(bf16_t, W_A1 + j * SZ_A1) + (size_t)r * 128 * 1024; }
            else { const int rr = r - 16; w.src = INP(IX_AWO) + (size_t)j * D * D; w.ld = D; w.c0 = rr * 128; w.dst = WSP(bf16_t, W_A3 + j * SZ_A3) + (size_t)rr * 128 * 1024; }
        } else if (vb < 112) { const int bb = vb - 48, j = bb / 32, r = bb % 32;
            if (r < 24) { int c0; if (r < 8) c0 = r * 128; else { const int rr = r - 8; c0 = 1024 + (rr & 1) * 1024 + (rr >> 1) * 128; }
                w.src = INP(IX_BWIN) + (size_t)j * D * 3072; w.ld = 3072; w.c0 = c0; w.dst = WSP(bf16_t, W_B1 + j * SZ_B1) + (size_t)r * 128 * 1024; }
            else { const int rr = r - 24; w.src = INP(IX_BWO) + (size_t)j * D * D; w.ld = D; w.c0 = rr * 128; w.dst = WSP(bf16_t, W_B2 + j * SZ_B2) + (size_t)rr * 128 * 1024; }
        } else { const int bb = vb - 112, l = bb / 44, r = bb % 44;
            w.src = INP(IX_FWU) + (size_t)l * D * 2 * DFF; w.ld = 2 * DFF; w.c0 = (r & 1) * DFF + (r >> 1) * 128; w.dst = WSP(bf16_t, W_F1 + l * SZ_F1) + (size_t)r * 128 * 1024; }
    } else if (cls == 1) {
        const int j = vb / 32, rr = vb % 32, pn = rr >> 1, mem = rr & 1, d = pn >> 3, q = pn & 7, h = q >> 1, half = q & 1;
        w.K = 256; w.src = (mem ? INP(IX_AWI) : INP(IX_AWR)) + (size_t)(((j * 2 + d) * 4 + h)) * 65536; w.ld = 256; w.c0 = half * 128;
        w.dst = WSP(bf16_t, W_A2 + j * SZ_A2) + (size_t)(pn * 256 + mem * 128) * 256;
    } else {
        const int l = vb / 8, rr = vb % 8;
        w.K = DFF; w.src = INP(IX_FWD) + (size_t)l * DFF * D; w.ld = D; w.c0 = rr * 128; w.dst = WSP(bf16_t, W_F2 + l * SZ_F2) + (size_t)rr * 128 * DFF;
    }
    return w;
}
__device__ __forceinline__ void p0_transpose(const WBlk& w, int rg, int kb, LAS float* scr, int lane) {
    const int k0 = 64 * kb, n0 = 32 * rg;
    { const int r8 = lane >> 3, c4 = lane & 7; f32x4 v[8];
#pragma unroll
        for (int i = 0; i < 8; ++i) v[i] = *(const f32x4*)(w.src + (size_t)(k0 + 8 * i + r8) * w.ld + w.c0 + n0 + 4 * c4);
#pragma unroll
        for (int i = 0; i < 8; ++i) { LAS float* d = scr + (8 * i + r8) * 33 + 4 * c4; d[0] = v[i].x; d[1] = v[i].y; d[2] = v[i].z; d[3] = v[i].w; } }
    LDS_WAIT(); asm volatile("" ::: "memory");
    const int c = lane & 7;
#pragma unroll
    for (int j = 0; j < 4; ++j) { const int n = (lane >> 3) + 8 * j; const LAS float* s = scr + (8 * c) * 33 + n;
        u32x4 o; o.x = cvt_pk_bf16(s[0 * 33], s[1 * 33]); o.y = cvt_pk_bf16(s[2 * 33], s[3 * 33]); o.z = cvt_pk_bf16(s[4 * 33], s[5 * 33]); o.w = cvt_pk_bf16(s[6 * 33], s[7 * 33]);
        *(u32x4*)(w.dst + (size_t)(n0 + n) * w.K + k0 + 8 * c) = o; }
    LDS_WAIT(); asm volatile("" ::: "memory");
}
__device__ __forceinline__ void phase_p0(const Ctx& C) {
    for (int it = C.bid; it < 192; it += C.G) p0_adaln(C, it);
    LAS float* scr = (LAS float*)(C.lds + C.wave * 16384);
    const int gw = C.bid * 8 + C.wave, NGW = C.G * 8;
    constexpr int N0 = 288 * 16, N1 = 64 * 4, N2 = 32 * 44;
    for (int it = gw; it < N0 + N1 + N2; it += NGW) {
        int cls, vb, rg, kc;
        if (it < N0) { cls = 0; vb = it >> 4; rg = (it >> 2) & 3; kc = it & 3; }
        else if (it < N0 + N1) { const int r = it - N0; cls = 1; vb = r >> 2; rg = r & 3; kc = 0; }
        else { const int r = it - N0 - N1; cls = 2; vb = r / 44; const int rem = r % 44; rg = rem / 11; kc = rem % 11; }
        const WBlk w = get_wblk(C, cls, vb);
        for (int kb = 4 * kc; kb < 4 * kc + 4; ++kb) p0_transpose(w, rg, kb, scr, C.lane);
    }
}

__device__ __forceinline__ size_t cf_off(int t, int c, int K) { return ((size_t)((t >> 4) * (K >> 5) + (c >> 5)) << 9) + (size_t)((((c >> 3) & 3) << 4) + (t & 15)) * 8 + (c & 7); }
__device__ __forceinline__ void p1_rows4(const float* __restrict__ xbase, bf16_t* __restrict__ obase, bf16_t* __restrict__ rbase, float* __restrict__ ssbase, int nss, const f32x4 (&gs)[4], int r0, int lane, bool frag) {
    f32x4 v[4][4];
#pragma unroll
    for (int q = 0; q < 4; ++q)
#pragma unroll
        for (int j = 0; j < 4; ++j) v[q][j] = ((const f32x4*)(xbase + (size_t)(r0 + q) * D) + lane)[64 * j];
#pragma unroll
    for (int q = 0; q < 4; ++q) { float s = 0.f;
#pragma unroll
        for (int j = 0; j < 4; ++j) s += (v[q][j].x * v[q][j].x + v[q][j].y * v[q][j].y) + (v[q][j].z * v[q][j].z + v[q][j].w * v[q][j].w);
        s = wave_sum(s);
        if (lane < nss) ssbase[(size_t)(r0 + q) * nss + lane] = lane == 0 ? s : 0.f;
#pragma unroll
        for (int j = 0; j < 4; ++j) { const f32x4 y = v[q][j] * gs[j]; u32x2 w; w.x = cvt_pk_bf16(y.x, y.y); w.y = cvt_pk_bf16(y.z, y.w); *(u32x2*)(obase + (frag ? cf_off(r0 + q, 4 * lane + 256 * j, D) : (size_t)(r0 + q) * D + 4 * lane + 256 * j)) = w;
            if (rbase) { u32x2 r; r.x = cvt_pk_bf16(v[q][j].x, v[q][j].y); r.y = cvt_pk_bf16(v[q][j].z, v[q][j].w); ((u32x2*)(rbase + (size_t)(r0 + q) * D) + lane)[64 * j] = r; } } }
}
__device__ __forceinline__ void phase_p1(const Ctx& C) {
    const int gw = C.bid * 8 + C.wave, NGW = C.G * 8;
    const float* __restrict__ mods = WSP(float, WS_MODS);
    for (int s = 0; s < 2; ++s) {
        f32x4 gs[4];
#pragma unroll
        for (int j = 0; j < 4; ++j) gs[j] = *((const f32x4*)INP(IX_NMG) + C.lane + 64 * j) * (*((const f32x4*)(mods + (size_t)s * NMOD + 1024) + C.lane + 64 * j) + 1.0f);
        const int nrow = s ? CT : T;
        for (int r0 = gw * 4; r0 < nrow; r0 += NGW * 4)
            p1_rows4(s ? INP(IX_CTX) : INP(IX_X), s ? WSP(bf16_t, CX_XB) : WSP(bf16_t, WS_SLOT), s ? nullptr : WSP(bf16_t, WS_XRES), s ? WSP(float, CX_SSP) : WSP(float, WS_SSP), s ? 64 : 16, gs, r0, C.lane, s != 0);
    }
    for (int rb = gw; rb < 2048; rb += NGW) {
        const int r = rb * 16; const bf16_t* __restrict__ bt; int l, shoff; float* __restrict__ outp; int ostride;
        if (r < 4096) { const int j = r / 2048, n = r % 2048; bt = WSP(bf16_t, W_A1 + j * SZ_A1) + (size_t)n * 1024; l = 2 * j; shoff = 0; outp = WSP(float, WS_BIASM) + (size_t)(l * 2) * 3072 + n; ostride = 3072; }
        else if (r < 10240) { const int rr = r - 4096, j = rr / 3072, n = rr % 3072; bt = WSP(bf16_t, W_B1 + j * SZ_B1) + (size_t)n * 1024; l = 2 * j + 1; shoff = 0; outp = WSP(float, WS_BIASM) + (size_t)(l * 2) * 3072 + n; ostride = 3072; }
        else { const int rr = r - 10240; l = rr / 5632; const int n = rr % 5632; bt = WSP(bf16_t, W_F1 + l * SZ_F1) + (size_t)n * 1024; shoff = 3072; outp = WSP(float, WS_BIASF) + (size_t)(l * 2) * 5632 + n; ostride = 5632; }
        f32x4 sh[2][2][2];
#pragma unroll
        for (int st = 0; st < 2; ++st)
#pragma unroll
            for (int h = 0; h < 2; ++h) { const float* p = mods + (size_t)(l * 2 + st) * NMOD + shoff + h * 512 + 8 * C.lane; sh[st][h][0] = *(const f32x4*)p; sh[st][h][1] = *(const f32x4*)(p + 4); }
#pragma unroll 1
        for (int b4 = 0; b4 < 4; ++b4) {
            u32x4 wv[4][2];
#pragma unroll
            for (int q = 0; q < 4; ++q)
#pragma unroll
                for (int h = 0; h < 2; ++h) wv[q][h] = *(const u32x4*)(bt + (size_t)(b4 * 4 + q) * 1024 + h * 512 + 8 * C.lane);
#pragma unroll
            for (int q = 0; q < 4; ++q) { float a0 = 0.f, a1 = 0.f;
#pragma unroll
                for (int h = 0; h < 2; ++h) { const u32x4 w = wv[q][h];
                    const f32x4 lo = (f32x4){bf2f(w.x & 0xffffu), bf2f(w.x >> 16), bf2f(w.y & 0xffffu), bf2f(w.y >> 16)}, hi = (f32x4){bf2f(w.z & 0xffffu), bf2f(w.z >> 16), bf2f(w.w & 0xffffu), bf2f(w.w >> 16)};
                    const f32x4 p0 = lo * sh[0][h][0] + hi * sh[0][h][1], p1 = lo * sh[1][h][0] + hi * sh[1][h][1];
                    a0 += (p0.x + p0.y) + (p0.z + p0.w); a1 += (p1.x + p1.y) + (p1.z + p1.w); }
                a0 = wave_sum(a0); a1 = wave_sum(a1);
                if (C.lane == 0) { outp[b4 * 4 + q] = a0; outp[ostride + b4 * 4 + q] = a1; } }
        }
    }
    for (int i = C.bid * 512 + C.tid; i < 4096; i += C.G * 512) { const float x = INP(IX_ALAM)[i]; const float ls = fminf(x, 0.f) - log1pf(expf(-fabsf(x))); WSP(float, WS_LA8)[i] = 8.0f * 1.4426950409f * ls; }
}

__device__ __forceinline__ void phase_conv4(const Ctx& C, const bf16_t* __restrict__ UPRE, bf16_t* __restrict__ U, const float* __restrict__ cw, const float* __restrict__ cb) {
    const int cg = C.tid & 127, sub = C.tid >> 7, c0 = cg * 8;
    float w[4][8], b[8];
#pragma unroll
    for (int k = 0; k < 4; ++k)
#pragma unroll
        for (int e = 0; e < 8; ++e) w[k][e] = cw[k * D + c0 + e];
#pragma unroll
    for (int e = 0; e < 8; ++e) b[e] = cb[c0 + e];
    for (int it = C.bid; it < T / 64; it += C.G) {
        const int t0 = it * 64 + sub * 16;
        float win[3][8];
#pragma unroll
        for (int r = 0; r < 3; ++r) { const int t = t0 - 2 + r; u32x4 v = *(const u32x4*)(UPRE + (size_t)(t >= 0 ? t : 0) * D + c0); if (t < 0) v = (u32x4){0u, 0u, 0u, 0u};
            win[r][0] = bf2f(v.x & 0xffffu); win[r][1] = bf2f(v.x >> 16); win[r][2] = bf2f(v.y & 0xffffu); win[r][3] = bf2f(v.y >> 16); win[r][4] = bf2f(v.z & 0xffffu); win[r][5] = bf2f(v.z >> 16); win[r][6] = bf2f(v.w & 0xffffu); win[r][7] = bf2f(v.w >> 16); }
#pragma unroll
        for (int i = 0; i < 16; ++i) { const int t = t0 + i; u32x4 v = *(const u32x4*)(UPRE + (size_t)(t + 1 < T ? t + 1 : T - 1) * D + c0); if (t + 1 >= T) v = (u32x4){0u, 0u, 0u, 0u};
            const float nx[8] = {bf2f(v.x & 0xffffu), bf2f(v.x >> 16), bf2f(v.y & 0xffffu), bf2f(v.y >> 16), bf2f(v.z & 0xffffu), bf2f(v.z >> 16), bf2f(v.w & 0xffffu), bf2f(v.w >> 16)};
            float o[8];
#pragma unroll
            for (int e = 0; e < 8; ++e) { o[e] = b[e] + w[0][e] * win[0][e] + w[1][e] * win[1][e] + w[2][e] * win[2][e] + w[3][e] * nx[e]; win[0][e] = win[1][e]; win[1][e] = win[2][e]; win[2][e] = nx[e]; }
            u32x4 ow; ow.x = cvt_pk_bf16(o[0], o[1]); ow.y = cvt_pk_bf16(o[2], o[3]); ow.z = cvt_pk_bf16(o[4], o[5]); ow.w = cvt_pk_bf16(o[6], o[7]);
            *(u32x4*)(U + (size_t)t * D + c0) = ow; }
    }
}
__device__ __forceinline__ void phase_vconv(const Ctx& C, const bf16_t* __restrict__ GB, const bf16_t* __restrict__ Z, bf16_t* __restrict__ Q, const float* __restrict__ cw, const float* __restrict__ cb) {
    const int cg = C.tid & 127, sub = C.tid >> 7, c0 = cg * 8;
    float w[3][8], b[8];
#pragma unroll
    for (int k = 0; k < 3; ++k)
#pragma unroll
        for (int e = 0; e < 8; ++e) w[k][e] = cw[k * D + c0 + e];
#pragma unroll
    for (int e = 0; e < 8; ++e) b[e] = cb[c0 + e];
    const int vb = (C.G & 7) == 0 ? (C.bid & 7) * (C.G >> 3) + (C.bid >> 3) : C.bid;
    for (int it = vb; it < T / 64; it += C.G) {
        const int t0 = it * 64 + sub * 16;
        const bool lo_ok = it > 0, hi_ok = it < T / 64 - 1;
        const long om = lo_ok ? -(long)64 * D : 0, op = hi_ok ? (long)64 * D : 0; const float ml = lo_ok ? 1.f : 0.f, mh = hi_ok ? 1.f : 0.f;
#pragma unroll 8
        for (int i = 0; i < 16; ++i) { const int t = t0 + i; const size_t off = (size_t)t * D + c0;
            const u32x4 g = *(const u32x4*)(GB + off), z1 = *(const u32x4*)(Z + off);
            const u32x4 z0 = *(const u32x4*)(Z + (long)off + om), z2 = *(const u32x4*)(Z + (long)off + op);
            const unsigned gw[4] = {g.x, g.y, g.z, g.w}, a0[4] = {z0.x, z0.y, z0.z, z0.w}, a1[4] = {z1.x, z1.y, z1.z, z1.w}, a2[4] = {z2.x, z2.y, z2.z, z2.w};
            unsigned ow[4];
#pragma unroll
            for (int p = 0; p < 4; ++p) {
                const float lo = bf2f(gw[p] & 0xffffu) * (b[2 * p] + ml * w[0][2 * p] * bf2f(a0[p] & 0xffffu) + w[1][2 * p] * bf2f(a1[p] & 0xffffu) + mh * w[2][2 * p] * bf2f(a2[p] & 0xffffu));
                const float hi = bf2f(gw[p] >> 16) * (b[2 * p + 1] + ml * w[0][2 * p + 1] * bf2f(a0[p] >> 16) + w[1][2 * p + 1] * bf2f(a1[p] >> 16) + mh * w[2][2 * p + 1] * bf2f(a2[p] >> 16));
                ow[p] = cvt_pk_bf16(lo, hi); }
            *(u32x4*)(Q + off) = (u32x4){ow[0], ow[1], ow[2], ow[3]}; }
    }
}

typedef _Float16 h16x8 __attribute__((ext_vector_type(8)));
__device__ __forceinline__ void eb_unpack(u32x4 w, f32x4& a, f32x4& b) {
    const h16x8 h = __builtin_bit_cast(h16x8, w);
    a = (f32x4){1.0f - (float)h[0], 1.0f - (float)h[2], 1.0f - (float)h[4], 1.0f - (float)h[6]}; b = (f32x4){(float)h[1], (float)h[3], (float)h[5], (float)h[7]};
}
__device__ __forceinline__ void phase_scan1(const Ctx& C, const h16* __restrict__ EB) {
    LAS float* lagg = (LAS float*)C.lds;
    for (int task = C.bid; task < 256; task += C.G) {
        const int j = task >> 2, cbk = task & 3, ch = cbk * 256 + 4 * C.lane, r0 = j * 256 + 32 * C.wave;
#pragma unroll
        for (int d = 0; d < 2; ++d) {
            const h16* e = EB + (((size_t)d * T + r0) * D + ch) * 2;
            f32x4 P = {1.f, 1.f, 1.f, 1.f}, Q = {0.f, 0.f, 0.f, 0.f};
            u32x4 ev[32];
#pragma unroll
            for (int i = 0; i < 32; ++i) ev[i] = *(const u32x4*)(e + (size_t)i * D * 2);
#pragma unroll
            for (int i = 0; i < 32; ++i) { const int ii = d ? 31 - i : i; f32x4 a, bb; eb_unpack(ev[ii], a, bb); P = P * a; Q = a * Q + bb; }
            float* ag = WSP(float, WS_AGG32) + (((size_t)d * 512 + j * 8 + C.wave) * D + ch) * 2;
            *(f32x4*)ag = (f32x4){P[0], Q[0], P[1], Q[1]}; *(f32x4*)(ag + 4) = (f32x4){P[2], Q[2], P[3], Q[3]};
            LAS float* la = lagg + ((d * 8 + C.wave) * 256 + 4 * C.lane) * 2;
            *(LAS f32x4*)la = (f32x4){P[0], Q[0], P[1], Q[1]}; *(LAS f32x4*)(la + 4) = (f32x4){P[2], Q[2], P[3], Q[3]};
        }
        __syncthreads();
        { const int d = C.tid >> 8, c = C.tid & 255; float P = 1.f, Q = 0.f;
#pragma unroll
            for (int i = 0; i < 8; ++i) { const int w = d ? 7 - i : i; const f32x2 pq = *(const LAS f32x2*)(lagg + ((d * 8 + w) * 256 + c) * 2); Q = pq.x * Q + pq.y; P *= pq.x; }
            *(f32x2*)(WSP(float, WS_AGGT) + (((size_t)d * 64 + j) * D + cbk * 256 + c) * 2) = (f32x2){P, Q}; }
        __syncthreads();
    }
}
__device__ __forceinline__ void phase_scan2(const Ctx& C, const h16* __restrict__ EB, const bf16_t* __restrict__ Gt, bf16_t* __restrict__ GS, const float* __restrict__ h0) {
    LAS float* cin = (LAS float*)(C.lds + RING_BYTES + 1024);
    LAS unsigned char* hbw = C.lds + C.wave * 16384 + 8 * C.lane;
    for (int task = C.bid; task < 256; task += C.G) {
        const int j = task >> 2, cbk = task & 3;
        const int ch = cbk * 256 + 4 * C.lane, r0 = j * 256 + 32 * C.wave;
        u32x4 ev[32];
        { const h16* e = EB + (((size_t)T + r0) * D + ch) * 2;
#pragma unroll
            for (int i = 0; i < 32; ++i) ev[i] = *(const u32x4*)(e + (size_t)i * D * 2); }
        { int tid_ = C.tid; asm volatile("" : "+v"(tid_));
            const int d = tid_ >> 8, c = tid_ & 255, chn = cbk * 256 + c; float h = h0[d * D + chn];
            const int n = d ? 63 - j : j; const float* base = WSP(float, WS_AGGT) + ((size_t)d * 64 * D + chn) * 2;
            for (int i = 0; i < n; i += 16) { f32x2 pq[16];
#pragma unroll
                for (int u = 0; u < 16; ++u) { const int ii = i + u; const int im = ii < n ? ii : n - 1; const int jj = d ? 63 - im : im; pq[u] = *(const f32x2*)(base + (size_t)jj * D * 2); if (ii >= n) pq[u] = (f32x2){1.f, 0.f}; }
#pragma unroll
                for (int u = 0; u < 16; ++u) h = pq[u].x * h + pq[u].y; }
            cin[d * 256 + c] = h; }
        __syncthreads();
        f32x4 hc[2];
#pragma unroll
        for (int d = 0; d < 2; ++d) { f32x4 h = *(const LAS f32x4*)(cin + d * 256 + 4 * C.lane); const int n = d ? 7 - C.wave : C.wave;
            f32x4 pq[7][2];
#pragma unroll
            for (int u = 0; u < 7; ++u) { const int im = u < n ? u : (n > 0 ? n - 1 : 0); const int w = d ? 7 - im : im; const float* ag = WSP(float, WS_AGG32) + (((size_t)d * 512 + j * 8 + w) * D + ch) * 2; pq[u][0] = *(const f32x4*)ag; pq[u][1] = *(const f32x4*)(ag + 4); }
#pragma unroll
            for (int u = 0; u < 7; ++u) if (u < n) { h[0] = pq[u][0][0] * h[0] + pq[u][0][1]; h[1] = pq[u][0][2] * h[1] + pq[u][0][3]; h[2] = pq[u][1][0] * h[2] + pq[u][1][1]; h[3] = pq[u][1][2] * h[3] + pq[u][1][3]; }
            hc[d] = h; }
        { f32x4 h = hc[1];
#pragma unroll
            for (int i = 31; i >= 0; --i) { f32x4 a, bb; eb_unpack(ev[i], a, bb); h = a * h + bb;
                u32x2 w; w.x = cvt_pk_bf16(h[0], h[1]); w.y = cvt_pk_bf16(h[2], h[3]); *(LAS u32x2*)(hbw + i * 512) = w; } }
        { f32x4 h = hc[0]; const h16* e = EB + ((size_t)r0 * D + ch) * 2;
#pragma unroll
            for (int hb2 = 0; hb2 < 2; ++hb2) { u32x2 gv[16];
#pragma unroll
                for (int i = 0; i < 16; ++i) { ev[i] = *(const u32x4*)(e + (size_t)(16 * hb2 + i) * D * 2); gv[i] = *(const u32x2*)(Gt + (size_t)(r0 + 16 * hb2 + i) * D + ch); }
#pragma unroll
                for (int i = 0; i < 16; ++i) { f32x4 a, bb; eb_unpack(ev[i], a, bb); h = a * h + bb;
                    const f32x4 hb = bf4_to_f4(*(const LAS u32x2*)(hbw + (16 * hb2 + i) * 512)); const f32x4 o = bf4_to_f4(gv[i]) * (h + hb);
                    u32x2 w; w.x = cvt_pk_bf16(o[0], o[1]); w.y = cvt_pk_bf16(o[2], o[3]); *(u32x2*)(GS + (size_t)(r0 + 16 * hb2 + i) * D + ch) = w; } } }
        __syncthreads();
    }
}
__device__ __forceinline__ void phase_final(const Ctx& C, const float* __restrict__ ssp) {
    const int gw = C.bid * 8 + C.wave, NGW = C.G * 8;
    const bf16_t* __restrict__ xres = WSP(bf16_t, WS_XRES); float* __restrict__ out = C.out; const float* __restrict__ fg = INP(IX_FG);
    f32x4 g[4];
#pragma unroll
    for (int j = 0; j < 4; ++j) g[j] = *((const f32x4*)fg + C.lane + 64 * j);
    for (int r0 = gw * 4; r0 < T; r0 += NGW * 4) {
        u32x2 xv[4][4]; float sv[4];
#pragma unroll
        for (int q = 0; q < 4; ++q) { { const float v_ = ssp[(size_t)(r0 + q) * 16 + (C.lane & 15)]; sv[q] = C.lane < 16 ? v_ : 0.f; }
#pragma unroll
            for (int j = 0; j < 4; ++j) xv[q][j] = ((const u32x2*)(xres + (size_t)(r0 + q) * D) + C.lane)[64 * j]; }
#pragma unroll
        for (int q = 0; q < 4; ++q) { const float rstd = 1.0f / sqrtf(wave_sum(sv[q]) * (1.0f / D) + EPS); f32x4* orow = (f32x4*)(out + (size_t)(r0 + q) * D) + C.lane;
#pragma unroll
            for (int j = 0; j < 4; ++j) orow[64 * j] = bf4_to_f4(xv[q][j]) * rstd * g[j]; }
    }
}
template <int NB, int UNR, int K>
__device__ __forceinline__ void ctx_mm(f32x4 (&acc)[2][NB], const bf16_t* A, int lda, const bf16_t* const (&Bp)[NB], int wave, int lane, int tid, LAS unsigned char* lds) {
    const int fr = lane & 15, fq = lane >> 4;
    constexpr int ROWB = K * 2 + 16, PPT = K / 256, NK = K / 32;
    const bf16_t* a0 = A + (size_t)(2 * wave) * lda * 16 + lane * 8; const bf16_t* a1 = a0 + (size_t)lda * 16;
    bf16x8 af[UNR][2];
    {   u32x4 stg[NB][PPT];
#pragma unroll
        for (int nb = 0; nb < NB; ++nb)
#pragma unroll
            for (int q = 0; q < PPT; ++q) { const int p = tid + 512 * q, r = p / (K / 8), kc = p % (K / 8); stg[nb][q] = *(const u32x4*)(Bp[nb] + (size_t)r * K + kc * 8); }
        __builtin_amdgcn_sched_barrier(0);
#pragma unroll
        for (int u = 0; u < UNR; ++u) { af[u][0] = *(const bf16x8*)(a0 + u * 512); af[u][1] = *(const bf16x8*)(a1 + u * 512); }
        __builtin_amdgcn_sched_barrier(0);
#pragma unroll
        for (int nb = 0; nb < NB; ++nb)
#pragma unroll
            for (int q = 0; q < PPT; ++q) { const int p = tid + 512 * q, r = p / (K / 8), kc = p % (K / 8); *(LAS u32x4*)(lds + (nb * 16 + r) * ROWB + kc * 16) = stg[nb][q]; } }
#pragma unroll
    for (int nb = 0; nb < NB; ++nb) { acc[0][nb] = (f32x4){0.f, 0.f, 0.f, 0.f}; acc[1][nb] = (f32x4){0.f, 0.f, 0.f, 0.f}; }
    __syncthreads();
    const LAS unsigned char* bl = lds + fr * ROWB + fq * 16;
#pragma unroll
    for (int kk = 0; kk < NK; ++kk) { constexpr int dummy = 0; (void)dummy; const int u = kk % UNR;
#pragma unroll
        for (int nb = 0; nb < NB; ++nb) { const bf16x8 bf = *(const LAS bf16x8*)(bl + nb * 16 * ROWB + kk * 64);
            acc[0][nb] = __builtin_amdgcn_mfma_f32_16x16x32_bf16(bf, af[u][0], acc[0][nb], 0, 0, 0); acc[1][nb] = __builtin_amdgcn_mfma_f32_16x16x32_bf16(bf, af[u][1], acc[1][nb], 0, 0, 0); }
        __builtin_amdgcn_sched_barrier(0);
        if (kk + UNR < NK) { af[u][0] = *(const bf16x8*)(a0 + (kk + UNR) * 512); af[u][1] = *(const bf16x8*)(a1 + (kk + UNR) * 512); }
        __builtin_amdgcn_sched_barrier(0);
    }
    __syncthreads();
}
template <int UNR, int K>
__device__ __forceinline__ void ctx_mm1(f32x4& acc, const bf16_t* A, int lda, const bf16_t* Bp, int row0, int lane, int tid, LAS unsigned char* lds) {
    const int fr = lane & 15, fq = lane >> 4;
    constexpr int ROWB = K * 2 + 16, PPT = K / 256, NK = K / 32;
    const bf16_t* a0 = A + (size_t)(row0 >> 4) * lda * 16 + lane * 8;
    bf16x8 af[UNR];
    {   u32x4 stg[PPT];
#pragma unroll
        for (int q = 0; q < PPT; ++q) { const int p = tid + 512 * q, r = p / (K / 8), kc = p % (K / 8); stg[q] = *(const u32x4*)(Bp + (size_t)r * K + kc * 8); }
        __builtin_amdgcn_sched_barrier(0);
#pragma unroll
        for (int u = 0; u < UNR; ++u) af[u] = *(const bf16x8*)(a0 + u * 512);
        __builtin_amdgcn_sched_barrier(0);
#pragma unroll
        for (int q = 0; q < PPT; ++q) { const int p = tid + 512 * q, r = p / (K / 8), kc = p % (K / 8); *(LAS u32x4*)(lds + r * ROWB + kc * 16) = stg[q]; } }
    acc = (f32x4){0.f, 0.f, 0.f, 0.f};
    __syncthreads();
    const LAS unsigned char* bl = lds + fr * ROWB + fq * 16;
#pragma unroll
    for (int kk = 0; kk < NK; ++kk) { const int u = kk % UNR;
        { const bf16x8 bf = *(const LAS bf16x8*)(bl + kk * 64); acc = __builtin_amdgcn_mfma_f32_16x16x32_bf16(bf, af[u], acc, 0, 0, 0); }
        __builtin_amdgcn_sched_barrier(0);
        if (kk + UNR < NK) af[u] = *(const bf16x8*)(a0 + (kk + UNR) * 512);
        __builtin_amdgcn_sched_barrier(0);
    }
    __syncthreads();
}
struct CtxSS { f32x4 a, b, c, d; };
__device__ __forceinline__ CtxSS ctx_ss_load(const float* sspc, int row, int fq) { const float* p = sspc + (size_t)row * 64 + fq * 16; CtxSS r; r.a = *(const f32x4*)p; r.b = *(const f32x4*)(p + 4); r.c = *(const f32x4*)(p + 8); r.d = *(const f32x4*)(p + 12); return r; }
__device__ __forceinline__ float ctx_rstd_fin(const CtxSS& v, int fr, int fq) {
    float s = ((v.a.x + v.a.y) + (v.a.z + v.a.w)) + ((v.b.x + v.b.y) + (v.b.z + v.b.w)) + ((v.c.x + v.c.y) + (v.c.z + v.c.w)) + ((v.d.x + v.d.y) + (v.d.z + v.d.w));
    s = add_x16(s); s = add_x32(s, XL32(fr, fq));
    return 1.0f / sqrtf(s * (1.0f / D) + EPS);
}
struct CtxP {
    int kind;
    const bf16_t* A; int lda, K; const bf16_t* Bt; const float* sspi; const float* bias;
    const float* hin; float* hout; bf16_t* xbo; const float* gate; const float* ng; const float* sc; float* sspo;
    bf16_t* o1; bf16_t* o2;
    const float* cw; const float* cb; const float* br; const float* bi; const float* la8; float* h0;
};
template <int KW> struct CtxCW { f32x4 w[KW][2]; f32x4 b[2]; };
template <int KW>
__device__ __forceinline__ CtxCW<KW> ctx_cw_load(const float* cw, int cstride, const float* cb, int c) {
    CtxCW<KW> r;
#pragma unroll
    for (int k = 0; k < KW; ++k) { r.w[k][0] = *(const f32x4*)(cw + (size_t)k * cstride + c); r.w[k][1] = *(const f32x4*)(cw + (size_t)k * cstride + c + 4); }
    r.b[0] = *(const f32x4*)(cb + c); r.b[1] = *(const f32x4*)(cb + c + 4);
    return r;
}
template <int KW, int PAD>
__device__ __forceinline__ void ctx_conv_rows(float (&o)[8], const LAS float* tile, int t, int hh, const CtxCW<KW>& cwv) {
    f32x4 o0 = cwv.b[0], o1 = cwv.b[1];
#pragma unroll
    for (int k = 0; k < KW; ++k) { const int tt = t + k - PAD; if (tt >= 0 && tt < CT) {
        const f32x4 a = *(const LAS f32x4*)(tile + tt * 16 + 8 * hh), b = *(const LAS f32x4*)(tile + tt * 16 + 8 * hh + 4);
        o0 += cwv.w[k][0] * a; o1 += cwv.w[k][1] * b; } }
    o[0] = o0[0]; o[1] = o0[1]; o[2] = o0[2]; o[3] = o0[3]; o[4] = o1[0]; o[5] = o1[1]; o[6] = o1[2]; o[7] = o1[3];
}
__device__ __forceinline__ void ctx_item(const Ctx& C0, const CtxP& P, int item) {
    Ctx C = C0; asm volatile("" : "+v"(C.lane)); C.tid = C.wave * 64 + C.lane;
    const int fr = C.lane & 15, fq = C.lane >> 4, c0 = 16 * item;
    LAS float* t0 = (LAS float*)C.lds; LAS float* t1 = t0 + 4096; LAS float* t2 = t1 + 4096; LAS float* t3 = t2 + 4096; LAS float* tagg = t3 + 4096;
    const int tt = C.tid >> 1, hh = C.tid & 1;
    if (P.kind == 1) {
        f32x4 acc[2][2]; const bf16_t* const Bp[2] = {P.Bt + (size_t)c0 * P.K, P.Bt + (size_t)(1024 + c0) * P.K};
        const f32x4 b0 = *(const f32x4*)(P.bias + c0 + 4 * fq), b1 = *(const f32x4*)(P.bias + 1024 + c0 + 4 * fq);
        const CtxSS ssv[2] = {ctx_ss_load(P.sspi, 32 * C.wave + fr, fq), ctx_ss_load(P.sspi, 32 * C.wave + 16 + fr, fq)};
        ctx_mm<2, 16, 1024>(acc, P.A, P.lda, Bp, C.wave, C.lane, C.tid, C.lds);
        const CtxCW<4> cwv = ctx_cw_load<4>(P.cw, D, P.cb, c0 + 8 * hh);
#pragma unroll
        for (int g = 0; g < 2; ++g) { const int t = 32 * C.wave + 16 * g + fr; const float rs = ctx_rstd_fin(ssv[g], fr, fq);
            *(LAS f32x4*)(t0 + t * 16 + 4 * fq) = acc[g][0] * rs + b0;
            const f32x4 gp = acc[g][1] * rs + b1; u32x2 w; w.x = cvt_pk_bf16(gelu_t(gp[0]), gelu_t(gp[1])); w.y = cvt_pk_bf16(gelu_t(gp[2]), gelu_t(gp[3]));
            *(u32x2*)(P.o2 + (size_t)t * D + c0 + 4 * fq) = w; }
        __syncthreads();
        float o[8]; ctx_conv_rows<4, 2>(o, t0, tt, hh, cwv);
        u32x4 w; w.x = cvt_pk_bf16(o[0], o[1]); w.y = cvt_pk_bf16(o[2], o[3]); w.z = cvt_pk_bf16(o[4], o[5]); w.w = cvt_pk_bf16(o[6], o[7]);
        *(u32x4*)(P.o1 + cf_off(tt, c0 + 8 * hh, D)) = w;
        __syncthreads();
    } else if (P.kind == 2) {
        f32x4 acc[2][4]; const int q = c0 >> 7, cl = c0 & 127, h = c0 >> 8;
        const bf16_t* const Bp[4] = {P.Bt + (size_t)((0 * 8 + q) * 256 + cl) * 256, P.Bt + (size_t)((0 * 8 + q) * 256 + 128 + cl) * 256, P.Bt + (size_t)((1 * 8 + q) * 256 + cl) * 256, P.Bt + (size_t)((1 * 8 + q) * 256 + 128 + cl) * 256};
        const u32x2 uw2[2] = {*(const u32x2*)(P.A + cf_off(32 * C.wave + fr, c0 + 4 * fq, D)), *(const u32x2*)(P.A + cf_off(32 * C.wave + 16 + fr, c0 + 4 * fq, D))};
        f32x4 brv2[2], biv2[2], lav2[2];
#pragma unroll
        for (int d = 0; d < 2; ++d) { brv2[d] = *(const f32x4*)(P.br + d * D + c0 + 4 * fq); biv2[d] = *(const f32x4*)(P.bi + d * D + c0 + 4 * fq); lav2[d] = *(const f32x4*)(P.la8 + d * D + c0 + 4 * fq); }
        ctx_mm<4, 8, 256>(acc, P.A + h * 256 * 16, P.lda, Bp, C.wave, C.lane, C.tid, C.lds);
#pragma unroll
        for (int g = 0; g < 2; ++g) { const int t = 32 * C.wave + 16 * g + fr; const f32x4 uu = bf4_to_f4(uw2[g]);
#pragma unroll
            for (int d = 0; d < 2; ++d) { const f32x4 brv = brv2[d], biv = biv2[d], lav = lav2[d];
                f32x4 av, bv;
#pragma unroll
                for (int j = 0; j < 4; ++j) { const float r = sigm(acc[g][2 * d][j] + brv[j]), ig = sigm(acc[g][2 * d + 1][j] + biv[j]); const float a = __builtin_amdgcn_exp2f(r * lav[j]), e = 1.0f - a; av[j] = a; bv[j] = __builtin_amdgcn_sqrtf(e * (1.0f + a)) * ig * uu[j]; }
                *(LAS f32x4*)((d ? t2 : t0) + t * 16 + 4 * fq) = av; *(LAS f32x4*)((d ? t3 : t1) + t * 16 + 4 * fq) = bv; } }
        __syncthreads();
        { const int c = C.tid & 15, d = (C.tid >> 4) & 1, chk = C.tid >> 5; const LAS float* ta = d ? t2 : t0; LAS float* tb = d ? t3 : t1;
            float Pp = 1.f, Qq = 0.f;
#pragma unroll
            for (int i = 0; i < 16; ++i) { const int t = 16 * chk + (d ? 15 - i : i); const float a = ta[t * 16 + c], b = tb[t * 16 + c]; Qq = a * Qq + b; Pp *= a; }
            tagg[((d * 16 + chk) * 16 + c) * 2] = Pp; tagg[((d * 16 + chk) * 16 + c) * 2 + 1] = Qq;
            __syncthreads();
            float hcar = 0.f; const int n = d ? 15 - chk : chk;
            for (int i = 0; i < n; ++i) { const int cc = d ? 15 - i : i; hcar = tagg[((d * 16 + cc) * 16 + c) * 2] * hcar + tagg[((d * 16 + cc) * 16 + c) * 2 + 1]; }
#pragma unroll
            for (int i = 0; i < 16; ++i) { const int t = 16 * chk + (d ? 15 - i : i); hcar = ta[t * 16 + c] * hcar + tb[t * 16 + c]; tb[t * 16 + c] = hcar; }
            if ((d == 0 && chk == 15) || (d == 1 && chk == 0)) P.h0[d * D + c0 + c] = hcar; }
        __syncthreads();
        if (P.o1) { const f32x4 f0 = *(const LAS f32x4*)(t1 + tt * 16 + 8 * hh), f1 = *(const LAS f32x4*)(t1 + tt * 16 + 8 * hh + 4), r0 = *(const LAS f32x4*)(t3 + tt * 16 + 8 * hh), r1 = *(const LAS f32x4*)(t3 + tt * 16 + 8 * hh + 4);
            const u32x4 gw = *(const u32x4*)(P.o2 + (size_t)tt * D + c0 + 8 * hh);
            const f32x4 s0 = f0 + r0, s1 = f1 + r1;
            u32x4 w; w.x = cvt_pk_bf16(bf2f(gw.x & 0xffffu) * s0[0], bf2f(gw.x >> 16) * s0[1]); w.y = cvt_pk_bf16(bf2f(gw.y & 0xffffu) * s0[2], bf2f(gw.y >> 16) * s0[3]);
            w.z = cvt_pk_bf16(bf2f(gw.z & 0xffffu) * s1[0], bf2f(gw.z >> 16) * s1[1]); w.w = cvt_pk_bf16(bf2f(gw.w & 0xffffu) * s1[2], bf2f(gw.w >> 16) * s1[3]);
            *(u32x4*)(P.o1 + cf_off(tt, c0 + 8 * hh, D)) = w; }
        __syncthreads();
    } else if (P.kind == 4) {
        const int cg = item & 63, c4 = 16 * cg, t = 128 * (item >> 6) + 16 * C.wave + fr; const size_t off = (size_t)t * D + c4 + 4 * fq;
        const f32x4 gv = *(const f32x4*)(P.gate + c4 + 4 * fq); const f32x4 gs = *(const f32x4*)(P.ng + c4 + 4 * fq) * (*(const f32x4*)(P.sc + c4 + 4 * fq) + 1.0f);
        const f32x4 hold = *(const f32x4*)(P.hin + off);
        f32x4 acc;
        if (P.K == D) ctx_mm1<32, 1024>(acc, P.A, P.lda, P.Bt + (size_t)c4 * 1024, 128 * (item >> 6) + 16 * C.wave, C.lane, C.tid, C.lds);
        else ctx_mm1<22, 2816>(acc, P.A, P.lda, P.Bt + (size_t)c4 * 2816, 128 * (item >> 6) + 16 * C.wave, C.lane, C.tid, C.lds);
        const f32x4 hn = hold + gv * acc;
        *(f32x4*)(P.hout + off) = hn;
        float ss = (hn[0] * hn[0] + hn[1] * hn[1]) + (hn[2] * hn[2] + hn[3] * hn[3]); ss = add_x16(ss); ss = add_x32(ss, XL32(fr, fq));
        if (fq == 0) P.sspo[(size_t)t * 64 + cg] = ss;
        const f32x4 y = hn * gs; u32x2 w; w.x = cvt_pk_bf16(y[0], y[1]); w.y = cvt_pk_bf16(y[2], y[3]); *(u32x2*)(P.xbo + cf_off(t, c4 + 4 * fq, D)) = w;
    } else if (P.kind == 5) {
        f32x4 acc[2][2]; const int q = c0 >> 7, cl = c0 & 127, nb0 = q * 256 + cl;
        const bf16_t* const Bp[2] = {P.Bt + (size_t)nb0 * P.K, P.Bt + (size_t)(nb0 + 128) * P.K};
        const f32x4 b0 = *(const f32x4*)(P.bias + nb0 + 4 * fq), b1 = *(const f32x4*)(P.bias + nb0 + 128 + 4 * fq);
        const CtxSS ssv[2] = {ctx_ss_load(P.sspi, 32 * C.wave + fr, fq), ctx_ss_load(P.sspi, 32 * C.wave + 16 + fr, fq)};
        ctx_mm<2, 16, 1024>(acc, P.A, P.lda, Bp, C.wave, C.lane, C.tid, C.lds);
        const CtxCW<3> cwv = ctx_cw_load<3>(P.cw, DFF, P.cb, c0 + 8 * hh);
#pragma unroll
        for (int g = 0; g < 2; ++g) { const int t = 32 * C.wave + 16 * g + fr; const float rs = ctx_rstd_fin(ssv[g], fr, fq);
            *(LAS f32x4*)(t0 + t * 16 + 4 * fq) = acc[g][0] * rs + b0; *(LAS f32x4*)(t1 + t * 16 + 4 * fq) = acc[g][1] * rs + b1; }
        __syncthreads();
        float o[8]; ctx_conv_rows<3, 1>(o, t0, tt, hh, cwv);
        const f32x4 v0 = *(const LAS f32x4*)(t1 + tt * 16 + 8 * hh), v1 = *(const LAS f32x4*)(t1 + tt * 16 + 8 * hh + 4);
        u32x4 w; w.x = cvt_pk_bf16(silu_f(o[0]) * v0[0], silu_f(o[1]) * v0[1]); w.y = cvt_pk_bf16(silu_f(o[2]) * v0[2], silu_f(o[3]) * v0[3]);
        w.z = cvt_pk_bf16(silu_f(o[4]) * v1[0], silu_f(o[5]) * v1[1]); w.w = cvt_pk_bf16(silu_f(o[6]) * v1[2], silu_f(o[7]) * v1[3]);
        *(u32x4*)(P.o1 + cf_off(tt, c0 + 8 * hh, DFF)) = w;
        __syncthreads();
    } else {
        f32x4 acc[2][3]; const int q = c0 >> 7, cl = c0 & 127, nb1 = 1024 + q * 256 + cl;
        const bf16_t* const Bp[3] = {P.Bt + (size_t)c0 * P.K, P.Bt + (size_t)nb1 * P.K, P.Bt + (size_t)(nb1 + 128) * P.K};
        const f32x4 b0 = *(const f32x4*)(P.bias + c0 + 4 * fq), b1 = *(const f32x4*)(P.bias + nb1 + 4 * fq), b2 = *(const f32x4*)(P.bias + nb1 + 128 + 4 * fq);
        const CtxSS ssv[2] = {ctx_ss_load(P.sspi, 32 * C.wave + fr, fq), ctx_ss_load(P.sspi, 32 * C.wave + 16 + fr, fq)};
        ctx_mm<3, 8, 1024>(acc, P.A, P.lda, Bp, C.wave, C.lane, C.tid, C.lds);
        const CtxCW<3> cwv = ctx_cw_load<3>(P.cw, D, P.cb, c0 + 8 * hh);
#pragma unroll
        for (int g = 0; g < 2; ++g) { const int t = 32 * C.wave + 16 * g + fr; const float rs = ctx_rstd_fin(ssv[g], fr, fq);
            *(LAS f32x4*)(t0 + t * 16 + 4 * fq) = (acc[g][1] * rs + b1) * (acc[g][2] * rs + b2); *(LAS f32x4*)(t1 + t * 16 + 4 * fq) = acc[g][0] * rs + b0; }
        __syncthreads();
        float o[8]; ctx_conv_rows<3, 1>(o, t0, tt, hh, cwv);
        const f32x4 v0 = *(const LAS f32x4*)(t1 + tt * 16 + 8 * hh), v1 = *(const LAS f32x4*)(t1 + tt * 16 + 8 * hh + 4);
        u32x4 w; w.x = cvt_pk_bf16(o[0] * v0[0], o[1] * v0[1]); w.y = cvt_pk_bf16(o[2] * v0[2], o[3] * v0[3]); w.z = cvt_pk_bf16(o[4] * v1[0], o[5] * v1[1]); w.w = cvt_pk_bf16(o[6] * v1[2], o[7] * v1[3]);
        *(u32x4*)(P.o1 + cf_off(tt, c0 + 8 * hh, D)) = w;
        __syncthreads();
    }
}
__device__ __forceinline__ int ctx_step(const Ctx& C, int ph, CtxP& P) {
    const float* mods = WSP(float, WS_MODS);
#define CMOD(l, chunk) (mods + (size_t)((l) * 2 + 1) * NMOD + (chunk) * 1024)
#define CXB(i) (WSP(bf16_t, CX_XB) + (size_t)(i) * CT * D)
#define CSSP(i) (WSP(float, CX_SSP) + (size_t)(i) * CT * 64)
    P.kind = 0; P.A = nullptr; P.lda = D; P.K = D; P.Bt = nullptr; P.sspi = nullptr; P.bias = nullptr; P.hin = nullptr; P.hout = nullptr; P.xbo = nullptr; P.gate = nullptr; P.ng = nullptr; P.sc = nullptr; P.sspo = nullptr;
    P.o1 = nullptr; P.o2 = nullptr; P.cw = nullptr; P.cb = nullptr; P.br = nullptr; P.bi = nullptr; P.la8 = nullptr; P.h0 = nullptr;
    int sid; switch (ph) { case 2: sid = 2; break; case 3: sid = 3; break; case 4: sid = 4; break; case 6: sid = 5; break; case 8: sid = 6; break; case 9: sid = 7; break; case 10: sid = 8; break;
                           case 11: sid = 9; break; case 13: sid = 10; break; case 14: sid = 11; break; case 15: sid = 12; break; default: sid = 0; }
    switch (sid) {
    case 2: case 11: { const int j = sid == 2 ? 0 : 1, l = 2 * j, xi = sid == 2 ? 0 : 4;
        P.kind = 1; P.A = CXB(xi); P.lda = D; P.K = D; P.Bt = WSP(bf16_t, W_A1 + j * SZ_A1); P.sspi = CSSP(xi); P.bias = WSP(float, WS_BIASM) + (size_t)(l * 2 + 1) * 3072;
        P.o1 = WSP(bf16_t, CX_U) + (size_t)j * CT * D; P.o2 = WSP(bf16_t, CX_G); P.cw = INP(IX_ACW) + (size_t)j * 4 * D; P.cb = INP(IX_ACB) + (size_t)j * D; return 64; }
    case 3: case 12: { const int j = sid == 3 ? 0 : 1;
        P.kind = 2; P.A = WSP(bf16_t, CX_U) + (size_t)j * CT * D; P.lda = D; P.K = 256; P.Bt = WSP(bf16_t, W_A2 + j * SZ_A2);
        P.br = INP(IX_ABR) + (size_t)j * 2 * D; P.bi = INP(IX_ABI) + (size_t)j * 2 * D; P.la8 = WSP(float, WS_LA8) + (size_t)j * 2 * D; P.h0 = WSP(float, WS_H0) + (size_t)j * 2 * D;
        P.o1 = j == 0 ? WSP(bf16_t, CX_GS) : nullptr; P.o2 = WSP(bf16_t, CX_G); return 64; }
    case 4: P.kind = 4; P.A = WSP(bf16_t, CX_GS); P.lda = D; P.K = D; P.Bt = WSP(bf16_t, W_A3); P.hin = INP(IX_CTX); P.hout = WSP(float, CX_H); P.xbo = CXB(1); P.gate = CMOD(0, 2); P.ng = INP(IX_NFG); P.sc = CMOD(0, 4); P.sspo = CSSP(1); return 128;
    case 5: case 9: { const int l = sid == 5 ? 0 : 1, xi = sid == 5 ? 1 : 3;
        P.kind = 5; P.A = CXB(xi); P.lda = D; P.K = D; P.Bt = WSP(bf16_t, W_F1 + l * SZ_F1); P.sspi = CSSP(xi); P.bias = WSP(float, WS_BIASF) + (size_t)(l * 2 + 1) * 5632;
        P.o1 = WSP(bf16_t, CX_Y + l * 1536 * KiB); P.cw = INP(IX_FCW) + (size_t)l * 3 * DFF; P.cb = INP(IX_FCB) + (size_t)l * DFF; return 176; }
    case 6: case 10: { const int l = sid == 6 ? 0 : 1, xo = sid == 6 ? 2 : 4;
        P.kind = 4; P.A = WSP(bf16_t, CX_Y + l * 1536 * KiB); P.lda = DFF; P.K = DFF; P.Bt = WSP(bf16_t, W_F2 + l * SZ_F2); P.hin = WSP(float, CX_H); P.hout = WSP(float, CX_H); P.xbo = CXB(xo);
        P.gate = CMOD(l, 5); P.ng = INP(IX_NMG) + (size_t)(l + 1) * D; P.sc = CMOD(l + 1, 1); P.sspo = CSSP(xo); return 128; }
    case 7: P.kind = 7; P.A = CXB(2); P.lda = D; P.K = D; P.Bt = WSP(bf16_t, W_B1); P.sspi = CSSP(2); P.bias = WSP(float, WS_BIASM) + (size_t)(1 * 2 + 1) * 3072;
        P.o1 = WSP(bf16_t, CX_Q); P.cw = INP(IX_BCW); P.cb = INP(IX_BCB); return 64;
    case 8: P.kind = 4; P.A = WSP(bf16_t, CX_Q); P.lda = D; P.K = D; P.Bt = WSP(bf16_t, W_B2); P.hin = WSP(float, CX_H); P.hout = WSP(float, CX_H); P.xbo = CXB(3); P.gate = CMOD(1, 2); P.ng = INP(IX_NFG) + D; P.sc = CMOD(1, 4); P.sspo = CSSP(3); return 128;
    default: return 0;
    }
#undef CMOD
#undef CXB
#undef CSSP
}

__global__ void __launch_bounds__(512, 2) mega_fwd(Args args) {
    extern __shared__ __attribute__((aligned(16))) unsigned char lds_raw[];
    Ctx C;
    C.in = args.in; C.out = args.out; C.ws = args.ws; C.lds = (LAS unsigned char*)lds_raw;
    C.tid = threadIdx.x; C.lane = C.tid & 63; C.wave = __builtin_amdgcn_readfirstlane(C.tid >> 6); C.G = gridDim.x; C.bid = blockIdx.x;
    volatile LAS unsigned* MISC = (volatile LAS unsigned*)(C.lds + MISC_OFF);
    for (int u = C.tid; u < (LDS_BYTES - LDSCTL_OFF) / 4; u += 512) ((LAS unsigned*)(C.lds + LDSCTL_OFF))[u] = 0u;
    __syncthreads();
    XcdBarrier bar; bar.bar = (unsigned*)(C.ws + WS_CTL) + 4096; bar.x = 0; bar.st = nullptr;
#if !MK_PER_PHASE
    bar = xcd_barrier_post((unsigned*)(C.ws + WS_CTL) + 4096, MISC + 8);
#endif
    const int lo = args.ph_lo, hi = args.ph_hi;
#define REFRESH_LANE() do { C.lane = lane_id(); asm volatile("" : "+v"(C.lane)); C.tid = C.wave * 64 + C.lane; } while (0)
#define IN(k) (lo <= (k) && (k) < hi)
#ifndef MK_BAR_REPS
#define MK_BAR_REPS 1
#endif
#define SEAM(k) do { if (IN(k) && IN((k) + 1)) { for (int br_ = 0; br_ < MK_BAR_REPS; ++br_) xcd_barrier(bar); } } while (0)
    const float* mods = WSP(float, WS_MODS);
#define LMOD(l, chunk) (mods + (size_t)((l) * 2) * NMOD + (chunk) * 1024)
#define SLOTP(type, i) WSP(type, WS_SLOT + (size_t)(i) * SLOT)
#define SSPA(i) (WSP(float, WS_SSP) + (size_t)(i) * T * 16)
    int ph = 0;
    if (IN(ph)) { REFRESH_LANE(); phase_p0(C); }
    SEAM(ph); ++ph;
    if (IN(ph)) { REFRESH_LANE(); phase_p1(C); }
    SEAM(ph); ++ph;
    for (ph = 2; ph < 28; ++ph) {
        if (ph == 5 || ph == 18) continue;
        if (IN(ph)) {
            asm volatile("" : "+s"(C.wave), "+s"(C.bid), "+s"(C.G));
            { size_t zz = 0; asm volatile("" : "+s"(zz)); C.ws = args.ws + zz; C.out = args.out + zz; }
            REFRESH_LANE();
            { CtxP cp; const int nci = ctx_step(C, ph, cp); const int coff = (ph == 8 || ph == 13) ? (C.G >> 1) : 0;
              for (int it = C.bid - coff; it < nci; it += C.G) if (it >= 0) ctx_item(C, cp, it); }
            int p = ph - 2, l = 0;
            if (p >= 13) { p -= 13; l = 2; }
            int kind;
            if (p < 8) kind = p; else { l += 1; p -= 8; kind = p == 0 ? 8 : p == 1 ? 9 : p + 3; }
            const int j = l >> 1;
            if (kind == 0) {
                pg8::Gemm g{SLOTP(bf16_t, 0), WSP(bf16_t, W_A1 + j * SZ_A1), D, D, 64, 8, 0, 0}; pg8::StaticOrder S; S.init(64, 8, C.G, C.bid);
                EpiA1 E{SLOTP(bf16_t, 1), SLOTP(bf16_t, 4), WSP(float, WS_BIASM) + (size_t)(l * 2) * 3072, SSPA(2 * l)};
                pg8::gemm_phase(C.lds, g, S, E, C.wave);
            } else if (kind == 1) {
                REFRESH_LANE();
                phase_conv4(C, SLOTP(bf16_t, 1), SLOTP(bf16_t, 5), INP(IX_ACW) + (size_t)j * 4 * D, INP(IX_ACB) + (size_t)j * D);
            } else if (kind == 2) {
                int kk = 256; asm volatile("" : "+s"(kk));
                pg8::Gemm g{SLOTP(bf16_t, 5), WSP(bf16_t, W_A2 + j * SZ_A2), D, kk, 64, 16, 1, 3}; pg8::StaticOrder S; S.init(64, 16, C.G, C.bid);
                EpiA2 E{SLOTP(bf16_t, 5), SLOTP(h16, 0), INP(IX_ABR) + (size_t)j * 2 * D, INP(IX_ABI) + (size_t)j * 2 * D, WSP(float, WS_LA8) + (size_t)j * 2 * D, WSP(float, WS_AGG32), WSP(float, WS_AGGT), C.lds};
                pg8::gemm_phase<EpiA2, false>(C.lds, g, S, E, C.wave);
            } else if (kind == 3) {
                REFRESH_LANE();
                phase_scan1(C, SLOTP(h16, 0));
            } else if (kind == 4) {
                REFRESH_LANE();
                phase_scan2(C, SLOTP(h16, 0), SLOTP(bf16_t, 4), SLOTP(bf16_t, 5), WSP(float, WS_H0) + (size_t)j * 2 * D);
            } else if (kind == 5) {
                const bf16_t* bt = (l & 1) ? WSP(bf16_t, W_B2 + j * SZ_B2) : WSP(bf16_t, W_A3 + j * SZ_A3);
                pg8::Gemm g{(l & 1) ? SLOTP(bf16_t, 3) : SLOTP(bf16_t, 5), bt, D, D, 64, 4, 0, 0}; pg8::StaticOrder S; S.init(64, 4, C.G, C.bid);
                EpiRes E{WSP(bf16_t, WS_XRES), SLOTP(bf16_t, 0), LMOD(l, 2), INP(IX_NFG) + (size_t)l * D, LMOD(l, 4), SSPA(2 * l + 1)};
                pg8::gemm_phase(C.lds, g, S, E, C.wave);
            } else if (kind == 6) {
                pg8::Gemm g{SLOTP(bf16_t, 0), WSP(bf16_t, W_F1 + l * SZ_F1), D, D, 64, 22, 0, 0}; pg8::StaticOrder S; S.init(64, 22, C.G, C.bid, ph > 13);
                EpiF1 E{SLOTP(bf16_t, 1), WSP(float, WS_BIASF) + (size_t)(l * 2) * 5632, SSPA(2 * l + 1), INP(IX_FCW) + (size_t)l * 3 * DFF, INP(IX_FCB) + (size_t)l * DFF};
                pg8::gemm_phase(C.lds, g, S, E, C.wave);
            } else if (kind == 7) {
                pg8::Gemm g{SLOTP(bf16_t, 1), WSP(bf16_t, W_F2 + l * SZ_F2), DFF, DFF, 64, 4, 0, 0}; pg8::StaticOrder S; S.init(64, 4, C.G, C.bid);
                EpiRes E{WSP(bf16_t, WS_XRES), SLOTP(bf16_t, 0), LMOD(l, 5), l < 3 ? INP(IX_NMG) + (size_t)(l + 1) * D : nullptr, l < 3 ? LMOD(l + 1, 1) : nullptr, SSPA(2 * l + 2)};
                pg8::gemm_phase(C.lds, g, S, E, C.wave);
            } else if (kind == 8) {
                pg8::Gemm g{SLOTP(bf16_t, 0), WSP(bf16_t, W_B1 + j * SZ_B1), D, D, 64, 12, 0, 0}; pg8::StaticOrder S; S.init(64, 12, C.G, C.bid);
                EpiB1 E{SLOTP(bf16_t, 1), SLOTP(bf16_t, 2), WSP(float, WS_BIASM) + (size_t)(l * 2) * 3072, SSPA(2 * l)};
                pg8::gemm_phase(C.lds, g, S, E, C.wave);
            } else {
                REFRESH_LANE();
                phase_vconv(C, SLOTP(bf16_t, 1), SLOTP(bf16_t, 2), SLOTP(bf16_t, 3), INP(IX_BCW) + (size_t)j * 3 * D, INP(IX_BCB) + (size_t)j * D);
            }
        }
        SEAM(ph);
    }
    if (IN(ph)) { REFRESH_LANE(); phase_final(C, SSPA(8)); }
}
constexpr int N_PHASES = 29;

extern "C" void kernel_launch(void* const* d_in, const int* in_sizes, int n_in, void* d_out, int out_size, void* d_ws, size_t ws_size, hipStream_t stream) {
    static int grid = 0;
    if (grid == 0) {
        if (n_in != N_IN || in_sizes[0] != T * D || out_size != T * D || ws_size < WS_END) { fprintf(stderr, "kernel_launch: unexpected problem shape (n_in %d, in0 %d, out %d, ws %zu < %zu)\n", n_in, n_in > 0 ? in_sizes[0] : -1, out_size, ws_size, (size_t)WS_END); grid = -1; return; }
        int dev = 0, cus = 0, per_cu = 0;
        if (hipGetDevice(&dev) != hipSuccess || hipDeviceGetAttribute(&cus, hipDeviceAttributeMultiprocessorCount, dev) != hipSuccess) { grid = -1; return; }
        if (hipFuncSetAttribute((const void*)mega_fwd, hipFuncAttributeMaxDynamicSharedMemorySize, LDS_BYTES) != hipSuccess) { fprintf(stderr, "kernel_launch: hipFuncSetAttribute failed\n"); grid = -1; return; }
        if (hipOccupancyMaxActiveBlocksPerMultiprocessor(&per_cu, (const void*)mega_fwd, 512, LDS_BYTES) != hipSuccess || per_cu < 1) fprintf(stderr, "kernel_launch: occupancy query reports %d\n", per_cu);
        (void)hipGetLastError();
        grid = cus;
    }
    if (grid < 0) return;
    (void)hipMemsetAsync((char*)d_ws + WS_CTL, 0, CTL_ZERO_BYTES, stream);
    Args a{};
    for (int i = 0; i < N_IN; ++i) a.in[i] = (const float*)d_in[i];
    a.out = (float*)d_out; a.ws = (unsigned char*)d_ws;
#if MK_PER_PHASE
    for (int p = 0; p < N_PHASES; ++p) {
        const bool dup = (MK_DUP_MASK >> p) & 1u;
        bool inplace = false;
        if (p >= 2 && p < 28) { int q = p - 2, l = 0; if (q >= 13) { q -= 13; l = 2; } int kind; if (q < 8) kind = q; else { l += 1; q -= 8; kind = q == 0 ? 8 : q == 1 ? 9 : q + 3; } inplace = kind == 5 || kind == 7; }
        const bool cin = (p == 6 || p == 8 || p == 10);
        char* xbk = (char*)d_ws + WS_SLOT + 4 * SLOT; char* cbk = (char*)d_ws + WS_END;
        if (dup && inplace) (void)hipMemcpyAsync(xbk, (char*)d_ws + WS_XRES, (size_t)T * D * 2, hipMemcpyDeviceToDevice, stream);
        if (dup && cin) (void)hipMemcpyAsync(cbk, (char*)d_ws + CX_H, (size_t)CT * D * 4, hipMemcpyDeviceToDevice, stream);
        a.ph_lo = p; a.ph_hi = p + 1; hipLaunchKernelGGL(mega_fwd, dim3(grid), dim3(512), LDS_BYTES, stream, a);
        if (dup) {
            if (inplace) (void)hipMemcpyAsync((char*)d_ws + WS_XRES, xbk, (size_t)T * D * 2, hipMemcpyDeviceToDevice, stream);
            if (cin) (void)hipMemcpyAsync((char*)d_ws + CX_H, cbk, (size_t)CT * D * 4, hipMemcpyDeviceToDevice, stream);
            hipLaunchKernelGGL(mega_fwd, dim3(grid), dim3(512), LDS_BYTES, stream, a);
        }
    }
#else
    a.ph_lo = 0; a.ph_hi = N_PHASES;
    hipLaunchKernelGGL(mega_fwd, dim3(grid), dim3(512), LDS_BYTES, stream, a);
#endif
}
```

```cpp
#include <hip/hip_runtime.h>
#include <cstdio>
#include <cstdint>

#ifndef MK_DUP_MASK
#define MK_DUP_MASK 0u
#endif
#ifndef MK_PER_PHASE
#define MK_PER_PHASE 0
#endif

#define LAS __attribute__((address_space(3)))
typedef unsigned short bf16_t;
typedef short bf16x8 __attribute__((ext_vector_type(8)));
typedef float f32x4 __attribute__((ext_vector_type(4)));
typedef float f32x2 __attribute__((ext_vector_type(2)));
typedef unsigned u32x4 __attribute__((ext_vector_type(4)));
typedef unsigned u32x2 __attribute__((ext_vector_type(2)));
typedef _Float16 h16;
typedef _Float16 h16x2 __attribute__((ext_vector_type(2)));
typedef _Float16 h16x4 __attribute__((ext_vector_type(4)));

constexpr int T = 16384, D = 1024, CT = 256, DFF = 2816, NMOD = 6144;
constexpr float EPS = 1e-6f;

enum { IX_X = 0, IX_C, IX_CTX, IX_CCTX, IX_ADAW, IX_ADAB, IX_NMG, IX_NFG, IX_AWX, IX_AWG, IX_ACW, IX_ACB, IX_AWR, IX_ABR, IX_AWI, IX_ABI, IX_ALAM, IX_AWO,
       IX_BWIN, IX_BCW, IX_BCB, IX_BWO, IX_FWU, IX_FCW, IX_FCB, IX_FWD, IX_FG, N_IN };

constexpr size_t MiB = 1u << 20, KiB = 1u << 10;
constexpr size_t WS_CTL = 0, CTL_ZERO_BYTES = 64 * KiB;
constexpr size_t WS_MODS = 1 * MiB;
constexpr size_t WS_BIASM = 1 * MiB + 256 * KiB;
constexpr size_t WS_BIASF = 1 * MiB + 512 * KiB;
constexpr size_t WS_LA8 = 1 * MiB + 768 * KiB;
constexpr size_t WS_H0 = WS_LA8 + 16 * KiB;
constexpr size_t WS_SSP = 2 * MiB;
constexpr size_t WS_AGGT = 11 * MiB;
constexpr size_t WS_AGG32 = 12 * MiB;
constexpr size_t WS_CTXR = 20 * MiB;
constexpr size_t CX_H = WS_CTXR;
constexpr size_t CX_XB = WS_CTXR + 1 * MiB;
constexpr size_t CX_U = WS_CTXR + 4 * MiB;
constexpr size_t CX_G = WS_CTXR + 5 * MiB;
constexpr size_t CX_GS = CX_G + 512 * KiB;
constexpr size_t CX_Q = WS_CTXR + 6 * MiB;
constexpr size_t CX_Y = CX_Q + 512 * KiB;
constexpr size_t CX_SSP = WS_CTXR + 10 * MiB;
constexpr size_t WS_W = 32 * MiB;
constexpr size_t W_A1 = WS_W, W_A2 = WS_W + 8 * MiB, W_A3 = WS_W + 12 * MiB, W_B1 = WS_W + 16 * MiB, W_B2 = WS_W + 28 * MiB, W_F1 = WS_W + 32 * MiB, W_F2 = WS_W + 76 * MiB;
constexpr size_t SZ_A1 = 4 * MiB, SZ_A2 = 2 * MiB, SZ_A3 = 2 * MiB, SZ_B1 = 6 * MiB, SZ_B2 = 2 * MiB, SZ_F1 = 11 * MiB, SZ_F2 = 5632 * KiB;
constexpr size_t WS_SLOT = 130 * MiB, SLOT = 32 * MiB;
constexpr size_t WS_XRES = WS_SLOT + 6 * SLOT;
constexpr size_t WS_END = WS_XRES + SLOT;
static_assert(W_F2 + 4 * SZ_F2 <= WS_SLOT, "weights fit");

constexpr int RING_BYTES = 131072, LDSCTL_OFF = RING_BYTES, MISC_OFF = LDSCTL_OFF + 320, LDS_BYTES = 147456;
constexpr int A2_BLK_OFF = RING_BYTES + 4096, A2_BLK_BYTES = 1280, A2_CNT_OFF = A2_BLK_OFF + 8 * A2_BLK_BYTES;
static_assert(A2_CNT_OFF + 16 <= LDS_BYTES, "LDS map");

__device__ __forceinline__ float bf2f(unsigned b) { return __uint_as_float(b << 16); }
__device__ __forceinline__ unsigned cvt_pk_bf16(float lo, float hi) { unsigned r; asm volatile("v_cvt_pk_bf16_f32 %0, %1, %2" : "=v"(r) : "v"(lo), "v"(hi)); return r; }
__device__ __forceinline__ float sigm(float x) { return __builtin_amdgcn_rcpf(1.f + __builtin_amdgcn_exp2f(-1.4426950409f * x)); }
__device__ __forceinline__ float silu_f(float x) { return x * sigm(x); }
__device__ __forceinline__ float gelu_t(float x) { const float u = x + 0.044715f * x * x * x; return x * __builtin_amdgcn_rcpf(1.f + __builtin_amdgcn_exp2f(-2.3022081986f * u)); }
__device__ __forceinline__ float one_minus_exp(float x) {
    float p = 1.f / 720.f; p = p * x + 1.f / 120.f; p = p * x + 1.f / 24.f; p = p * x + 1.f / 6.f; p = p * x + 0.5f; p = p * x + 1.f;
    const float small = -(p * x);
    const float big = 1.f - __builtin_amdgcn_exp2f(1.4426950409f * x);
    return x < -0.25f ? big : small;
}
__device__ __forceinline__ int lane_id() { return (int)__builtin_amdgcn_mbcnt_hi(~0u, __builtin_amdgcn_mbcnt_lo(~0u, 0u)); }
#define SWZ_X4 0x101F
#define SWZ_X8 0x201F
#define SWZ_X16 0x401F
__device__ __forceinline__ float add_x16(float v) { return v + __builtin_bit_cast(float, __builtin_amdgcn_ds_swizzle(__builtin_bit_cast(int, v), SWZ_X16)); }
__device__ __forceinline__ float add_x32(float v, int xl) { return v + __builtin_bit_cast(float, __builtin_amdgcn_ds_bpermute(xl, __builtin_bit_cast(int, v))); }
#define XL32(fr, fq) ((((fr) + 16 * (fq)) ^ 32) << 2)
__device__ __forceinline__ float wave_sum(float v) {
    v += __builtin_bit_cast(float, __builtin_amdgcn_update_dpp(0, __builtin_bit_cast(int, v), 0xB1, 0xf, 0xf, false));
    v += __builtin_bit_cast(float, __builtin_amdgcn_update_dpp(0, __builtin_bit_cast(int, v), 0x4E, 0xf, 0xf, false));
    v += __builtin_bit_cast(float, __builtin_amdgcn_ds_swizzle(__builtin_bit_cast(int, v), SWZ_X4));
    v += __builtin_bit_cast(float, __builtin_amdgcn_ds_swizzle(__builtin_bit_cast(int, v), SWZ_X8));
    v = add_x16(v);
    return __builtin_bit_cast(float, __builtin_amdgcn_readlane(__builtin_bit_cast(int, v), 0)) + __builtin_bit_cast(float, __builtin_amdgcn_readlane(__builtin_bit_cast(int, v), 32));
}
__device__ __forceinline__ float dpp_ror1(float x) { return __builtin_bit_cast(float, __builtin_amdgcn_update_dpp(0, __builtin_bit_cast(int, x), 0x121, 0xf, 0xf, false)); }
__device__ __forceinline__ float dpp_ror15(float x) { return __builtin_bit_cast(float, __builtin_amdgcn_update_dpp(0, __builtin_bit_cast(int, x), 0x12F, 0xf, 0xf, false)); }
__device__ __forceinline__ unsigned pk_h2(float a, float b) { h16x2 v = {(h16)a, (h16)b}; return __builtin_bit_cast(unsigned, v); }
__device__ __forceinline__ f32x4 h4_to_f4(u32x2 w) { h16x4 h = __builtin_bit_cast(h16x4, w); return (f32x4){(float)h[0], (float)h[1], (float)h[2], (float)h[3]}; }
__device__ __forceinline__ f32x4 bf4_to_f4(u32x2 w) { return (f32x4){bf2f(w.x & 0xffffu), bf2f(w.x >> 16), bf2f(w.y & 0xffffu), bf2f(w.y >> 16)}; }

namespace pg8 {
constexpr int BM = 256, BK = 64, HALF = 128, HTB = HALF * BK * 2, STAGE_BYTES = 8 * HTB, NXCD = 8, WGM = 4;
__host__ __device__ __forceinline__ int lds_byte(int r, int c) { const int st = (r >> 4) * 2 + (c >> 5), rr = r & 15, cc = c & 31, ob = rr * 64 + cc * 2; return st * 1024 + (ob ^ (((ob >> 9) & 1) << 5)); }
__host__ __device__ __forceinline__ void stage_rc(int b, int& R, int& C) { const int st = b / 1024, sb = b % 1024, swz = sb ^ (((sb >> 9) & 1) << 5); R = (st >> 1) * 16 + swz / 64; C = (st & 1) * 32 + (swz % 64) / 2; }
__host__ __device__ __forceinline__ int perm32(int rho) { const int n = rho >> 4, i = rho & 15; return 8 * (i >> 2) + 4 * n + (i & 3); }
struct Unit { int pm, pn, hrow, nai; };
struct Gemm { const bf16_t* A; const bf16_t* Bt; int lda, K, nM, nN, acs, acm; };
struct StaticOrder {
    int nM, nN, nwg, G, c; bool halves;
    __device__ void init(int nM_, int nN_, int G_, int c_, bool halves_ = false) { nM = nM_; nN = nN_; nwg = nM * nN; G = G_; c = c_; halves = halves_; }
    __device__ bool next(int i, Unit& u) const {
        const int fullr = nwg / G, rem = nwg - fullr * G; const bool split = halves && (rem * 2 == G);
        long L; u.hrow = 0; u.nai = 2;
        if (i < fullr) L = (long)i * G + c;
        else if (i == fullr && split) { L = (long)fullr * G + (c >> 1); u.hrow = (c & 1) * 128; u.nai = 1; }
        else if (i == fullr && c < rem) L = (long)i * G + c;
        else return false;
        int wgid = (int)L; { const int q = nwg / NXCD, r = nwg % NXCD, xcd = wgid % NXCD, off = wgid / NXCD; wgid = (xcd < r ? xcd * (q + 1) : r * (q + 1) + (xcd - r) * q) + off; }
        const int nig = WGM * nN, gid = wgid / nig, fm = gid * WGM, gsz = (nM - fm) < WGM ? (nM - fm) : WGM;
        u.pm = fm + ((wgid % nig) % gsz); u.pn = (wgid % nig) / gsz; return true;
    }
};

template <class Epi, bool PERM = true>
__device__ __forceinline__ void gemm_phase(LAS unsigned char* lds, const Gemm g, const StaticOrder& S, const Epi& E, int wid_) {
    int lane_ = lane_id(); asm volatile("" : "+v"(lane_));
    const int wid = wid_, lane = lane_, tid = wid * 64 + lane, wr = wid >> 2, wc = wid & 3, fr = lane & 15, fq = lane >> 4;
    const int K = g.K, nt = K / BK;
    unsigned voffA[2], voffB[2];
#pragma unroll
    for (int i = 0; i < 2; ++i) { int R, C; stage_rc(tid * 16 + i * 8192, R, C); const int Rb = PERM ? (R & ~31) + perm32(R & 31) : R;
        voffA[i] = (unsigned)(R * g.lda + C) * 2u; voffB[i] = (unsigned)(Rb * K + C) * 2u; }
    const unsigned kstep = (unsigned)(BK * 2);
    const unsigned hstepA = (unsigned)HALF * (unsigned)g.lda * 2u, tstepA = 2u * hstepA;
    const unsigned hstepB = (unsigned)HALF * (unsigned)K * 2u, tstepB = 2u * hstepB;
    const unsigned ldsw = (unsigned)wid * 1024u;
    const int aoff = lds_byte(wr * 64 + fr, fq * 8), boff = lds_byte(wc * 32 + fr, fq * 8);
    const __amdgpu_buffer_rsrc_t rsA = __builtin_amdgcn_make_buffer_rsrc((void*)g.A, 0, 0x7fffffff, 0x00020000);
    const __amdgpu_buffer_rsrc_t rsB = __builtin_amdgcn_make_buffer_rsrc((void*)g.Bt, 0, 0x7fffffff, 0x00020000);
#define PG8_UA(u) ((unsigned)(u).pm * tstepA + ((u).hrow ? hstepA : 0u) + (unsigned)((((u).pn >> g.acs) & g.acm) * 512))
#define PG8_UB(u) ((unsigned)(u).pn * tstepB)
#define PG8_SA(b, h) (((b) * 2 + (h)) * HTB)
#define PG8_SB(b, h) ((4 + (b) * 2 + (h)) * HTB)
#define PG8_STAGE(bufoff, rs, soff, voff) do { _Pragma("unroll") for (int _i = 0; _i < 2; ++_i) \
        __builtin_amdgcn_raw_ptr_buffer_load_lds(rs, (LAS void*)(lds + (bufoff) + ldsw + _i * 8192), 16, (int)(voff)[_i], (int)(soff), 0, 0); } while (0)
#define PG8_LDA(dst, b, h) do { _Pragma("unroll") for (int m = 0; m < 4; ++m) _Pragma("unroll") for (int k = 0; k < 2; ++k) dst[m][k] = *(const LAS bf16x8*)(lds + PG8_SA(b, h) + aoff + m * 2048 + k * 1024); } while (0)
#define PG8_LDB(dst, b, h) do { _Pragma("unroll") for (int n = 0; n < 2; ++n) _Pragma("unroll") for (int k = 0; k < 2; ++k) dst[n][k] = *(const LAS bf16x8*)(lds + PG8_SB(b, h) + boff + n * 2048 + k * 1024); } while (0)
#define PG8_MMA(ai, bj, At, Bt) do { __builtin_amdgcn_s_setprio(1); _Pragma("unroll") for (int m = 0; m < 4; ++m) _Pragma("unroll") for (int n = 0; n < 2; ++n) _Pragma("unroll") for (int k = 0; k < 2; ++k) \
        acc[ai][bj][m][n] = __builtin_amdgcn_mfma_f32_16x16x32_bf16(Bt[n][k], At[m][k], acc[ai][bj][m][n], 0, 0, 0); __builtin_amdgcn_s_setprio(0); } while (0)
#define PG8_WAIT_V(n) asm volatile("s_waitcnt vmcnt(" #n ")" ::: "memory")
#define PG8_WAIT_L(n) asm volatile("s_waitcnt lgkmcnt(" #n ")" ::: "memory")
#define PG8_BAR __builtin_amdgcn_s_barrier()
#define PG8_SCHED __builtin_amdgcn_sched_barrier(0)
    Unit cur, nxt; int ui = 0;
    if (!S.next(0, cur)) return;
    f32x4 acc[2][2][4][2];
#pragma unroll
    for (int a = 0; a < 2; ++a)
#pragma unroll
        for (int b = 0; b < 2; ++b)
#pragma unroll
            for (int m = 0; m < 4; ++m)
#pragma unroll
                for (int n = 0; n < 2; ++n) acc[a][b][m][n] = (f32x4){0.f, 0.f, 0.f, 0.f};
    bf16x8 At[4][2], B0[2][2], B1[2][2];
    unsigned cA = PG8_UA(cur), cB = PG8_UB(cur);
    PG8_STAGE(PG8_SB(0, 0), rsB, cB, voffB); PG8_STAGE(PG8_SB(0, 1), rsB, cB + hstepB, voffB); PG8_STAGE(PG8_SA(0, 0), rsA, cA, voffA); PG8_STAGE(PG8_SA(0, 1), rsA, cA + hstepA, voffA);
    if (wr == 1) PG8_BAR;
    PG8_WAIT_V(2); PG8_BAR;
    PG8_STAGE(PG8_SB(1, 0), rsB, cB + kstep, voffB); PG8_STAGE(PG8_SA(1, 0), rsA, cA + kstep, voffA); PG8_STAGE(PG8_SB(1, 1), rsB, cB + hstepB + kstep, voffB);
    PG8_WAIT_V(6); PG8_BAR;
    for (;;) {
        const bool has_next = S.next(ui + 1, nxt);
        const unsigned nA = has_next ? PG8_UA(nxt) : cA, nB = has_next ? PG8_UB(nxt) : cB;
        for (int t = 0; t < nt; t += 2) {
            const bool last = (t == nt - 2);
            const unsigned a1 = cA + (unsigned)(t + 1) * kstep;
            const unsigned a2 = last ? nA : cA + (unsigned)(t + 2) * kstep, b2 = last ? nB : cB + (unsigned)(t + 2) * kstep;
            const unsigned a3 = a2 + kstep, b3 = b2 + kstep;
            PG8_LDB(B0, 0, 0); PG8_LDB(B1, 0, 1); PG8_SCHED; PG8_LDA(At, 0, 0); PG8_STAGE(PG8_SA(1, 1), rsA, a1 + hstepA, voffA);
            PG8_WAIT_V(8); PG8_WAIT_L(0); PG8_BAR; PG8_MMA(0, 0, At, B0); PG8_MMA(0, 1, At, B1); PG8_BAR; PG8_SCHED;
            PG8_LDA(At, 0, 1); PG8_STAGE(PG8_SB(0, 0), rsB, b2, voffB); PG8_STAGE(PG8_SB(0, 1), rsB, b2 + hstepB, voffB); PG8_STAGE(PG8_SA(0, 0), rsA, a2, voffA);
            PG8_WAIT_V(8); PG8_WAIT_L(0); PG8_BAR; if (cur.nai == 2) { PG8_MMA(1, 0, At, B0); PG8_MMA(1, 1, At, B1); } PG8_BAR; PG8_SCHED;
            PG8_LDB(B0, 1, 0); PG8_LDB(B1, 1, 1); PG8_SCHED; PG8_LDA(At, 1, 0); PG8_STAGE(PG8_SA(0, 1), rsA, a2 + hstepA, voffA);
            PG8_WAIT_V(8); PG8_WAIT_L(0); PG8_BAR; PG8_MMA(0, 0, At, B0); PG8_MMA(0, 1, At, B1); PG8_BAR; PG8_SCHED;
            PG8_LDA(At, 1, 1); PG8_STAGE(PG8_SB(1, 0), rsB, b3, voffB); PG8_STAGE(PG8_SB(1, 1), rsB, b3 + hstepB, voffB); PG8_STAGE(PG8_SA(1, 0), rsA, a3, voffA);
            PG8_WAIT_V(8); PG8_WAIT_L(0); PG8_BAR; if (cur.nai == 2) { PG8_MMA(1, 0, At, B0); PG8_MMA(1, 1, At, B1); } PG8_BAR; PG8_SCHED;
        }
        if (wr == 0) PG8_BAR;
        { int lnE = lane_id(); asm volatile("" : "+v"(lnE)); int frE = lnE & 15, fqE = lnE >> 4, wrE = wr, wcE = wc; asm volatile("" : "+s"(wrE), "+s"(wcE));
          E(acc, cur, wrE, wcE, frE, fqE); }
        if (!has_next) break;
#pragma unroll
        for (int a = 0; a < 2; ++a)
#pragma unroll
            for (int b = 0; b < 2; ++b)
#pragma unroll
                for (int m = 0; m < 4; ++m)
#pragma unroll
                    for (int n = 0; n < 2; ++n) acc[a][b][m][n] = (f32x4){0.f, 0.f, 0.f, 0.f};
        cur = nxt; cA = nA; cB = nB; ++ui;
        if (wr == 1) PG8_BAR;
    }
    PG8_WAIT_V(0);
    PG8_BAR;
#undef PG8_UA
#undef PG8_UB
#undef PG8_SA
#undef PG8_SB
#undef PG8_STAGE
#undef PG8_LDA
#undef PG8_LDB
#undef PG8_MMA
#undef PG8_WAIT_V
#undef PG8_WAIT_L
#undef PG8_BAR
#undef PG8_SCHED
}
}

typedef f32x4 Acc[2][2][4][2];

__device__ __forceinline__ void load_rstd(float (&rs)[2][4], const float* ssp, int row0, int fr, int fq) {
#pragma unroll
    for (int ai = 0; ai < 2; ++ai)
#pragma unroll
        for (int m = 0; m < 4; ++m) {
            const f32x4 p = *(const f32x4*)(ssp + (size_t)(row0 + ai * 128 + m * 16) * 16 + fq * 4);
            float s = (p.x + p.y) + (p.z + p.w);
            s = add_x16(s); s = add_x32(s, XL32(fr, fq));
            rs[ai][m] = __builtin_amdgcn_rsqf(s * (1.0f / D) + EPS);
        }
}

struct EpiA1 {
    bf16_t* UPRE; bf16_t* G; const float* bias; const float* ssp;
    __device__ __forceinline__ void operator()(const Acc& acc, const pg8::Unit& u, int wr, int wc, int fr, int fq) const {
        const int row0 = u.pm * 256 + wr * 64 + fr;
        float rs[2][4]; load_rstd(rs, ssp, row0, fr, fq);
        const bool isg = u.pn >= 4; bf16_t* out = isg ? G : UPRE;
        const int oc0 = (u.pn & 3) * 256 + wc * 32 + 8 * fq, bc0 = u.pn * 256 + wc * 32 + 8 * fq;
        f32x4 bv[2][2];
#pragma unroll
        for (int bj = 0; bj < 2; ++bj)
#pragma unroll
            for (int n = 0; n < 2; ++n) bv[bj][n] = *(const f32x4*)(bias + bc0 + bj * 128 + 4 * n);
#pragma unroll
        for (int ai = 0; ai < 2; ++ai)
#pragma unroll
            for (int m = 0; m < 4; ++m) { bf16_t* rowp = out + (size_t)(row0 + ai * 128 + m * 16) * D + oc0; const float r = rs[ai][m];
#pragma unroll
                for (int bj = 0; bj < 2; ++bj) { f32x4 v0 = acc[ai][bj][m][0] * r + bv[bj][0], v1 = acc[ai][bj][m][1] * r + bv[bj][1];
                    if (isg) { v0 = (f32x4){gelu_t(v0[0]), gelu_t(v0[1]), gelu_t(v0[2]), gelu_t(v0[3])}; v1 = (f32x4){gelu_t(v1[0]), gelu_t(v1[1]), gelu_t(v1[2]), gelu_t(v1[3])}; }
                    u32x4 w; w.x = cvt_pk_bf16(v0[0], v0[1]); w.y = cvt_pk_bf16(v0[2], v0[3]); w.z = cvt_pk_bf16(v1[0], v1[1]); w.w = cvt_pk_bf16(v1[2], v1[3]);
                    *(u32x4*)(rowp + bj * 128) = w; } }
    }
};

struct EpiA2 {
    const bf16_t* U; h16* EB; const float* br; const float* bi; const float* la8; float* agg32; float* aggt; LAS unsigned char* lds;
    __device__ __forceinline__ void operator()(const Acc& acc, const pg8::Unit& u, int wr, int wc, int fr, int fq) const {
        const int row0 = u.pm * 256 + wr * 64 + fr, d = u.pn >> 3, q = u.pn & 7, c0 = q * 128 + wc * 32 + 4 * fq;
        h16* Ed = EB + (size_t)d * T * D * 2;
        u32x2 uw[2][4][2];
#pragma unroll
        for (int ai = 0; ai < 2; ++ai)
#pragma unroll
            for (int m = 0; m < 4; ++m)
#pragma unroll
                for (int n = 0; n < 2; ++n) uw[ai][m][n] = *(const u32x2*)(U + (size_t)(row0 + ai * 128 + m * 16) * D + c0 + 16 * n);
        f32x4 brv2[2], biv2[2], lav2[2];
#pragma unroll
        for (int n = 0; n < 2; ++n) { brv2[n] = *(const f32x4*)(br + d * D + c0 + 16 * n); biv2[n] = *(const f32x4*)(bi + d * D + c0 + 16 * n); lav2[n] = *(const f32x4*)(la8 + d * D + c0 + 16 * n); }
        const int lane = fq * 16 + fr, cl = lane & 15, qt = lane >> 4;
        LAS unsigned char* blk = lds + A2_BLK_OFF + (wr * 4 + wc) * A2_BLK_BYTES;
        LAS unsigned char* wp = blk + ((fr >> 2) * 80 + (fr & 3) * 16 + 4 * fq) * 4;
        const LAS unsigned char* rp = blk + (qt * 80 + cl) * 4 + (d ? 3 * 64 : 0); const int rstep = d ? -64 : 64;
        const bool sec1 = ((qt & 1) ^ d) != 0, sec2 = ((qt >> 1) ^ d) != 0;
        const int plane = (lane ^ 32) * 4;
        float SP[2][2][2], SQ[2][2][2];
#pragma unroll
        for (int ai = 0; ai < 2; ++ai) {
            float BP[2] = {1.f, 1.f}, BQ[2] = {0.f, 0.f};
#pragma unroll
            for (int m = 0; m < 4; ++m) {
#pragma unroll
                for (int n = 0; n < 2; ++n) { const size_t off = (size_t)(row0 + ai * 128 + m * 16) * D + c0 + 16 * n;
                    const f32x4 uu = bf4_to_f4(uw[ai][m][n]); const f32x4 brv = brv2[n], biv = biv2[n], lav = lav2[n];
                    unsigned w[4];
#pragma unroll
                    for (int j = 0; j < 4; ++j) { const float r = sigm(acc[ai][0][m][n][j] + brv[j]), ig = sigm(acc[ai][1][m][n][j] + biv[j]);
                        const float a = __builtin_amdgcn_exp2f(r * lav[j]), e = 1.0f - a; w[j] = pk_h2(e, __builtin_amdgcn_sqrtf(e * (1.0f + a)) * ig * uu[j]); }
                    const u32x4 wv = (u32x4){w[0], w[1], w[2], w[3]};
                    *(u32x4*)(Ed + off * 2) = wv;
                    *(LAS u32x4*)wp = wv;
                    unsigned v[4];
#pragma unroll
                    for (int k = 0; k < 4; ++k) v[k] = *(const LAS unsigned*)(rp + k * rstep);
                    float P = 1.f, Q = 0.f;
#pragma unroll
                    for (int k = 0; k < 4; ++k) { const h16x2 hh = __builtin_bit_cast(h16x2, v[k]); const float a = 1.0f - (float)hh[0], b = (float)hh[1]; P *= a; Q = a * Q + b; }
                    {   const float Pp = __int_as_float(__builtin_amdgcn_ds_swizzle(__float_as_int(P), 0x401F)), Qp = __int_as_float(__builtin_amdgcn_ds_swizzle(__float_as_int(Q), 0x401F));
                        const float fQ = sec1 ? Qp : Q, sP = sec1 ? P : Pp, sQ = sec1 ? Q : Qp; P = P * Pp; Q = sP * fQ + sQ; }
                    {   const float Pp = __int_as_float(__builtin_amdgcn_ds_bpermute(plane, __float_as_int(P))), Qp = __int_as_float(__builtin_amdgcn_ds_bpermute(plane, __float_as_int(Q)));
                        const float fQ = sec2 ? Qp : Q, sP = sec2 ? P : Pp, sQ = sec2 ? Q : Qp; P = P * Pp; Q = sP * fQ + sQ; }
                    if (m & 1) { const float fP = d ? P : BP[n], fQ = d ? Q : BQ[n], sP = d ? BP[n] : P, sQ = d ? BQ[n] : Q;
                        SP[ai][m >> 1][n] = sP * fP; SQ[ai][m >> 1][n] = sP * fQ + sQ; }
                    else { BP[n] = P; BQ[n] = Q; } }
            }
        }
        if (lane < 16) {
#pragma unroll
            for (int ai = 0; ai < 2; ++ai)
#pragma unroll
                for (int mm = 0; mm < 2; ++mm)
#pragma unroll
                    for (int n = 0; n < 2; ++n) { const int sc = ai * 4 + wr * 2 + mm; const f32x2 pq = (f32x2){SP[ai][mm][n], SQ[ai][mm][n]};
                        *(f32x2*)(agg32 + (((size_t)d * 512 + u.pm * 8 + sc) * D + q * 128 + wc * 32 + 16 * n + cl) * 2) = pq;
                        *(LAS f32x2*)(blk + ((((ai * 2 + mm) * 2 + n) * 16 + cl) * 8)) = pq; }
        }
        asm volatile("" ::: "memory");
        unsigned old = 0u; if (lane == 0) old = __hip_atomic_fetch_add((LAS unsigned*)(lds + A2_CNT_OFF) + wc, 1u, __ATOMIC_RELAXED, __HIP_MEMORY_SCOPE_WORKGROUP);
        old = (unsigned)__builtin_amdgcn_readfirstlane((int)old);
        asm volatile("" ::: "memory");
        if (old & 1u) { float P = 1.f, Q = 0.f; const int l32 = lane & 31;
#pragma unroll
            for (int k = 0; k < 8; ++k) { const int sc = d ? 7 - k : k;
                const f32x2 pq = *(const LAS f32x2*)(lds + A2_BLK_OFF + (((sc >> 1) & 1) * 4 + wc) * A2_BLK_BYTES + ((((sc >> 2) * 2 + (sc & 1)) * 32 + l32) * 8)); Q = pq.x * Q + pq.y; P *= pq.x; }
            if (lane < 32) *(f32x2*)(aggt + (((size_t)d * 64 + u.pm) * D + q * 128 + wc * 32 + l32) * 2) = (f32x2){P, Q}; }
    }
};

struct EpiRes {
    bf16_t* xres; bf16_t* xb; const float* gate; const float* ng; const float* sc; float* sspo;
    __device__ __forceinline__ void operator()(const Acc& acc, const pg8::Unit& u, int wr, int wc, int fr, int fq) const {
        const int row0 = u.pm * 256 + wr * 64 + fr, c0 = u.pn * 256 + wc * 32 + 8 * fq;
        f32x4 gv[2][2], gs[2][2];
#pragma unroll
        for (int bj = 0; bj < 2; ++bj)
#pragma unroll
            for (int n = 0; n < 2; ++n) { gv[bj][n] = *(const f32x4*)(gate + c0 + bj * 128 + 4 * n);
                if (ng) { const f32x4 a = *(const f32x4*)(ng + c0 + bj * 128 + 4 * n), b = *(const f32x4*)(sc + c0 + bj * 128 + 4 * n); gs[bj][n] = a * (b + 1.0f); } else gs[bj][n] = (f32x4){0.f, 0.f, 0.f, 0.f}; }
#pragma unroll
        for (int ai = 0; ai < 2; ++ai) {
            u32x4 xo[1][4][2];
#pragma unroll
            for (int m = 0; m < 4; ++m)
#pragma unroll
                for (int bj = 0; bj < 2; ++bj) xo[0][m][bj] = *(const u32x4*)(xres + (size_t)(row0 + ai * 128 + m * 16) * D + c0 + bj * 128);
#pragma unroll
            for (int m = 0; m < 4; ++m) { const int row = row0 + ai * 128 + m * 16; const size_t off = (size_t)row * D + c0; float ss = 0.f;
#pragma unroll
                for (int bj = 0; bj < 2; ++bj) { const u32x4 w0 = xo[0][m][bj];
                    const f32x4 o0 = (f32x4){bf2f(w0.x & 0xffffu), bf2f(w0.x >> 16), bf2f(w0.y & 0xffffu), bf2f(w0.y >> 16)}, o1 = (f32x4){bf2f(w0.z & 0xffffu), bf2f(w0.z >> 16), bf2f(w0.w & 0xffffu), bf2f(w0.w >> 16)};
                    const f32x4 x0 = o0 + gv[bj][0] * acc[ai][bj][m][0], x1 = o1 + gv[bj][1] * acc[ai][bj][m][1];
                    u32x4 wx; wx.x = cvt_pk_bf16(x0[0], x0[1]); wx.y = cvt_pk_bf16(x0[2], x0[3]); wx.z = cvt_pk_bf16(x1[0], x1[1]); wx.w = cvt_pk_bf16(x1[2], x1[3]);
                    *(u32x4*)(xres + off + bj * 128) = wx;
                    ss += (x0[0] * x0[0] + x0[1] * x0[1]) + (x0[2] * x0[2] + x0[3] * x0[3]) + (x1[0] * x1[0] + x1[1] * x1[1]) + (x1[2] * x1[2] + x1[3] * x1[3]);
                    if (ng) { const f32x4 y0 = x0 * gs[bj][0], y1 = x1 * gs[bj][1]; u32x4 w; w.x = cvt_pk_bf16(y0[0], y0[1]); w.y = cvt_pk_bf16(y0[2], y0[3]); w.z = cvt_pk_bf16(y1[0], y1[1]); w.w = cvt_pk_bf16(y1[2], y1[3]);
                        *(u32x4*)(xb + off + bj * 128) = w; } }
                ss = add_x16(ss); ss = add_x32(ss, XL32(fr, fq));
                if (fq == 0) sspo[(size_t)row * 16 + u.pn * 4 + wc] = ss; }
        }
    }
};

struct EpiB1 {
    bf16_t* GB; bf16_t* Z; const float* bias; const float* ssp;
    __device__ __forceinline__ void operator()(const Acc& acc, const pg8::Unit& u, int wr, int wc, int fr, int fq) const {
        const int row0 = u.pm * 256 + wr * 64 + fr;
        float rs[2][4]; load_rstd(rs, ssp, row0, fr, fq);
        const int bc0 = u.pn * 256 + wc * 32 + 8 * fq;
        f32x4 bv[2][2];
#pragma unroll
        for (int bj = 0; bj < 2; ++bj)
#pragma unroll
            for (int n = 0; n < 2; ++n) bv[bj][n] = *(const f32x4*)(bias + bc0 + bj * 128 + 4 * n);
        if (u.pn < 4) {
#pragma unroll
            for (int ai = 0; ai < 2; ++ai)
#pragma unroll
                for (int m = 0; m < 4; ++m) { bf16_t* rowp = GB + (size_t)(row0 + ai * 128 + m * 16) * D + bc0; const float r = rs[ai][m];
#pragma unroll
                    for (int bj = 0; bj < 2; ++bj) { const f32x4 v0 = acc[ai][bj][m][0] * r + bv[bj][0], v1 = acc[ai][bj][m][1] * r + bv[bj][1];
                        u32x4 w; w.x = cvt_pk_bf16(v0[0], v0[1]); w.y = cvt_pk_bf16(v0[2], v0[3]); w.z = cvt_pk_bf16(v1[0], v1[1]); w.w = cvt_pk_bf16(v1[2], v1[3]);
                        *(u32x4*)(rowp + bj * 128) = w; } }
        } else {
            const int c0 = (u.pn - 4) * 128 + wc * 32 + 8 * fq;
#pragma unroll
            for (int ai = 0; ai < 2; ++ai)
#pragma unroll
                for (int m = 0; m < 4; ++m) { const float r = rs[ai][m];
                    const f32x4 z0 = (acc[ai][0][m][0] * r + bv[0][0]) * (acc[ai][1][m][0] * r + bv[1][0]), z1 = (acc[ai][0][m][1] * r + bv[0][1]) * (acc[ai][1][m][1] * r + bv[1][1]);
                    u32x4 w; w.x = cvt_pk_bf16(z0[0], z0[1]); w.y = cvt_pk_bf16(z0[2], z0[3]); w.z = cvt_pk_bf16(z1[0], z1[1]); w.w = cvt_pk_bf16(z1[2], z1[3]);
                    *(u32x4*)(Z + (size_t)(row0 + ai * 128 + m * 16) * D + c0) = w; }
        }
    }
};

struct EpiF1 {
    bf16_t* Y; const float* bias; const float* ssp; const float* cw; const float* cb;
    __device__ __forceinline__ void operator()(const Acc& acc, const pg8::Unit& u, int wr, int wc, int fr, int fq) const {
        const int row0 = u.pm * 256 + u.hrow + wr * 64 + fr;
        const int bc0 = u.pn * 256 + wc * 32 + 8 * fq, c0 = u.pn * 128 + wc * 32 + 8 * fq;
        f32x4 bg[2], bvv[2], w0[2], w1[2], w2[2], cbv[2];
#pragma unroll
        for (int n = 0; n < 2; ++n) { bg[n] = *(const f32x4*)(bias + bc0 + 4 * n); bvv[n] = *(const f32x4*)(bias + bc0 + 128 + 4 * n);
            w0[n] = *(const f32x4*)(cw + c0 + 4 * n); w1[n] = *(const f32x4*)(cw + DFF + c0 + 4 * n); w2[n] = *(const f32x4*)(cw + 2 * DFF + c0 + 4 * n); cbv[n] = *(const f32x4*)(cb + c0 + 4 * n); }
        float rs[2][4]; load_rstd(rs, ssp, row0, fr, fq);
        const bool first = (fr == 0), lastl = (fr == 15);
#pragma unroll
        for (int ai = 0; ai < 2; ++ai) {
            if (ai >= u.nai) break;
            unsigned pk0[4][2];
#pragma unroll
            for (int n = 0; n < 2; ++n) {
                f32x4 gq[4];
#pragma unroll
                for (int m = 0; m < 4; ++m) gq[m] = acc[ai][0][m][n] * rs[ai][m] + bg[n];
#pragma unroll
                for (int m = 0; m < 4; ++m) {
#define ROR1V(v) ((f32x4){dpp_ror1((v)[0]), dpp_ror1((v)[1]), dpp_ror1((v)[2]), dpp_ror1((v)[3])})
#define ROR15V(v) ((f32x4){dpp_ror15((v)[0]), dpp_ror15((v)[1]), dpp_ror15((v)[2]), dpp_ror15((v)[3])})
                    const f32x4 ls = ROR1V(gq[m]), rsm = ROR15V(gq[m]);
                    f32x4 lf, rt;
                    if (m == 0) lf = first ? (f32x4){0.f, 0.f, 0.f, 0.f} : ls; else { const f32x4 lp = ROR1V(gq[m > 0 ? m - 1 : 0]); lf = first ? lp : ls; }
                    if (m == 3) rt = lastl ? (f32x4){0.f, 0.f, 0.f, 0.f} : rsm; else { const f32x4 rn = ROR15V(gq[m < 3 ? m + 1 : 3]); rt = lastl ? rn : rsm; }
                    const f32x4 gc = cbv[n] + w0[n] * lf + w1[n] * gq[m] + w2[n] * rt;
                    const f32x4 vv = acc[ai][1][m][n] * rs[ai][m] + bvv[n];
                    const f32x4 y = (f32x4){silu_f(gc[0]) * vv[0], silu_f(gc[1]) * vv[1], silu_f(gc[2]) * vv[2], silu_f(gc[3]) * vv[3]};
                    const unsigned p0 = cvt_pk_bf16(y[0], y[1]), p1 = cvt_pk_bf16(y[2], y[3]);
                    if (n == 0) { pk0[m][0] = p0; pk0[m][1] = p1; }
                    else *(u32x4*)(Y + (size_t)(row0 + ai * 128 + m * 16) * DFF + c0) = (u32x4){pk0[m][0], pk0[m][1], p0, p1}; }
            }
        }
    }
};

#define XB_TMO      128
#define XB_XCNT(j)  (256  + 64 * (j))
#define XB_XSUB(j)  (1280 + 64 * (j))
#define XB_XGEN(j)  (2304 + 64 * (j))
#define XB_TOP      3328
#define XB_TOPGEN   3392
#define XCD_BAR_WORDS 3456
#define XB_SPIN_CAP (1u << 18)
__device__ __forceinline__ unsigned xb_ld(unsigned* p)              { return __hip_atomic_load(p, __ATOMIC_RELAXED, __HIP_MEMORY_SCOPE_AGENT); }
__device__ __forceinline__ unsigned xb_add(unsigned* p, unsigned v) { return __hip_atomic_fetch_add(p, v, __ATOMIC_RELAXED, __HIP_MEMORY_SCOPE_AGENT); }
__device__ __forceinline__ unsigned xb_xcc_id() { return (unsigned)__builtin_amdgcn_s_getreg((3 << 11) | 20) & 0xFu; }
#define XB_SPIN(cond, bar) do { unsigned _sp = 0; while (cond) { __builtin_amdgcn_s_sleep(1); \
    if ((++_sp & 255u) == 0u) { if (xb_ld(&(bar)[XB_TMO])) break; if (_sp > XB_SPIN_CAP) { atomicAdd(&(bar)[XB_TMO], 1u); break; } } } } while (0)
struct XcdBarrier { unsigned* bar; unsigned x; volatile LAS unsigned* st; };
__device__ __forceinline__ XcdBarrier xcd_barrier_post(unsigned* bar, volatile LAS unsigned* st) {
    XcdBarrier b; b.bar = bar; b.x = xb_xcc_id(); b.st = st;
    if (threadIdx.x == 0) (void)xb_add(&bar[XB_XCNT(b.x)], 1u);
    return b;
}
__device__ __forceinline__ void xcd_barrier_complete(unsigned* bar, unsigned x, unsigned& nloc, unsigned& nx) {
    const unsigned G = gridDim.x * gridDim.y * gridDim.z;
    unsigned sum, cnt, mine, sp = 0u;
    for (;;) {
        sum = 0u; cnt = 0u; mine = 0u;
#pragma unroll
        for (unsigned j = 0; j < 16; ++j) { const unsigned c = xb_ld(&bar[XB_XCNT(j)]); sum += c; cnt += (c > 0u) ? 1u : 0u; mine = (j == x) ? c : mine; }
        if (sum == G) break;
        __builtin_amdgcn_s_sleep(1);
        if ((++sp & 255u) == 0u) { if (xb_ld(&bar[XB_TMO])) break; if (sp > XB_SPIN_CAP) { atomicAdd(&bar[XB_TMO], 1u); break; } }
    }
    nloc = mine > 0u ? mine : 1u; nx = cnt > 0u ? cnt : 1u;
}
__device__ __forceinline__ void xcd_barrier(const XcdBarrier& b) {
    asm volatile("s_waitcnt vmcnt(0)" ::: "memory");
    __syncthreads();
    if (threadIdx.x == 0) {
        unsigned* bar = b.bar;
        __builtin_amdgcn_s_waitcnt(0);
        unsigned nloc = b.st[0], nx = b.st[1];
        if (nloc == 0u) { xcd_barrier_complete(bar, b.x, nloc, nx); b.st[0] = nloc; b.st[1] = nx; }
        const unsigned old = xb_add(&bar[XB_XSUB(b.x)], 1u);
        const unsigned gen = old / nloc;
        if (old + 1u == (gen + 1u) * nloc) {
            __builtin_amdgcn_fence(__ATOMIC_RELEASE, "agent");
            asm volatile("s_waitcnt vmcnt(0)" ::: "memory");
            const unsigned og = xb_add(&bar[XB_TOP], 1u);
            const unsigned tg = og / nx;
            if (og + 1u == (tg + 1u) * nx) xb_add(&bar[XB_TOPGEN], 1u);
            else XB_SPIN(xb_ld(&bar[XB_TOPGEN]) == tg, bar);
            __builtin_amdgcn_fence(__ATOMIC_ACQUIRE, "agent");
            xb_add(&bar[XB_XGEN(b.x)], 1u);
            asm volatile("s_waitcnt vmcnt(0)" ::: "memory");
        } else {
            XB_SPIN(xb_ld(&bar[XB_XGEN(b.x)]) == gen, bar);
            __builtin_amdgcn_fence(__ATOMIC_ACQUIRE, "agent");
            asm volatile("s_waitcnt vmcnt(0)" ::: "memory");
        }
    }
    __syncthreads();
}

struct Args { const float* in[N_IN]; float* out; unsigned char* ws; int ph_lo, ph_hi; };
struct Ctx {
    const float* const* in; float* out; unsigned char* ws; LAS unsigned char* lds;
    int tid, lane, wave, G, bid;
};
#define WSP(type, off) ((type*)(C.ws + (off)))
#define INP(i) (C.in[i])
#define LDS_WAIT() asm volatile("s_waitcnt lgkmcnt(0)" ::: "memory")

__device__ __forceinline__ void p0_adaln(const Ctx& C, int item) {
    LAS float* sv = (LAS float*)C.lds;
    LAS float* red = (LAS float*)(C.lds + 8192);
    const int l = item / 48, cbk = item % 48;
    for (int i = C.tid; i < 2048; i += 512) { const float v = i < 1024 ? INP(IX_C)[i] : INP(IX_CCTX)[i - 1024]; sv[i] = silu_f(v); }
    __syncthreads();
    const float* W = INP(IX_ADAW) + (size_t)l * D * NMOD + cbk * 128 + 2 * C.lane;
    const int k0 = C.wave * 128;
    f32x2 a0 = {0.f, 0.f}, a1 = {0.f, 0.f};
#pragma unroll 16
    for (int k = 0; k < 128; ++k) { const f32x2 w = *(const f32x2*)(W + (size_t)(k0 + k) * NMOD); const float s0 = sv[k0 + k], s1 = sv[1024 + k0 + k]; a0 += w * s0; a1 += w * s1; }
    red[(C.wave * 2 + 0) * 128 + 2 * C.lane] = a0.x; red[(C.wave * 2 + 0) * 128 + 2 * C.lane + 1] = a0.y;
    red[(C.wave * 2 + 1) * 128 + 2 * C.lane] = a1.x; red[(C.wave * 2 + 1) * 128 + 2 * C.lane + 1] = a1.y;
    __syncthreads();
    if (C.tid < 256) { const int s = C.tid >> 7, c = C.tid & 127; float v = INP(IX_ADAB)[l * NMOD + cbk * 128 + c];
#pragma unroll
        for (int w = 0; w < 8; ++w) v += red[(w * 2 + s) * 128 + c];
        WSP(float, WS_MODS)[(size_t)(l * 2 + s) * NMOD + cbk * 128 + c] = v; }
    __syncthreads();
}
struct WBlk { const float* src; int ld, c0, K; bf16_t* dst; };
__device__ __forceinline__ WBlk get_wblk(const Ctx& C, int cls, int vb) {
    WBlk w;
    if (cls == 0) {
        w.K = 1024;
        if (vb < 48) { const int j = vb / 24, r = vb % 24;
            if (r < 16) { w.src = (r < 8 ? INP(IX_AWX) : INP(IX_AWG)) + (size_t)j * D * D; w.ld = D; w.c0 = (r & 7) * 128; w.dst = WSP(bf16_t, W_A1 + j * SZ_A1) + (size_t)r * 128 * 1024; }
            else { const int rr = r - 16; w.src = INP(IX_AWO) + (size_t)j * D * D; w.ld = D; w.c0 = rr * 128; w.dst = WSP(bf16_t, W_A3 + j * SZ_A3) + (size_t)rr * 128 * 1024; }
        } else if (vb < 112) { const int bb = vb - 48, j = bb / 32, r = bb % 32;
            if (r < 24) { int c0; if (r < 8) c0 = r * 128; else { const int rr = r - 8; c0 = 1024 + (rr & 1) * 1024 + (rr >> 1) * 128; }
                w.src = INP(IX_BWIN) + (size_t)j * D * 3072; w.ld = 3072; w.c0 = c0; w.dst = WSP(bf16_t, W_B1 + j * SZ_B1) + (size_t)r * 128 * 1024; }
            else { const int rr = r - 24; w.src = INP(IX_BWO) + (size_t)j * D * D; w.ld = D; w.c0 = rr * 128; w.dst = WSP(bf16_t, W_B2 + j * SZ_B2) + (size_t)rr * 128 * 1024; }
        } else { const int bb = vb - 112, l = bb / 44, r = bb % 44;
            w.src = INP(IX_FWU) + (size_t)l * D * 2 * DFF; w.ld = 2 * DFF; w.c0 = (r & 1) * DFF + (r >> 1) * 128; w.dst = WSP(bf16_t, W_F1 + l * SZ_F1) + (size_t)r * 128 * 1024; }
    } else if (cls == 1) {
        const int j = vb / 32, rr = vb % 32, pn = rr >> 1, mem = rr & 1, d = pn >> 3, q = pn & 7, h = q >> 1, half = q & 1;
        w.K = 256; w.src = (mem ? INP(IX_AWI) : INP(IX_AWR)) + (size_t)(((j * 2 + d) * 4 + h)) * 65536; w.ld = 256; w.c0 = half * 128;
        w.dst = WSP(bf16_t, W_A2 + j * SZ_A2) + (size_t)(pn * 256 + mem * 128) * 256;
    } else {
        const int l = vb / 8, rr = vb % 8;
        w.K = DFF; w.src = INP(IX_FWD) + (size_t)l * DFF * D; w.ld = D; w.c0 = rr * 128; w.dst = WSP(bf16_t, W_F2 + l * SZ_F2) + (size_t)rr * 128 * DFF;
    }
    return w;
}
__device__ __forceinline__ void p0_transpose4(const WBlk& w, int rg, int kc, LAS float* scr, int lane) {
    const int n0 = 32 * rg, r8 = lane >> 3, c4 = lane & 7;
    f32x4 v[4][8];
#pragma unroll
    for (int t = 0; t < 4; ++t)
#pragma unroll
        for (int i = 0; i < 8; ++i) v[t][i] = *(const f32x4*)(w.src + (size_t)(64 * (4 * kc + t) + 8 * i + r8) * w.ld + w.c0 + n0 + 4 * c4);
#pragma unroll
    for (int t = 0; t < 4; ++t) { const int k0 = 64 * (4 * kc + t);
#pragma unroll
        for (int i = 0; i < 8; ++i) { LAS float* d = scr + (8 * i + r8) * 33 + 4 * c4; d[0] = v[t][i].x; d[1] = v[t][i].y; d[2] = v[t][i].z; d[3] = v[t][i].w; }
        LDS_WAIT(); asm volatile("" ::: "memory");
        const int c = lane & 7;
#pragma unroll
        for (int j = 0; j < 4; ++j) { const int n = (lane >> 3) + 8 * j; const LAS float* sp = scr + (8 * c) * 33 + n;
            u32x4 o; o.x = cvt_pk_bf16(sp[0 * 33], sp[1 * 33]); o.y = cvt_pk_bf16(sp[2 * 33], sp[3 * 33]); o.z = cvt_pk_bf16(sp[4 * 33], sp[5 * 33]); o.w = cvt_pk_bf16(sp[6 * 33], sp[7 * 33]);
            *(u32x4*)(w.dst + (size_t)(n0 + n) * w.K + k0 + 8 * c) = o; }
        LDS_WAIT(); asm volatile("" ::: "memory"); }
}
__device__ __forceinline__ void phase_p0(const Ctx& C) {
    for (int it = C.bid; it < 192; it += C.G) p0_adaln(C, it);
    LAS float* scr = (LAS float*)(C.lds + C.wave * 16384);
    const int gw = C.bid * 8 + C.wave, NGW = C.G * 8;
    constexpr int N0 = 288 * 16, N1 = 64 * 4, N2 = 32 * 44;
    for (int it = gw; it < N0 + N1 + N2; it += NGW) {
        int cls, vb, rg, kc;
        if (it < N0) { cls = 0; vb = it >> 4; rg = (it >> 2) & 3; kc = it & 3; }
        else if (it < N0 + N1) { const int r = it - N0; cls = 1; vb = r >> 2; rg = r & 3; kc = 0; }
        else { const int r = it - N0 - N1; cls = 2; vb = r / 44; const int rem = r % 44; rg = rem / 11; kc = rem % 11; }
        const WBlk w = get_wblk(C, cls, vb);
        p0_transpose4(w, rg, kc, scr, C.lane);
    }
}

__device__ __forceinline__ size_t cf_off(int t, int c, int K) { return ((size_t)((t >> 4) * (K >> 5) + (c >> 5)) << 9) + (size_t)((((c >> 3) & 3) << 4) + (t & 15)) * 8 + (c & 7); }
__device__ __forceinline__ void p1_rows4(const float* __restrict__ xbase, bf16_t* __restrict__ obase, bf16_t* __restrict__ rbase, float* __restrict__ ssbase, int nss, const f32x4 (&gs)[4], int r0, int lane, bool frag) {
    f32x4 v[4][4];
#pragma unroll
    for (int q = 0; q < 4; ++q)
#pragma unroll
        for (int j = 0; j < 4; ++j) v[q][j] = ((const f32x4*)(xbase + (size_t)(r0 + q) * D) + lane)[64 * j];
#pragma unroll
    for (int q = 0; q < 4; ++q) { float s = 0.f;
#pragma unroll
        for (int j = 0; j < 4; ++j) s += (v[q][j].x * v[q][j].x + v[q][j].y * v[q][j].y) + (v[q][j].z * v[q][j].z + v[q][j].w * v[q][j].w);
        s = wave_sum(s);
        if (lane < nss) ssbase[(size_t)(r0 + q) * nss + lane] = lane == 0 ? s : 0.f;
#pragma unroll
        for (int j = 0; j < 4; ++j) { const f32x4 y = v[q][j] * gs[j]; u32x2 w; w.x = cvt_pk_bf16(y.x, y.y); w.y = cvt_pk_bf16(y.z, y.w); *(u32x2*)(obase + (frag ? cf_off(r0 + q, 4 * lane + 256 * j, D) : (size_t)(r0 + q) * D + 4 * lane + 256 * j)) = w;
            if (rbase) { u32x2 r; r.x = cvt_pk_bf16(v[q][j].x, v[q][j].y); r.y = cvt_pk_bf16(v[q][j].z, v[q][j].w); ((u32x2*)(rbase + (size_t)(r0 + q) * D) + lane)[64 * j] = r; } } }
}
__device__ __forceinline__ void phase_p1(const Ctx& C) {
    const int gw = C.bid * 8 + C.wave, NGW = C.G * 8;
    const float* __restrict__ mods = WSP(float, WS_MODS);
    for (int s = 0; s < 2; ++s) {
        f32x4 gs[4];
#pragma unroll
        for (int j = 0; j < 4; ++j) gs[j] = *((const f32x4*)INP(IX_NMG) + C.lane + 64 * j) * (*((const f32x4*)(mods + (size_t)s * NMOD + 1024) + C.lane + 64 * j) + 1.0f);
        const int nrow = s ? CT : T;
        for (int r0 = gw * 4; r0 < nrow; r0 += NGW * 4)
            p1_rows4(s ? INP(IX_CTX) : INP(IX_X), s ? WSP(bf16_t, CX_XB) : WSP(bf16_t, WS_SLOT), s ? nullptr : WSP(bf16_t, WS_XRES), s ? WSP(float, CX_SSP) : WSP(float, WS_SSP), s ? 64 : 16, gs, r0, C.lane, s != 0);
    }
    for (int rb = gw; rb < 2048; rb += NGW) {
        const int r = rb * 16; const bf16_t* __restrict__ bt; int l, shoff; float* __restrict__ outp; int ostride;
        if (r < 4096) { const int j = r / 2048, n = r % 2048; bt = WSP(bf16_t, W_A1 + j * SZ_A1) + (size_t)n * 1024; l = 2 * j; shoff = 0; outp = WSP(float, WS_BIASM) + (size_t)(l * 2) * 3072 + n; ostride = 3072; }
        else if (r < 10240) { const int rr = r - 4096, j = rr / 3072, n = rr % 3072; bt = WSP(bf16_t, W_B1 + j * SZ_B1) + (size_t)n * 1024; l = 2 * j + 1; shoff = 0; outp = WSP(float, WS_BIASM) + (size_t)(l * 2) * 3072 + n; ostride = 3072; }
        else { const int rr = r - 10240; l = rr / 5632; const int n = rr % 5632; bt = WSP(bf16_t, W_F1 + l * SZ_F1) + (size_t)n * 1024; shoff = 3072; outp = WSP(float, WS_BIASF) + (size_t)(l * 2) * 5632 + n; ostride = 5632; }
        f32x4 sh[2][2][2];
#pragma unroll
        for (int st = 0; st < 2; ++st)
#pragma unroll
            for (int h = 0; h < 2; ++h) { const float* p = mods + (size_t)(l * 2 + st) * NMOD + shoff + h * 512 + 8 * C.lane; sh[st][h][0] = *(const f32x4*)p; sh[st][h][1] = *(const f32x4*)(p + 4); }
#pragma unroll 1
        for (int b4 = 0; b4 < 4; ++b4) {
            u32x4 wv[4][2];
#pragma unroll
            for (int q = 0; q < 4; ++q)
#pragma unroll
                for (int h = 0; h < 2; ++h) wv[q][h] = *(const u32x4*)(bt + (size_t)(b4 * 4 + q) * 1024 + h * 512 + 8 * C.lane);
#pragma unroll
            for (int q = 0; q < 4; ++q) { float a0 = 0.f, a1 = 0.f;
#pragma unroll
                for (int h = 0; h < 2; ++h) { const u32x4 w = wv[q][h];
                    const f32x4 lo = (f32x4){bf2f(w.x & 0xffffu), bf2f(w.x >> 16), bf2f(w.y & 0xffffu), bf2f(w.y >> 16)}, hi = (f32x4){bf2f(w.z & 0xffffu), bf2f(w.z >> 16), bf2f(w.w & 0xffffu), bf2f(w.w >> 16)};
                    const f32x4 p0 = lo * sh[0][h][0] + hi * sh[0][h][1], p1 = lo * sh[1][h][0] + hi * sh[1][h][1];
                    a0 += (p0.x + p0.y) + (p0.z + p0.w); a1 += (p1.x + p1.y) + (p1.z + p1.w); }
                a0 = wave_sum(a0); a1 = wave_sum(a1);
                if (C.lane == 0) { outp[b4 * 4 + q] = a0; outp[ostride + b4 * 4 + q] = a1; } }
        }
    }
    for (int i = C.bid * 512 + C.tid; i < 4096; i += C.G * 512) { const float x = INP(IX_ALAM)[i]; const float ls = fminf(x, 0.f) - log1pf(expf(-fabsf(x))); WSP(float, WS_LA8)[i] = 8.0f * 1.4426950409f * ls; }
}

__device__ __forceinline__ void phase_conv4(const Ctx& C, const bf16_t* __restrict__ UPRE, bf16_t* __restrict__ U, const float* __restrict__ cw, const float* __restrict__ cb) {
    const int cg = C.tid & 127, sub = C.tid >> 7, c0 = cg * 8;
    float w[4][8], b[8];
#pragma unroll
    for (int k = 0; k < 4; ++k)
#pragma unroll
        for (int e = 0; e < 8; ++e) w[k][e] = cw[k * D + c0 + e];
#pragma unroll
    for (int e = 0; e < 8; ++e) b[e] = cb[c0 + e];
    for (int it = C.bid; it < T / 64; it += C.G) {
        const int t0 = it * 64 + sub * 16;
        float win[3][8];
#pragma unroll
        for (int r = 0; r < 3; ++r) { const int t = t0 - 2 + r; u32x4 v = *(const u32x4*)(UPRE + (size_t)(t >= 0 ? t : 0) * D + c0); if (t < 0) v = (u32x4){0u, 0u, 0u, 0u};
            win[r][0] = bf2f(v.x & 0xffffu); win[r][1] = bf2f(v.x >> 16); win[r][2] = bf2f(v.y & 0xffffu); win[r][3] = bf2f(v.y >> 16); win[r][4] = bf2f(v.z & 0xffffu); win[r][5] = bf2f(v.z >> 16); win[r][6] = bf2f(v.w & 0xffffu); win[r][7] = bf2f(v.w >> 16); }
#pragma unroll
        for (int i = 0; i < 16; ++i) { const int t = t0 + i; u32x4 v = *(const u32x4*)(UPRE + (size_t)(t + 1 < T ? t + 1 : T - 1) * D + c0); if (t + 1 >= T) v = (u32x4){0u, 0u, 0u, 0u};
            const float nx[8] = {bf2f(v.x & 0xffffu), bf2f(v.x >> 16), bf2f(v.y & 0xffffu), bf2f(v.y >> 16), bf2f(v.z & 0xffffu), bf2f(v.z >> 16), bf2f(v.w & 0xffffu), bf2f(v.w >> 16)};
            float o[8];
#pragma unroll
            for (int e = 0; e < 8; ++e) { o[e] = b[e] + w[0][e] * win[0][e] + w[1][e] * win[1][e] + w[2][e] * win[2][e] + w[3][e] * nx[e]; win[0][e] = win[1][e]; win[1][e] = win[2][e]; win[2][e] = nx[e]; }
            u32x4 ow; ow.x = cvt_pk_bf16(o[0], o[1]); ow.y = cvt_pk_bf16(o[2], o[3]); ow.z = cvt_pk_bf16(o[4], o[5]); ow.w = cvt_pk_bf16(o[6], o[7]);
            *(u32x4*)(U + (size_t)t * D + c0) = ow; }
    }
}
__device__ __forceinline__ void phase_vconv(const Ctx& C, const bf16_t* __restrict__ GB, const bf16_t* __restrict__ Z, bf16_t* __restrict__ Q, const float* __restrict__ cw, const float* __restrict__ cb) {
    const int cg = C.tid & 127, sub = C.tid >> 7, c0 = cg * 8;
    float w[3][8], b[8];
#pragma unroll
    for (int k = 0; k < 3; ++k)
#pragma unroll
        for (int e = 0; e < 8; ++e) w[k][e] = cw[k * D + c0 + e];
#pragma unroll
    for (int e = 0; e < 8; ++e) b[e] = cb[c0 + e];
    const int vb = (C.G & 7) == 0 ? (C.bid & 7) * (C.G >> 3) + (C.bid >> 3) : C.bid;
    for (int it = vb; it < T / 64; it += C.G) {
        const int t0 = it * 64 + sub * 16;
        const bool lo_ok = it > 0, hi_ok = it < T / 64 - 1;
        const long om = lo_ok ? -(long)64 * D : 0, op = hi_ok ? (long)64 * D : 0; const float ml = lo_ok ? 1.f : 0.f, mh = hi_ok ? 1.f : 0.f;
#pragma unroll 8
        for (int i = 0; i < 16; ++i) { const int t = t0 + i; const size_t off = (size_t)t * D + c0;
            const u32x4 g = *(const u32x4*)(GB + off), z1 = *(const u32x4*)(Z + off);
            const u32x4 z0 = *(const u32x4*)(Z + (long)off + om), z2 = *(const u32x4*)(Z + (long)off + op);
            const unsigned gw[4] = {g.x, g.y, g.z, g.w}, a0[4] = {z0.x, z0.y, z0.z, z0.w}, a1[4] = {z1.x, z1.y, z1.z, z1.w}, a2[4] = {z2.x, z2.y, z2.z, z2.w};
            unsigned ow[4];
#pragma unroll
            for (int p = 0; p < 4; ++p) {
                const float lo = bf2f(gw[p] & 0xffffu) * (b[2 * p] + ml * w[0][2 * p] * bf2f(a0[p] & 0xffffu) + w[1][2 * p] * bf2f(a1[p] & 0xffffu) + mh * w[2][2 * p] * bf2f(a2[p] & 0xffffu));
                const float hi = bf2f(gw[p] >> 16) * (b[2 * p + 1] + ml * w[0][2 * p + 1] * bf2f(a0[p] >> 16) + w[1][2 * p + 1] * bf2f(a1[p] >> 16) + mh * w[2][2 * p + 1] * bf2f(a2[p] >> 16));
                ow[p] = cvt_pk_bf16(lo, hi); }
            *(u32x4*)(Q + off) = (u32x4){ow[0], ow[1], ow[2], ow[3]}; }
    }
}

typedef _Float16 h16x8 __attribute__((ext_vector_type(8)));
__device__ __forceinline__ void eb_unpack(u32x4 w, f32x4& a, f32x4& b) {
    const h16x8 h = __builtin_bit_cast(h16x8, w);
    a = (f32x4){1.0f - (float)h[0], 1.0f - (float)h[2], 1.0f - (float)h[4], 1.0f - (float)h[6]}; b = (f32x4){(float)h[1], (float)h[3], (float)h[5], (float)h[7]};
}
__device__ __forceinline__ void phase_scan1(const Ctx& C, const h16* __restrict__ EB) {
    LAS float* lagg = (LAS float*)C.lds;
    for (int task = C.bid; task < 256; task += C.G) {
        const int j = task >> 2, cbk = task & 3, ch = cbk * 256 + 4 * C.lane, r0 = j * 256 + 32 * C.wave;
#pragma unroll
        for (int d = 0; d < 2; ++d) {
            const h16* e = EB + (((size_t)d * T + r0) * D + ch) * 2;
            f32x4 P = {1.f, 1.f, 1.f, 1.f}, Q = {0.f, 0.f, 0.f, 0.f};
            u32x4 ev[32];
#pragma unroll
            for (int i = 0; i < 32; ++i) ev[i] = *(const u32x4*)(e + (size_t)i * D * 2);
#pragma unroll
            for (int i = 0; i < 32; ++i) { const int ii = d ? 31 - i : i; f32x4 a, bb; eb_unpack(ev[ii], a, bb); P = P * a; Q = a * Q + bb; }
            float* ag = WSP(float, WS_AGG32) + (((size_t)d * 512 + j * 8 + C.wave) * D + ch) * 2;
            *(f32x4*)ag = (f32x4){P[0], Q[0], P[1], Q[1]}; *(f32x4*)(ag + 4) = (f32x4){P[2], Q[2], P[3], Q[3]};
            LAS float* la = lagg + ((d * 8 + C.wave) * 256 + 4 * C.lane) * 2;
            *(LAS f32x4*)la = (f32x4){P[0], Q[0], P[1], Q[1]}; *(LAS f32x4*)(la + 4) = (f32x4){P[2], Q[2], P[3], Q[3]};
        }
        __syncthreads();
        { const int d = C.tid >> 8, c = C.tid & 255; float P = 1.f, Q = 0.f;
#pragma unroll
            for (int i = 0; i < 8; ++i) { const int w = d ? 7 - i : i; const f32x2 pq = *(const LAS f32x2*)(lagg + ((d * 8 + w) * 256 + c) * 2); Q = pq.x * Q + pq.y; P *= pq.x; }
            *(f32x2*)(WSP(float, WS_AGGT) + (((size_t)d * 64 + j) * D + cbk * 256 + c) * 2) = (f32x2){P, Q}; }
        __syncthreads();
    }
}
__device__ __forceinline__ void phase_scan2(const Ctx& C, const h16* __restrict__ EB, const bf16_t* __restrict__ Gt, bf16_t* __restrict__ GS, const float* __restrict__ h0) {
    LAS float* cin = (LAS float*)(C.lds + RING_BYTES + 1024);
    LAS unsigned char* hbw = C.lds + C.wave * 16384 + 8 * C.lane;
    for (int task = C.bid; task < 256; task += C.G) {
        const int j = task >> 2, cbk = task & 3;
        const int ch = cbk * 256 + 4 * C.lane, r0 = j * 256 + 32 * C.wave;
        u32x4 ev[32];
        { const h16* e = EB + (((size_t)T + r0) * D + ch) * 2;
#pragma unroll
            for (int i = 0; i < 32; ++i) ev[i] = *(const u32x4*)(e + (size_t)i * D * 2); }
        { int tid_ = C.tid; asm volatile("" : "+v"(tid_));
            const int d = tid_ >> 8, c = tid_ & 255, chn = cbk * 256 + c; float h = h0[d * D + chn];
            const int n = d ? 63 - j : j; const float* base = WSP(float, WS_AGGT) + ((size_t)d * 64 * D + chn) * 2;
            for (int i = 0; i < n; i += 16) { f32x2 pq[16];
#pragma unroll
                for (int u = 0; u < 16; ++u) { const int ii = i + u; const int im = ii < n ? ii : n - 1; const int jj = d ? 63 - im : im; pq[u] = *(const f32x2*)(base + (size_t)jj * D * 2); if (ii >= n) pq[u] = (f32x2){1.f, 0.f}; }
#pragma unroll
                for (int u = 0; u < 16; ++u) h = pq[u].x * h + pq[u].y; }
            cin[d * 256 + c] = h; }
        __syncthreads();
        f32x4 hc[2];
#pragma unroll
        for (int d = 0; d < 2; ++d) { f32x4 h = *(const LAS f32x4*)(cin + d * 256 + 4 * C.lane); const int n = d ? 7 - C.wave : C.wave;
            f32x4 pq[7][2];
#pragma unroll
            for (int u = 0; u < 7; ++u) { const int im = u < n ? u : (n > 0 ? n - 1 : 0); const int w = d ? 7 - im : im; const float* ag = WSP(float, WS_AGG32) + (((size_t)d * 512 + j * 8 + w) * D + ch) * 2; pq[u][0] = *(const f32x4*)ag; pq[u][1] = *(const f32x4*)(ag + 4); }
#pragma unroll
            for (int u = 0; u < 7; ++u) if (u < n) { h[0] = pq[u][0][0] * h[0] + pq[u][0][1]; h[1] = pq[u][0][2] * h[1] + pq[u][0][3]; h[2] = pq[u][1][0] * h[2] + pq[u][1][1]; h[3] = pq[u][1][2] * h[3] + pq[u][1][3]; }
            hc[d] = h; }
        { f32x4 h = hc[1];
#pragma unroll
            for (int i = 31; i >= 0; --i) { f32x4 a, bb; eb_unpack(ev[i], a, bb); h = a * h + bb;
                u32x2 w; w.x = cvt_pk_bf16(h[0], h[1]); w.y = cvt_pk_bf16(h[2], h[3]); *(LAS u32x2*)(hbw + i * 512) = w; } }
        { f32x4 h = hc[0]; const h16* e = EB + ((size_t)r0 * D + ch) * 2;
#pragma unroll
            for (int hb2 = 0; hb2 < 2; ++hb2) { u32x2 gv[16];
#pragma unroll
                for (int i = 0; i < 16; ++i) { ev[i] = *(const u32x4*)(e + (size_t)(16 * hb2 + i) * D * 2); gv[i] = *(const u32x2*)(Gt + (size_t)(r0 + 16 * hb2 + i) * D + ch); }
#pragma unroll
                for (int i = 0; i < 16; ++i) { f32x4 a, bb; eb_unpack(ev[i], a, bb); h = a * h + bb;
                    const f32x4 hb = bf4_to_f4(*(const LAS u32x2*)(hbw + (16 * hb2 + i) * 512)); const f32x4 o = bf4_to_f4(gv[i]) * (h + hb);
                    u32x2 w; w.x = cvt_pk_bf16(o[0], o[1]); w.y = cvt_pk_bf16(o[2], o[3]); *(u32x2*)(GS + (size_t)(r0 + 16 * hb2 + i) * D + ch) = w; } } }
        __syncthreads();
    }
}
__device__ __forceinline__ void phase_final(const Ctx& C, const float* __restrict__ ssp) {
    const int gw = C.bid * 8 + C.wave, NGW = C.G * 8;
    const bf16_t* __restrict__ xres = WSP(bf16_t, WS_XRES); float* __restrict__ out = C.out; const float* __restrict__ fg = INP(IX_FG);
    f32x4 g[4];
#pragma unroll
    for (int j = 0; j < 4; ++j) g[j] = *((const f32x4*)fg + C.lane + 64 * j);
    for (int r0 = gw * 4; r0 < T; r0 += NGW * 4) {
        u32x2 xv[4][4]; float sv[4];
#pragma unroll
        for (int q = 0; q < 4; ++q) { { const float v_ = ssp[(size_t)(r0 + q) * 16 + (C.lane & 15)]; sv[q] = C.lane < 16 ? v_ : 0.f; }
#pragma unroll
            for (int j = 0; j < 4; ++j) xv[q][j] = ((const u32x2*)(xres + (size_t)(r0 + q) * D) + C.lane)[64 * j]; }
#pragma unroll
        for (int q = 0; q < 4; ++q) { const float rstd = 1.0f / sqrtf(wave_sum(sv[q]) * (1.0f / D) + EPS); f32x4* orow = (f32x4*)(out + (size_t)(r0 + q) * D) + C.lane;
#pragma unroll
            for (int j = 0; j < 4; ++j) orow[64 * j] = bf4_to_f4(xv[q][j]) * rstd * g[j]; }
    }
}
template <int NB, int UNR, int K>
__device__ __forceinline__ void ctx_mm(f32x4 (&acc)[2][NB], const bf16_t* A, int lda, const bf16_t* const (&Bp)[NB], int wave, int lane, int tid, LAS unsigned char* lds) {
    const int fr = lane & 15, fq = lane >> 4;
    constexpr int ROWB = K * 2 + 16, PPT = K / 256, NK = K / 32;
    const bf16_t* a0 = A + (size_t)(2 * wave) * lda * 16 + lane * 8; const bf16_t* a1 = a0 + (size_t)lda * 16;
    bf16x8 af[UNR][2];
    {   u32x4 stg[NB][PPT];
#pragma unroll
        for (int nb = 0; nb < NB; ++nb)
#pragma unroll
            for (int q = 0; q < PPT; ++q) { const int p = tid + 512 * q, r = p / (K / 8), kc = p % (K / 8); stg[nb][q] = *(const u32x4*)(Bp[nb] + (size_t)r * K + kc * 8); }
        __builtin_amdgcn_sched_barrier(0);
#pragma unroll
        for (int u = 0; u < UNR; ++u) { af[u][0] = *(const bf16x8*)(a0 + u * 512); af[u][1] = *(const bf16x8*)(a1 + u * 512); }
        __builtin_amdgcn_sched_barrier(0);
#pragma unroll
        for (int nb = 0; nb < NB; ++nb)
#pragma unroll
            for (int q = 0; q < PPT; ++q) { const int p = tid + 512 * q, r = p / (K / 8), kc = p % (K / 8); *(LAS u32x4*)(lds + (nb * 16 + r) * ROWB + kc * 16) = stg[nb][q]; } }
#pragma unroll
    for (int nb = 0; nb < NB; ++nb) { acc[0][nb] = (f32x4){0.f, 0.f, 0.f, 0.f}; acc[1][nb] = (f32x4){0.f, 0.f, 0.f, 0.f}; }
    __syncthreads();
    const LAS unsigned char* bl = lds + fr * ROWB + fq * 16;
#pragma unroll
    for (int kk = 0; kk < NK; ++kk) { constexpr int dummy = 0; (void)dummy; const int u = kk % UNR;
#pragma unroll
        for (int nb = 0; nb < NB; ++nb) { const bf16x8 bf = *(const LAS bf16x8*)(bl + nb * 16 * ROWB + kk * 64);
            acc[0][nb] = __builtin_amdgcn_mfma_f32_16x16x32_bf16(bf, af[u][0], acc[0][nb], 0, 0, 0); acc[1][nb] = __builtin_amdgcn_mfma_f32_16x16x32_bf16(bf, af[u][1], acc[1][nb], 0, 0, 0); }
        __builtin_amdgcn_sched_barrier(0);
        if (kk + UNR < NK) { af[u][0] = *(const bf16x8*)(a0 + (kk + UNR) * 512); af[u][1] = *(const bf16x8*)(a1 + (kk + UNR) * 512); }
        __builtin_amdgcn_sched_barrier(0);
    }
    __syncthreads();
}
template <int UNR, int K>
__device__ __forceinline__ void ctx_mm1(f32x4& acc, const bf16_t* A, int lda, const bf16_t* Bp, int row0, int lane, int tid, LAS unsigned char* lds) {
    const int fr = lane & 15, fq = lane >> 4;
    constexpr int ROWB = K * 2 + 16, PPT = K / 256, NK = K / 32;
    const bf16_t* a0 = A + (size_t)(row0 >> 4) * lda * 16 + lane * 8;
    bf16x8 af[UNR];
    {   u32x4 stg[PPT];
#pragma unroll
        for (int q = 0; q < PPT; ++q) { const int p = tid + 512 * q, r = p / (K / 8), kc = p % (K / 8); stg[q] = *(const u32x4*)(Bp + (size_t)r * K + kc * 8); }
        __builtin_amdgcn_sched_barrier(0);
#pragma unroll
        for (int u = 0; u < UNR; ++u) af[u] = *(const bf16x8*)(a0 + u * 512);
        __builtin_amdgcn_sched_barrier(0);
#pragma unroll
        for (int q = 0; q < PPT; ++q) { const int p = tid + 512 * q, r = p / (K / 8), kc = p % (K / 8); *(LAS u32x4*)(lds + r * ROWB + kc * 16) = stg[q]; } }
    acc = (f32x4){0.f, 0.f, 0.f, 0.f};
    __syncthreads();
    const LAS unsigned char* bl = lds + fr * ROWB + fq * 16;
#pragma unroll
    for (int kk = 0; kk < NK; ++kk) { const int u = kk % UNR;
        { const bf16x8 bf = *(const LAS bf16x8*)(bl + kk * 64); acc = __builtin_amdgcn_mfma_f32_16x16x32_bf16(bf, af[u], acc, 0, 0, 0); }
        __builtin_amdgcn_sched_barrier(0);
        if (kk + UNR < NK) af[u] = *(const bf16x8*)(a0 + (kk + UNR) * 512);
        __builtin_amdgcn_sched_barrier(0);
    }
    __syncthreads();
}
struct CtxSS { f32x4 a, b, c, d; };
__device__ __forceinline__ CtxSS ctx_ss_load(const float* sspc, int row, int fq) { const float* p = sspc + (size_t)row * 64 + fq * 16; CtxSS r; r.a = *(const f32x4*)p; r.b = *(const f32x4*)(p + 4); r.c = *(const f32x4*)(p + 8); r.d = *(const f32x4*)(p + 12); return r; }
__device__ __forceinline__ float ctx_rstd_fin(const CtxSS& v, int fr, int fq) {
    float s = ((v.a.x + v.a.y) + (v.a.z + v.a.w)) + ((v.b.x + v.b.y) + (v.b.z + v.b.w)) + ((v.c.x + v.c.y) + (v.c.z + v.c.w)) + ((v.d.x + v.d.y) + (v.d.z + v.d.w));
    s = add_x16(s); s = add_x32(s, XL32(fr, fq));
    return 1.0f / sqrtf(s * (1.0f / D) + EPS);
}
struct CtxP {
    int kind;
    const bf16_t* A; int lda, K; const bf16_t* Bt; const float* sspi; const float* bias;
    const float* hin; float* hout; bf16_t* xbo; const float* gate; const float* ng; const float* sc; float* sspo;
    bf16_t* o1; bf16_t* o2;
    const float* cw; const float* cb; const float* br; const float* bi; const float* la8; float* h0;
};
template <int KW> struct CtxCW { f32x4 w[KW][2]; f32x4 b[2]; };
template <int KW>
__device__ __forceinline__ CtxCW<KW> ctx_cw_load(const float* cw, int cstride, const float* cb, int c) {
    CtxCW<KW> r;
#pragma unroll
    for (int k = 0; k < KW; ++k) { r.w[k][0] = *(const f32x4*)(cw + (size_t)k * cstride + c); r.w[k][1] = *(const f32x4*)(cw + (size_t)k * cstride + c + 4); }
    r.b[0] = *(const f32x4*)(cb + c); r.b[1] = *(const f32x4*)(cb + c + 4);
    return r;
}
template <int KW, int PAD>
__device__ __forceinline__ void ctx_conv_rows(float (&o)[8], const LAS float* tile, int t, int hh, const CtxCW<KW>& cwv) {
    f32x4 o0 = cwv.b[0], o1 = cwv.b[1];
#pragma unroll
    for (int k = 0; k < KW; ++k) { const int tt = t + k - PAD; if (tt >= 0 && tt < CT) {
        const f32x4 a = *(const LAS f32x4*)(tile + tt * 16 + 8 * hh), b = *(const LAS f32x4*)(tile + tt * 16 + 8 * hh + 4);
        o0 += cwv.w[k][0] * a; o1 += cwv.w[k][1] * b; } }
    o[0] = o0[0]; o[1] = o0[1]; o[2] = o0[2]; o[3] = o0[3]; o[4] = o1[0]; o[5] = o1[1]; o[6] = o1[2]; o[7] = o1[3];
}
__device__ __forceinline__ void ctx_item(const Ctx& C0, const CtxP& P, int item) {
    Ctx C = C0; asm volatile("" : "+v"(C.lane)); C.tid = C.wave * 64 + C.lane;
    const int fr = C.lane & 15, fq = C.lane >> 4, c0 = 16 * item;
    LAS float* t0 = (LAS float*)C.lds; LAS float* t1 = t0 + 4096; LAS float* t2 = t1 + 4096; LAS float* t3 = t2 + 4096; LAS float* tagg = t3 + 4096;
    const int tt = C.tid >> 1, hh = C.tid & 1;
    if (P.kind == 1) {
        f32x4 acc[2][2]; const bf16_t* const Bp[2] = {P.Bt + (size_t)c0 * P.K, P.Bt + (size_t)(1024 + c0) * P.K};
        const f32x4 b0 = *(const f32x4*)(P.bias + c0 + 4 * fq), b1 = *(const f32x4*)(P.bias + 1024 + c0 + 4 * fq);
        const CtxSS ssv[2] = {ctx_ss_load(P.sspi, 32 * C.wave + fr, fq), ctx_ss_load(P.sspi, 32 * C.wave + 16 + fr, fq)};
        ctx_mm<2, 16, 1024>(acc, P.A, P.lda, Bp, C.wave, C.lane, C.tid, C.lds);
        const CtxCW<4> cwv = ctx_cw_load<4>(P.cw, D, P.cb, c0 + 8 * hh);
#pragma unroll
        for (int g = 0; g < 2; ++g) { const int t = 32 * C.wave + 16 * g + fr; const float rs = ctx_rstd_fin(ssv[g], fr, fq);
            *(LAS f32x4*)(t0 + t * 16 + 4 * fq) = acc[g][0] * rs + b0;
            const f32x4 gp = acc[g][1] * rs + b1; u32x2 w; w.x = cvt_pk_bf16(gelu_t(gp[0]), gelu_t(gp[1])); w.y = cvt_pk_bf16(gelu_t(gp[2]), gelu_t(gp[3]));
            *(u32x2*)(P.o2 + (size_t)t * D + c0 + 4 * fq) = w; }
        __syncthreads();
        float o[8]; ctx_conv_rows<4, 2>(o, t0, tt, hh, cwv);
        u32x4 w; w.x = cvt_pk_bf16(o[0], o[1]); w.y = cvt_pk_bf16(o[2], o[3]); w.z = cvt_pk_bf16(o[4], o[5]); w.w = cvt_pk_bf16(o[6], o[7]);
        *(u32x4*)(P.o1 + cf_off(tt, c0 + 8 * hh, D)) = w;
        __syncthreads();
    } else if (P.kind == 2) {
        f32x4 acc[2][4]; const int q = c0 >> 7, cl = c0 & 127, h = c0 >> 8;
        const bf16_t* const Bp[4] = {P.Bt + (size_t)((0 * 8 + q) * 256 + cl) * 256, P.Bt + (size_t)((0 * 8 + q) * 256 + 128 + cl) * 256, P.Bt + (size_t)((1 * 8 + q) * 256 + cl) * 256, P.Bt + (size_t)((1 * 8 + q) * 256 + 128 + cl) * 256};
        const u32x2 uw2[2] = {*(const u32x2*)(P.A + cf_off(32 * C.wave + fr, c0 + 4 * fq, D)), *(const u32x2*)(P.A + cf_off(32 * C.wave + 16 + fr, c0 + 4 * fq, D))};
        f32x4 brv2[2], biv2[2], lav2[2];
#pragma unroll
        for (int d = 0; d < 2; ++d) { brv2[d] = *(const f32x4*)(P.br + d * D + c0 + 4 * fq); biv2[d] = *(const f32x4*)(P.bi + d * D + c0 + 4 * fq); lav2[d] = *(const f32x4*)(P.la8 + d * D + c0 + 4 * fq); }
        ctx_mm<4, 8, 256>(acc, P.A + h * 256 * 16, P.lda, Bp, C.wave, C.lane, C.tid, C.lds);
#pragma unroll
        for (int g = 0; g < 2; ++g) { const int t = 32 * C.wave + 16 * g + fr; const f32x4 uu = bf4_to_f4(uw2[g]);
#pragma unroll
            for (int d = 0; d < 2; ++d) { const f32x4 brv = brv2[d], biv = biv2[d], lav = lav2[d];
                f32x4 av, bv;
#pragma unroll
                for (int j = 0; j < 4; ++j) { const float r = sigm(acc[g][2 * d][j] + brv[j]), ig = sigm(acc[g][2 * d + 1][j] + biv[j]); const float a = __builtin_amdgcn_exp2f(r * lav[j]), e = 1.0f - a; av[j] = a; bv[j] = __builtin_amdgcn_sqrtf(e * (1.0f + a)) * ig * uu[j]; }
                *(LAS f32x4*)((d ? t2 : t0) + t * 16 + 4 * fq) = av; *(LAS f32x4*)((d ? t3 : t1) + t * 16 + 4 * fq) = bv; } }
        __syncthreads();
        { const int c = C.tid & 15, d = (C.tid >> 4) & 1, chk = C.tid >> 5; const LAS float* ta = d ? t2 : t0; LAS float* tb = d ? t3 : t1;
            float Pp = 1.f, Qq = 0.f;
#pragma unroll
            for (int i = 0; i < 16; ++i) { const int t = 16 * chk + (d ? 15 - i : i); const float a = ta[t * 16 + c], b = tb[t * 16 + c]; Qq = a * Qq + b; Pp *= a; }
            tagg[((d * 16 + chk) * 16 + c) * 2] = Pp; tagg[((d * 16 + chk) * 16 + c) * 2 + 1] = Qq;
            __syncthreads();
            float hcar = 0.f; const int n = d ? 15 - chk : chk;
            for (int i = 0; i < n; ++i) { const int cc = d ? 15 - i : i; hcar = tagg[((d * 16 + cc) * 16 + c) * 2] * hcar + tagg[((d * 16 + cc) * 16 + c) * 2 + 1]; }
#pragma unroll
            for (int i = 0; i < 16; ++i) { const int t = 16 * chk + (d ? 15 - i : i); hcar = ta[t * 16 + c] * hcar + tb[t * 16 + c]; tb[t * 16 + c] = hcar; }
            if ((d == 0 && chk == 15) || (d == 1 && chk == 0)) P.h0[d * D + c0 + c] = hcar; }
        __syncthreads();
        if (P.o1) { const f32x4 f0 = *(const LAS f32x4*)(t1 + tt * 16 + 8 * hh), f1 = *(const LAS f32x4*)(t1 + tt * 16 + 8 * hh + 4), r0 = *(const LAS f32x4*)(t3 + tt * 16 + 8 * hh), r1 = *(const LAS f32x4*)(t3 + tt * 16 + 8 * hh + 4);
            const u32x4 gw = *(const u32x4*)(P.o2 + (size_t)tt * D + c0 + 8 * hh);
            const f32x4 s0 = f0 + r0, s1 = f1 + r1;
            u32x4 w; w.x = cvt_pk_bf16(bf2f(gw.x & 0xffffu) * s0[0], bf2f(gw.x >> 16) * s0[1]); w.y = cvt_pk_bf16(bf2f(gw.y & 0xffffu) * s0[2], bf2f(gw.y >> 16) * s0[3]);
            w.z = cvt_pk_bf16(bf2f(gw.z & 0xffffu) * s1[0], bf2f(gw.z >> 16) * s1[1]); w.w = cvt_pk_bf16(bf2f(gw.w & 0xffffu) * s1[2], bf2f(gw.w >> 16) * s1[3]);
            *(u32x4*)(P.o1 + cf_off(tt, c0 + 8 * hh, D)) = w; }
        __syncthreads();
    } else if (P.kind == 4) {
        const int cg = item & 63, c4 = 16 * cg, t = 128 * (item >> 6) + 16 * C.wave + fr; const size_t off = (size_t)t * D + c4 + 4 * fq;
        const f32x4 gv = *(const f32x4*)(P.gate + c4 + 4 * fq); const f32x4 gs = *(const f32x4*)(P.ng + c4 + 4 * fq) * (*(const f32x4*)(P.sc + c4 + 4 * fq) + 1.0f);
        const f32x4 hold = *(const f32x4*)(P.hin + off);
        f32x4 acc;
        if (P.K == D) ctx_mm1<32, 1024>(acc, P.A, P.lda, P.Bt + (size_t)c4 * 1024, 128 * (item >> 6) + 16 * C.wave, C.lane, C.tid, C.lds);
        else ctx_mm1<22, 2816>(acc, P.A, P.lda, P.Bt + (size_t)c4 * 2816, 128 * (item >> 6) + 16 * C.wave, C.lane, C.tid, C.lds);
        const f32x4 hn = hold + gv * acc;
        *(f32x4*)(P.hout + off) = hn;
        float ss = (hn[0] * hn[0] + hn[1] * hn[1]) + (hn[2] * hn[2] + hn[3] * hn[3]); ss = add_x16(ss); ss = add_x32(ss, XL32(fr, fq));
        if (fq == 0) P.sspo[(size_t)t * 64 + cg] = ss;
        const f32x4 y = hn * gs; u32x2 w; w.x = cvt_pk_bf16(y[0], y[1]); w.y = cvt_pk_bf16(y[2], y[3]); *(u32x2*)(P.xbo + cf_off(t, c4 + 4 * fq, D)) = w;
    } else if (P.kind == 5) {
        f32x4 acc[2][2]; const int q = c0 >> 7, cl = c0 & 127, nb0 = q * 256 + cl;
        const bf16_t* const Bp[2] = {P.Bt + (size_t)nb0 * P.K, P.Bt + (size_t)(nb0 + 128) * P.K};
        const f32x4 b0 = *(const f32x4*)(P.bias + nb0 + 4 * fq), b1 = *(const f32x4*)(P.bias + nb0 + 128 + 4 * fq);
        const CtxSS ssv[2] = {ctx_ss_load(P.sspi, 32 * C.wave + fr, fq), ctx_ss_load(P.sspi, 32 * C.wave + 16 + fr, fq)};
        ctx_mm<2, 16, 1024>(acc, P.A, P.lda, Bp, C.wave, C.lane, C.tid, C.lds);
        const CtxCW<3> cwv = ctx_cw_load<3>(P.cw, DFF, P.cb, c0 + 8 * hh);
#pragma unroll
        for (int g = 0; g < 2; ++g) { const int t = 32 * C.wave + 16 * g + fr; const float rs = ctx_rstd_fin(ssv[g], fr, fq);
            *(LAS f32x4*)(t0 + t * 16 + 4 * fq) = acc[g][0] * rs + b0; *(LAS f32x4*)(t1 + t * 16 + 4 * fq) = acc[g][1] * rs + b1; }
        __syncthreads();
        float o[8]; ctx_conv_rows<3, 1>(o, t0, tt, hh, cwv);
        const f32x4 v0 = *(const LAS f32x4*)(t1 + tt * 16 + 8 * hh), v1 = *(const LAS f32x4*)(t1 + tt * 16 + 8 * hh + 4);
        u32x4 w; w.x = cvt_pk_bf16(silu_f(o[0]) * v0[0], silu_f(o[1]) * v0[1]); w.y = cvt_pk_bf16(silu_f(o[2]) * v0[2], silu_f(o[3]) * v0[3]);
        w.z = cvt_pk_bf16(silu_f(o[4]) * v1[0], silu_f(o[5]) * v1[1]); w.w = cvt_pk_bf16(silu_f(o[6]) * v1[2], silu_f(o[7]) * v1[3]);
        *(u32x4*)(P.o1 + cf_off(tt, c0 + 8 * hh, DFF)) = w;
        __syncthreads();
    } else {
        f32x4 acc[2][3]; const int q = c0 >> 7, cl = c0 & 127, nb1 = 1024 + q * 256 + cl;
        const bf16_t* const Bp[3] = {P.Bt + (size_t)c0 * P.K, P.Bt + (size_t)nb1 * P.K, P.Bt + (size_t)(nb1 + 128) * P.K};
        const f32x4 b0 = *(const f32x4*)(P.bias + c0 + 4 * fq), b1 = *(const f32x4*)(P.bias + nb1 + 4 * fq), b2 = *(const f32x4*)(P.bias + nb1 + 128 + 4 * fq);
        const CtxSS ssv[2] = {ctx_ss_load(P.sspi, 32 * C.wave + fr, fq), ctx_ss_load(P.sspi, 32 * C.wave + 16 + fr, fq)};
        ctx_mm<3, 8, 1024>(acc, P.A, P.lda, Bp, C.wave, C.lane, C.tid, C.lds);
        const CtxCW<3> cwv = ctx_cw_load<3>(P.cw, D, P.cb, c0 + 8 * hh);
#pragma unroll
        for (int g = 0; g < 2; ++g) { const int t = 32 * C.wave + 16 * g + fr; const float rs = ctx_rstd_fin(ssv[g], fr, fq);
            *(LAS f32x4*)(t0 + t * 16 + 4 * fq) = (acc[g][1] * rs + b1) * (acc[g][2] * rs + b2); *(LAS f32x4*)(t1 + t * 16 + 4 * fq) = acc[g][0] * rs + b0; }
        __syncthreads();
        float o[8]; ctx_conv_rows<3, 1>(o, t0, tt, hh, cwv);
        const f32x4 v0 = *(const LAS f32x4*)(t1 + tt * 16 + 8 * hh), v1 = *(const LAS f32x4*)(t1 + tt * 16 + 8 * hh + 4);
        u32x4 w; w.x = cvt_pk_bf16(o[0] * v0[0], o[1] * v0[1]); w.y = cvt_pk_bf16(o[2] * v0[2], o[3] * v0[3]); w.z = cvt_pk_bf16(o[4] * v1[0], o[5] * v1[1]); w.w = cvt_pk_bf16(o[6] * v1[2], o[7] * v1[3]);
        *(u32x4*)(P.o1 + cf_off(tt, c0 + 8 * hh, D)) = w;
        __syncthreads();
    }
}
__device__ __forceinline__ int ctx_step(const Ctx& C, int ph, CtxP& P) {
    const float* mods = WSP(float, WS_MODS);
#define CMOD(l, chunk) (mods + (size_t)((l) * 2 + 1) * NMOD + (chunk) * 1024)
#define CXB(i) (WSP(bf16_t, CX_XB) + (size_t)(i) * CT * D)
#define CSSP(i) (WSP(float, CX_SSP) + (size_t)(i) * CT * 64)
    P.kind = 0; P.A = nullptr; P.lda = D; P.K = D; P.Bt = nullptr; P.sspi = nullptr; P.bias = nullptr; P.hin = nullptr; P.hout = nullptr; P.xbo = nullptr; P.gate = nullptr; P.ng = nullptr; P.sc = nullptr; P.sspo = nullptr;
    P.o1 = nullptr; P.o2 = nullptr; P.cw = nullptr; P.cb = nullptr; P.br = nullptr; P.bi = nullptr; P.la8 = nullptr; P.h0 = nullptr;
    int sid; switch (ph) { case 2: sid = 2; break; case 3: sid = 3; break; case 4: sid = 4; break; case 6: sid = 5; break; case 8: sid = 6; break; case 9: sid = 7; break; case 10: sid = 8; break;
                           case 11: sid = 9; break; case 13: sid = 10; break; case 14: sid = 11; break; case 15: sid = 12; break; default: sid = 0; }
    switch (sid) {
    case 2: case 11: { const int j = sid == 2 ? 0 : 1, l = 2 * j, xi = sid == 2 ? 0 : 4;
        P.kind = 1; P.A = CXB(xi); P.lda = D; P.K = D; P.Bt = WSP(bf16_t, W_A1 + j * SZ_A1); P.sspi = CSSP(xi); P.bias = WSP(float, WS_BIASM) + (size_t)(l * 2 + 1) * 3072;
        P.o1 = WSP(bf16_t, CX_U) + (size_t)j * CT * D; P.o2 = WSP(bf16_t, CX_G); P.cw = INP(IX_ACW) + (size_t)j * 4 * D; P.cb = INP(IX_ACB) + (size_t)j * D; return 64; }
    case 3: case 12: { const int j = sid == 3 ? 0 : 1;
        P.kind = 2; P.A = WSP(bf16_t, CX_U) + (size_t)j * CT * D; P.lda = D; P.K = 256; P.Bt = WSP(bf16_t, W_A2 + j * SZ_A2);
        P.br = INP(IX_ABR) + (size_t)j * 2 * D; P.bi = INP(IX_ABI) + (size_t)j * 2 * D; P.la8 = WSP(float, WS_LA8) + (size_t)j * 2 * D; P.h0 = WSP(float, WS_H0) + (size_t)j * 2 * D;
        P.o1 = j == 0 ? WSP(bf16_t, CX_GS) : nullptr; P.o2 = WSP(bf16_t, CX_G); return 64; }
    case 4: P.kind = 4; P.A = WSP(bf16_t, CX_GS); P.lda = D; P.K = D; P.Bt = WSP(bf16_t, W_A3); P.hin = INP(IX_CTX); P.hout = WSP(float, CX_H); P.xbo = CXB(1); P.gate = CMOD(0, 2); P.ng = INP(IX_NFG); P.sc = CMOD(0, 4); P.sspo = CSSP(1); return 128;
    case 5: case 9: { const int l = sid == 5 ? 0 : 1, xi = sid == 5 ? 1 : 3;
        P.kind = 5; P.A = CXB(xi); P.lda = D; P.K = D; P.Bt = WSP(bf16_t, W_F1 + l * SZ_F1); P.sspi = CSSP(xi); P.bias = WSP(float, WS_BIASF) + (size_t)(l * 2 + 1) * 5632;
        P.o1 = WSP(bf16_t, CX_Y + l * 1536 * KiB); P.cw = INP(IX_FCW) + (size_t)l * 3 * DFF; P.cb = INP(IX_FCB) + (size_t)l * DFF; return 176; }
    case 6: case 10: { const int l = sid == 6 ? 0 : 1, xo = sid == 6 ? 2 : 4;
        P.kind = 4; P.A = WSP(bf16_t, CX_Y + l * 1536 * KiB); P.lda = DFF; P.K = DFF; P.Bt = WSP(bf16_t, W_F2 + l * SZ_F2); P.hin = WSP(float, CX_H); P.hout = WSP(float, CX_H); P.xbo = CXB(xo);
        P.gate = CMOD(l, 5); P.ng = INP(IX_NMG) + (size_t)(l + 1) * D; P.sc = CMOD(l + 1, 1); P.sspo = CSSP(xo); return 128; }
    case 7: P.kind = 7; P.A = CXB(2); P.lda = D; P.K = D; P.Bt = WSP(bf16_t, W_B1); P.sspi = CSSP(2); P.bias = WSP(float, WS_BIASM) + (size_t)(1 * 2 + 1) * 3072;
        P.o1 = WSP(bf16_t, CX_Q); P.cw = INP(IX_BCW); P.cb = INP(IX_BCB); return 64;
    case 8: P.kind = 4; P.A = WSP(bf16_t, CX_Q); P.lda = D; P.K = D; P.Bt = WSP(bf16_t, W_B2); P.hin = WSP(float, CX_H); P.hout = WSP(float, CX_H); P.xbo = CXB(3); P.gate = CMOD(1, 2); P.ng = INP(IX_NFG) + D; P.sc = CMOD(1, 4); P.sspo = CSSP(3); return 128;
    default: return 0;
    }
#undef CMOD
#undef CXB
#undef CSSP
}

__global__ void __launch_bounds__(512, 2) mega_fwd(Args args) {
    extern __shared__ __attribute__((aligned(16))) unsigned char lds_raw[];
    Ctx C;
    C.in = args.in; C.out = args.out; C.ws = args.ws; C.lds = (LAS unsigned char*)lds_raw;
    C.tid = threadIdx.x; C.lane = C.tid & 63; C.wave = __builtin_amdgcn_readfirstlane(C.tid >> 6); C.G = gridDim.x; C.bid = blockIdx.x;
    volatile LAS unsigned* MISC = (volatile LAS unsigned*)(C.lds + MISC_OFF);
    for (int u = C.tid; u < (LDS_BYTES - LDSCTL_OFF) / 4; u += 512) ((LAS unsigned*)(C.lds + LDSCTL_OFF))[u] = 0u;
    __syncthreads();
    XcdBarrier bar; bar.bar = (unsigned*)(C.ws + WS_CTL) + 4096; bar.x = 0; bar.st = nullptr;
#if !MK_PER_PHASE
    bar = xcd_barrier_post((unsigned*)(C.ws + WS_CTL) + 4096, MISC + 8);
#endif
    const int lo = args.ph_lo, hi = args.ph_hi;
#define REFRESH_LANE() do { C.lane = lane_id(); asm volatile("" : "+v"(C.lane)); C.tid = C.wave * 64 + C.lane; } while (0)
#define IN(k) (lo <= (k) && (k) < hi)
#ifndef MK_BAR_REPS
#define MK_BAR_REPS 1
#endif
#define SEAM(k) do { if (IN(k) && IN((k) + 1)) { for (int br_ = 0; br_ < MK_BAR_REPS; ++br_) xcd_barrier(bar); } } while (0)
    const float* mods = WSP(float, WS_MODS);
#define LMOD(l, chunk) (mods + (size_t)((l) * 2) * NMOD + (chunk) * 1024)
#define SLOTP(type, i) WSP(type, WS_SLOT + (size_t)(i) * SLOT)
#define SSPA(i) (WSP(float, WS_SSP) + (size_t)(i) * T * 16)
    int ph = 0;
    if (IN(ph)) { REFRESH_LANE(); phase_p0(C); }
    SEAM(ph); ++ph;
    if (IN(ph)) { REFRESH_LANE(); phase_p1(C); }
    SEAM(ph); ++ph;
    for (ph = 2; ph < 28; ++ph) {
        if (ph == 5 || ph == 18) continue;
        if (IN(ph)) {
            asm volatile("" : "+s"(C.wave), "+s"(C.bid), "+s"(C.G));
            { size_t zz = 0; asm volatile("" : "+s"(zz)); C.ws = args.ws + zz; C.out = args.out + zz; }
            REFRESH_LANE();
            { CtxP cp; const int nci = ctx_step(C, ph, cp); const int coff = (ph == 8 || ph == 13) ? (C.G >> 1) : 0;
              for (int it = C.bid - coff; it < nci; it += C.G) if (it >= 0) ctx_item(C, cp, it); }
            int p = ph - 2, l = 0;
            if (p >= 13) { p -= 13; l = 2; }
            int kind;
            if (p < 8) kind = p; else { l += 1; p -= 8; kind = p == 0 ? 8 : p == 1 ? 9 : p + 3; }
            const int j = l >> 1;
            if (kind == 0) {
                pg8::Gemm g{SLOTP(bf16_t, 0), WSP(bf16_t, W_A1 + j * SZ_A1), D, D, 64, 8, 0, 0}; pg8::StaticOrder S; S.init(64, 8, C.G, C.bid);
                EpiA1 E{SLOTP(bf16_t, 1), SLOTP(bf16_t, 4), WSP(float, WS_BIASM) + (size_t)(l * 2) * 3072, SSPA(2 * l)};
                pg8::gemm_phase(C.lds, g, S, E, C.wave);
            } else if (kind == 1) {
                REFRESH_LANE();
                phase_conv4(C, SLOTP(bf16_t, 1), SLOTP(bf16_t, 5), INP(IX_ACW) + (size_t)j * 4 * D, INP(IX_ACB) + (size_t)j * D);
            } else if (kind == 2) {
                int kk = 256; asm volatile("" : "+s"(kk));
                pg8::Gemm g{SLOTP(bf16_t, 5), WSP(bf16_t, W_A2 + j * SZ_A2), D, kk, 64, 16, 1, 3}; pg8::StaticOrder S; S.init(64, 16, C.G, C.bid);
                EpiA2 E{SLOTP(bf16_t, 5), SLOTP(h16, 0), INP(IX_ABR) + (size_t)j * 2 * D, INP(IX_ABI) + (size_t)j * 2 * D, WSP(float, WS_LA8) + (size_t)j * 2 * D, WSP(float, WS_AGG32), WSP(float, WS_AGGT), C.lds};
                pg8::gemm_phase<EpiA2, false>(C.lds, g, S, E, C.wave);
            } else if (kind == 3) {
                REFRESH_LANE();
                phase_scan1(C, SLOTP(h16, 0));
            } else if (kind == 4) {
                REFRESH_LANE();
                phase_scan2(C, SLOTP(h16, 0), SLOTP(bf16_t, 4), SLOTP(bf16_t, 5), WSP(float, WS_H0) + (size_t)j * 2 * D);
            } else if (kind == 5) {
                const bf16_t* bt = (l & 1) ? WSP(bf16_t, W_B2 + j * SZ_B2) : WSP(bf16_t, W_A3 + j * SZ_A3);
                pg8::Gemm g{(l & 1) ? SLOTP(bf16_t, 3) : SLOTP(bf16_t, 5), bt, D, D, 64, 4, 0, 0}; pg8::StaticOrder S; S.init(64, 4, C.G, C.bid);
                EpiRes E{WSP(bf16_t, WS_XRES), SLOTP(bf16_t, 0), LMOD(l, 2), INP(IX_NFG) + (size_t)l * D, LMOD(l, 4), SSPA(2 * l + 1)};
                pg8::gemm_phase(C.lds, g, S, E, C.wave);
            } else if (kind == 6) {
                pg8::Gemm g{SLOTP(bf16_t, 0), WSP(bf16_t, W_F1 + l * SZ_F1), D, D, 64, 22, 0, 0}; pg8::StaticOrder S; S.init(64, 22, C.G, C.bid, ph > 13);
                EpiF1 E{SLOTP(bf16_t, 1), WSP(float, WS_BIASF) + (size_t)(l * 2) * 5632, SSPA(2 * l + 1), INP(IX_FCW) + (size_t)l * 3 * DFF, INP(IX_FCB) + (size_t)l * DFF};
                pg8::gemm_phase(C.lds, g, S, E, C.wave);
            } else if (kind == 7) {
                pg8::Gemm g{SLOTP(bf16_t, 1), WSP(bf16_t, W_F2 + l * SZ_F2), DFF, DFF, 64, 4, 0, 0}; pg8::StaticOrder S; S.init(64, 4, C.G, C.bid);
                EpiRes E{WSP(bf16_t, WS_XRES), SLOTP(bf16_t, 0), LMOD(l, 5), l < 3 ? INP(IX_NMG) + (size_t)(l + 1) * D : nullptr, l < 3 ? LMOD(l + 1, 1) : nullptr, SSPA(2 * l + 2)};
                pg8::gemm_phase(C.lds, g, S, E, C.wave);
            } else if (kind == 8) {
                pg8::Gemm g{SLOTP(bf16_t, 0), WSP(bf16_t, W_B1 + j * SZ_B1), D, D, 64, 12, 0, 0}; pg8::StaticOrder S; S.init(64, 12, C.G, C.bid);
                EpiB1 E{SLOTP(bf16_t, 1), SLOTP(bf16_t, 2), WSP(float, WS_BIASM) + (size_t)(l * 2) * 3072, SSPA(2 * l)};
                pg8::gemm_phase(C.lds, g, S, E, C.wave);
            } else {
                REFRESH_LANE();
                phase_vconv(C, SLOTP(bf16_t, 1), SLOTP(bf16_t, 2), SLOTP(bf16_t, 3), INP(IX_BCW) + (size_t)j * 3 * D, INP(IX_BCB) + (size_t)j * D);
            }
        }
        SEAM(ph);
    }
    if (IN(ph)) { REFRESH_LANE(); phase_final(C, SSPA(8)); }
}
constexpr int N_PHASES = 29;

extern "C" void kernel_launch(void* const* d_in, const int* in_sizes, int n_in, void* d_out, int out_size, void* d_ws, size_t ws_size, hipStream_t stream) {
    static int grid = 0;
    if (grid == 0) {
        if (n_in != N_IN || in_sizes[0] != T * D || out_size != T * D || ws_size < WS_END) { fprintf(stderr, "kernel_launch: unexpected problem shape (n_in %d, in0 %d, out %d, ws %zu < %zu)\n", n_in, n_in > 0 ? in_sizes[0] : -1, out_size, ws_size, (size_t)WS_END); grid = -1; return; }
        int dev = 0, cus = 0, per_cu = 0;
        if (hipGetDevice(&dev) != hipSuccess || hipDeviceGetAttribute(&cus, hipDeviceAttributeMultiprocessorCount, dev) != hipSuccess) { grid = -1; return; }
        if (hipFuncSetAttribute((const void*)mega_fwd, hipFuncAttributeMaxDynamicSharedMemorySize, LDS_BYTES) != hipSuccess) { fprintf(stderr, "kernel_launch: hipFuncSetAttribute failed\n"); grid = -1; return; }
        if (hipOccupancyMaxActiveBlocksPerMultiprocessor(&per_cu, (const void*)mega_fwd, 512, LDS_BYTES) != hipSuccess || per_cu < 1) fprintf(stderr, "kernel_launch: occupancy query reports %d\n", per_cu);
        (void)hipGetLastError();
        grid = cus;
    }
    if (grid < 0) return;
    (void)hipMemsetAsync((char*)d_ws + WS_CTL, 0, CTL_ZERO_BYTES, stream);
    Args a{};
    for (int i = 0; i < N_IN; ++i) a.in[i] = (const float*)d_in[i];
    a.out = (float*)d_out; a.ws = (unsigned char*)d_ws;
#if MK_PER_PHASE
    for (int p = 0; p < N_PHASES; ++p) {
        const bool dup = (MK_DUP_MASK >> p) & 1u;
        bool inplace = false;
        if (p >= 2 && p < 28) { int q = p - 2, l = 0; if (q >= 13) { q -= 13; l = 2; } int kind; if (q < 8) kind = q; else { l += 1; q -= 8; kind = q == 0 ? 8 : q == 1 ? 9 : q + 3; } inplace = kind == 5 || kind == 7; }
        const bool cin = (p == 6 || p == 8 || p == 10);
        char* xbk = (char*)d_ws + WS_SLOT + 4 * SLOT; char* cbk = (char*)d_ws + WS_END;
        if (dup && inplace) (void)hipMemcpyAsync(xbk, (char*)d_ws + WS_XRES, (size_t)T * D * 2, hipMemcpyDeviceToDevice, stream);
        if (dup && cin) (void)hipMemcpyAsync(cbk, (char*)d_ws + CX_H, (size_t)CT * D * 4, hipMemcpyDeviceToDevice, stream);
        a.ph_lo = p; a.ph_hi = p + 1; hipLaunchKernelGGL(mega_fwd, dim3(grid), dim3(512), LDS_BYTES, stream, a);
        if (dup) {
            if (inplace) (void)hipMemcpyAsync((char*)d_ws + WS_XRES, xbk, (size_t)T * D * 2, hipMemcpyDeviceToDevice, stream);
            if (cin) (void)hipMemcpyAsync((char*)d_ws + CX_H, cbk, (size_t)CT * D * 4, hipMemcpyDeviceToDevice, stream);
            hipLaunchKernelGGL(mega_fwd, dim3(grid), dim3(512), LDS_BYTES, stream, a);
        }
    }
#else
    a.ph_lo = 0; a.ph_hi = N_PHASES;
    hipLaunchKernelGGL(mega_fwd, dim3(grid), dim3(512), LDS_BYTES, stream, a);
#endif
}
```

```cpp
#include <hip/hip_runtime.h>
#include <cstdio>
#include <cstdint>

#ifndef MK_DUP_MASK
#define MK_DUP_MASK 0u
#endif
#ifndef MK_PER_PHASE
#define MK_PER_PHASE 0
#endif

#define LAS __attribute__((address_space(3)))
typedef unsigned short bf16_t;
typedef short bf16x8 __attribute__((ext_vector_type(8)));
typedef float f32x4 __attribute__((ext_vector_type(4)));
typedef float f32x2 __attribute__((ext_vector_type(2)));
typedef unsigned u32x4 __attribute__((ext_vector_type(4)));
typedef unsigned u32x2 __attribute__((ext_vector_type(2)));
typedef _Float16 h16;
typedef _Float16 h16x2 __attribute__((ext_vector_type(2)));
typedef _Float16 h16x4 __attribute__((ext_vector_type(4)));

constexpr int T = 16384, D = 1024, CT = 256, DFF = 2816, NMOD = 6144;
constexpr float EPS = 1e-6f;

enum { IX_X = 0, IX_C, IX_CTX, IX_CCTX, IX_ADAW, IX_ADAB, IX_NMG, IX_NFG, IX_AWX, IX_AWG, IX_ACW, IX_ACB, IX_AWR, IX_ABR, IX_AWI, IX_ABI, IX_ALAM, IX_AWO,
       IX_BWIN, IX_BCW, IX_BCB, IX_BWO, IX_FWU, IX_FCW, IX_FCB, IX_FWD, IX_FG, N_IN };

constexpr size_t MiB = 1u << 20, KiB = 1u << 10;
constexpr size_t WS_CTL = 0, CTL_ZERO_BYTES = 64 * KiB;
constexpr size_t WS_MODS = 1 * MiB;
constexpr size_t WS_BIASM = 1 * MiB + 256 * KiB;
constexpr size_t WS_BIASF = 1 * MiB + 512 * KiB;
constexpr size_t WS_LA8 = 1 * MiB + 768 * KiB;
constexpr size_t WS_H0 = WS_LA8 + 16 * KiB;
constexpr size_t WS_SSP = 2 * MiB;
constexpr size_t WS_AGGT = 11 * MiB;
constexpr size_t WS_AGG32 = 12 * MiB;
constexpr size_t WS_CTXR = 20 * MiB;
constexpr size_t CX_H = WS_CTXR;
constexpr size_t CX_XB = WS_CTXR + 1 * MiB;
constexpr size_t CX_U = WS_CTXR + 4 * MiB;
constexpr size_t CX_G = WS_CTXR + 5 * MiB;
constexpr size_t CX_GS = CX_G + 512 * KiB;
constexpr size_t CX_Q = WS_CTXR + 6 * MiB;
constexpr size_t CX_Y = CX_Q + 512 * KiB;
constexpr size_t CX_SSP = WS_CTXR + 10 * MiB;
constexpr size_t WS_W = 32 * MiB;
constexpr size_t W_A1 = WS_W, W_A2 = WS_W + 8 * MiB, W_A3 = WS_W + 12 * MiB, W_B1 = WS_W + 16 * MiB, W_B2 = WS_W + 28 * MiB, W_F1 = WS_W + 32 * MiB, W_F2 = WS_W + 76 * MiB;
constexpr size_t SZ_A1 = 4 * MiB, SZ_A2 = 2 * MiB, SZ_A3 = 2 * MiB, SZ_B1 = 6 * MiB, SZ_B2 = 2 * MiB, SZ_F1 = 11 * MiB, SZ_F2 = 5632 * KiB;
constexpr size_t WS_SLOT = 130 * MiB, SLOT = 32 * MiB;
constexpr size_t WS_XRES = WS_SLOT + 6 * SLOT;
constexpr size_t WS_END = WS_XRES + SLOT;
static_assert(W_F2 + 4 * SZ_F2 <= WS_SLOT, "weights fit");

constexpr int RING_BYTES = 131072, LDSCTL_OFF = RING_BYTES, MISC_OFF = LDSCTL_OFF + 320, LDS_BYTES = 163840;
constexpr int F1_SLOTS = 6, F1_RS_OFF = RING_BYTES + 4096, F1_CV_OFF = F1_RS_OFF + F1_SLOTS * 1024, F1_CV_BYTES = 3072;
static_assert(F1_CV_OFF + F1_SLOTS * F1_CV_BYTES <= LDS_BYTES, "LDS map (F1 tables)");
constexpr int A2_BLK_OFF = RING_BYTES + 4096, A2_BLK_BYTES = 1280, A2_CNT_OFF = RING_BYTES + 512;
static_assert(A2_BLK_OFF + 8 * A2_BLK_BYTES <= LDS_BYTES && MISC_OFF + 128 <= A2_CNT_OFF && A2_CNT_OFF + 16 <= RING_BYTES + 1024, "LDS map");

__device__ __forceinline__ float bf2f(unsigned b) { return __uint_as_float(b << 16); }
__device__ __forceinline__ unsigned cvt_pk_bf16(float lo, float hi) { unsigned r; asm volatile("v_cvt_pk_bf16_f32 %0, %1, %2" : "=v"(r) : "v"(lo), "v"(hi)); return r; }
__device__ __forceinline__ float sigm(float x) { return __builtin_amdgcn_rcpf(1.f + __builtin_amdgcn_exp2f(-1.4426950409f * x)); }
__device__ __forceinline__ float silu_f(float x) { return x * sigm(x); }
__device__ __forceinline__ float gelu_t(float x) { const float u = x + 0.044715f * x * x * x; return x * __builtin_amdgcn_rcpf(1.f + __builtin_amdgcn_exp2f(-2.3022081986f * u)); }
__device__ __forceinline__ float one_minus_exp(float x) {
    float p = 1.f / 720.f; p = p * x + 1.f / 120.f; p = p * x + 1.f / 24.f; p = p * x + 1.f / 6.f; p = p * x + 0.5f; p = p * x + 1.f;
    const float small = -(p * x);
    const float big = 1.f - __builtin_amdgcn_exp2f(1.4426950409f * x);
    return x < -0.25f ? big : small;
}
__device__ __forceinline__ int lane_id() { return (int)__builtin_amdgcn_mbcnt_hi(~0u, __builtin_amdgcn_mbcnt_lo(~0u, 0u)); }
#define SWZ_X4 0x101F
#define SWZ_X8 0x201F
#define SWZ_X16 0x401F
__device__ __forceinline__ float add_x16(float v) { return v + __builtin_bit_cast(float, __builtin_amdgcn_ds_swizzle(__builtin_bit_cast(int, v), SWZ_X16)); }
__device__ __forceinline__ float add_x32(float v, int xl) { return v + __builtin_bit_cast(float, __builtin_amdgcn_ds_bpermute(xl, __builtin_bit_cast(int, v))); }
#define XL32(fr, fq) ((((fr) + 16 * (fq)) ^ 32) << 2)
__device__ __forceinline__ float wave_sum(float v) {
    v += __builtin_bit_cast(float, __builtin_amdgcn_update_dpp(0, __builtin_bit_cast(int, v), 0xB1, 0xf, 0xf, true));
    v += __builtin_bit_cast(float, __builtin_amdgcn_update_dpp(0, __builtin_bit_cast(int, v), 0x4E, 0xf, 0xf, true));
    v += __builtin_bit_cast(float, __builtin_amdgcn_ds_swizzle(__builtin_bit_cast(int, v), SWZ_X4));
    v += __builtin_bit_cast(float, __builtin_amdgcn_ds_swizzle(__builtin_bit_cast(int, v), SWZ_X8));
    v = add_x16(v);
    return __builtin_bit_cast(float, __builtin_amdgcn_readlane(__builtin_bit_cast(int, v), 0)) + __builtin_bit_cast(float, __builtin_amdgcn_readlane(__builtin_bit_cast(int, v), 32));
}
__device__ __forceinline__ float dpp_ror1(float x) { return __builtin_bit_cast(float, __builtin_amdgcn_update_dpp(0, __builtin_bit_cast(int, x), 0x121, 0xf, 0xf, true)); }
__device__ __forceinline__ float dpp_shr1z(float x) { return __builtin_bit_cast(float, __builtin_amdgcn_update_dpp(0, __builtin_bit_cast(int, x), 0x111, 0xf, 0xf, true)); }
__device__ __forceinline__ float dpp_shl1z(float x) { return __builtin_bit_cast(float, __builtin_amdgcn_update_dpp(0, __builtin_bit_cast(int, x), 0x101, 0xf, 0xf, true)); }
__device__ __forceinline__ float dpp_ror15(float x) { return __builtin_bit_cast(float, __builtin_amdgcn_update_dpp(0, __builtin_bit_cast(int, x), 0x12F, 0xf, 0xf, true)); }
__device__ __forceinline__ unsigned pk_h2(float a, float b) { h16x2 v = {(h16)a, (h16)b}; return __builtin_bit_cast(unsigned, v); }
__device__ __forceinline__ f32x4 h4_to_f4(u32x2 w) { h16x4 h = __builtin_bit_cast(h16x4, w); return (f32x4){(float)h[0], (float)h[1], (float)h[2], (float)h[3]}; }
__device__ __forceinline__ f32x4 bf4_to_f4(u32x2 w) { return (f32x4){bf2f(w.x & 0xffffu), bf2f(w.x >> 16), bf2f(w.y & 0xffffu), bf2f(w.y >> 16)}; }

namespace pg8 {
constexpr int BM = 256, BK = 64, HALF = 128, HTB = HALF * BK * 2, STAGE_BYTES = 8 * HTB, NXCD = 8, WGM = 4;
__host__ __device__ __forceinline__ int lds_byte(int r, int c) { const int st = (r >> 4) * 2 + (c >> 5), rr = r & 15, cc = c & 31, ob = rr * 64 + cc * 2; return st * 1024 + (ob ^ (((ob >> 9) & 1) << 5)); }
__host__ __device__ __forceinline__ void stage_rc(int b, int& R, int& C) { const int st = b / 1024, sb = b % 1024, swz = sb ^ (((sb >> 9) & 1) << 5); R = (st >> 1) * 16 + swz / 64; C = (st & 1) * 32 + (swz % 64) / 2; }
__host__ __device__ __forceinline__ int perm32(int rho) { const int n = rho >> 4, i = rho & 15; return 8 * (i >> 2) + 4 * n + (i & 3); }
struct Unit { int pm, pn, hrow, nai, idx; };
struct Gemm { const bf16_t* A; const bf16_t* Bt; int lda, K, nM, nN, acs, acm; };
struct StaticOrder {
    int nM, nN, nwg, G, c, base, cap; bool halves;
    __device__ void init(int nM_, int nN_, int G_, int c_, bool halves_ = false) { nM = nM_; nN = nN_; nwg = nM * nN; G = G_; c = c_; halves = halves_; base = 0; cap = 1 << 30; }
    __device__ bool next(int i, Unit& u) const {
        if (i >= cap) return false;
        u.idx = i; i += base;
        const int fullr = nwg / G, rem = nwg - fullr * G; const bool split = halves && (rem * 2 == G);
        long L; u.hrow = 0; u.nai = 2;
        if (i < fullr) L = (long)i * G + c;
        else if (i == fullr && split) { L = (long)fullr * G + (c >> 1); u.hrow = (c & 1) * 128; u.nai = 1; }
        else if (i == fullr && c < rem) L = (long)i * G + c;
        else return false;
        int wgid = (int)L; { const int q = nwg / NXCD, r = nwg % NXCD, xcd = wgid % NXCD, off = wgid / NXCD; wgid = (xcd < r ? xcd * (q + 1) : r * (q + 1) + (xcd - r) * q) + off; }
        const int nig = WGM * nN, gid = wgid / nig, fm = gid * WGM, gsz = (nM - fm) < WGM ? (nM - fm) : WGM;
        u.pm = fm + ((wgid % nig) % gsz); u.pn = (wgid % nig) / gsz; return true;
    }
};

template <class Epi, bool PERM = true, bool ROWP = false>
__device__ __forceinline__ void gemm_phase(LAS unsigned char* lds, const Gemm g, const StaticOrder& S, const Epi& E, int wid_) {
    int lane_ = lane_id(); asm volatile("" : "+v"(lane_));
    const int wid = wid_, lane = lane_, tid = wid * 64 + lane, wr = wid >> 2, wc = wid & 3, fr = lane & 15, fq = lane >> 4;
    const int K = g.K, nt = K / BK;
    unsigned voffA[2], voffB[2];
#pragma unroll
    for (int i = 0; i < 2; ++i) { int R, C; stage_rc(tid * 16 + i * 8192, R, C); const int Rb = PERM ? (R & ~31) + perm32(R & 31) : R;
        const int Ra = ROWP ? (R & 64) + 4 * (R & 15) + ((R >> 4) & 3) : R;
        voffA[i] = (unsigned)(Ra * g.lda + C) * 2u; voffB[i] = (unsigned)(Rb * K + C) * 2u; }
    const unsigned kstep = (unsigned)(BK * 2);
    const unsigned hstepA = (unsigned)HALF * (unsigned)g.lda * 2u, tstepA = 2u * hstepA;
    const unsigned hstepB = (unsigned)HALF * (unsigned)K * 2u, tstepB = 2u * hstepB;
    const unsigned ldsw = (unsigned)wid * 1024u;
    const int aoff = lds_byte(wr * 64 + fr, fq * 8), boff = lds_byte(wc * 32 + fr, fq * 8);
    const __amdgpu_buffer_rsrc_t rsA = __builtin_amdgcn_make_buffer_rsrc((void*)g.A, 0, 0x7fffffff, 0x00020000);
    const __amdgpu_buffer_rsrc_t rsB = __builtin_amdgcn_make_buffer_rsrc((void*)g.Bt, 0, 0x7fffffff, 0x00020000);
#define PG8_UA(u) ((unsigned)(u).pm * tstepA + ((u).hrow ? hstepA : 0u) + (unsigned)((((u).pn >> g.acs) & g.acm) * 512))
#define PG8_UB(u) ((unsigned)(u).pn * tstepB)
#define PG8_SA(b, h) (((b) * 2 + (h)) * HTB)
#define PG8_SB(b, h) ((4 + (b) * 2 + (h)) * HTB)
#define PG8_STAGE(bufoff, rs, soff, voff) do { _Pragma("unroll") for (int _i = 0; _i < 2; ++_i) \
        __builtin_amdgcn_raw_ptr_buffer_load_lds(rs, (LAS void*)(lds + (bufoff) + ldsw + _i * 8192), 16, (int)(voff)[_i], (int)(soff), 0, 0); } while (0)
#define PG8_LDA(dst, b, h) do { _Pragma("unroll") for (int m = 0; m < 4; ++m) _Pragma("unroll") for (int k = 0; k < 2; ++k) dst[m][k] = *(const LAS bf16x8*)(lds + PG8_SA(b, h) + aoff + m * 2048 + k * 1024); } while (0)
#define PG8_LDB(dst, b, h) do { _Pragma("unroll") for (int n = 0; n < 2; ++n) _Pragma("unroll") for (int k = 0; k < 2; ++k) dst[n][k] = *(const LAS bf16x8*)(lds + PG8_SB(b, h) + boff + n * 2048 + k * 1024); } while (0)
#define PG8_MMA(ai, bj, At, Bt) do { __builtin_amdgcn_s_setprio(1); _Pragma("unroll") for (int m = 0; m < 4; ++m) _Pragma("unroll") for (int n = 0; n < 2; ++n) _Pragma("unroll") for (int k = 0; k < 2; ++k) \
        acc[ai][bj][m][n] = __builtin_amdgcn_mfma_f32_16x16x32_bf16(Bt[n][k], At[m][k], acc[ai][bj][m][n], 0, 0, 0); __builtin_amdgcn_s_setprio(0); } while (0)
#define PG8_WAIT_V(n) asm volatile("s_waitcnt vmcnt(" #n ")" ::: "memory")
#define PG8_WAIT_L(n) asm volatile("s_waitcnt lgkmcnt(" #n ")" ::: "memory")
#define PG8_BAR __builtin_amdgcn_s_barrier()
#define PG8_SCHED __builtin_amdgcn_sched_barrier(0)
    Unit cur, nxt; int ui = 0;
    if (!S.next(0, cur)) return;
    f32x4 acc[2][2][4][2];
#pragma unroll
    for (int a = 0; a < 2; ++a)
#pragma unroll
        for (int b = 0; b < 2; ++b)
#pragma unroll
            for (int m = 0; m < 4; ++m)
#pragma unroll
                for (int n = 0; n < 2; ++n) acc[a][b][m][n] = (f32x4){0.f, 0.f, 0.f, 0.f};
    bf16x8 At[4][2], B0[2][2], B1[2][2];
    unsigned cA = PG8_UA(cur), cB = PG8_UB(cur);
    PG8_STAGE(PG8_SB(0, 0), rsB, cB, voffB); PG8_STAGE(PG8_SB(0, 1), rsB, cB + hstepB, voffB); PG8_STAGE(PG8_SA(0, 0), rsA, cA, voffA); PG8_STAGE(PG8_SA(0, 1), rsA, cA + hstepA, voffA);
    if (wr == 1) PG8_BAR;
    PG8_WAIT_V(2); PG8_BAR;
    PG8_STAGE(PG8_SB(1, 0), rsB, cB + kstep, voffB); PG8_STAGE(PG8_SA(1, 0), rsA, cA + kstep, voffA); PG8_STAGE(PG8_SB(1, 1), rsB, cB + hstepB + kstep, voffB);
    PG8_WAIT_V(6); PG8_BAR;
    for (;;) {
        const bool has_next = S.next(ui + 1, nxt);
        const unsigned nA = has_next ? PG8_UA(nxt) : cA, nB = has_next ? PG8_UB(nxt) : cB;
        for (int t = 0; t < nt; t += 2) {
            const bool last = (t == nt - 2);
            const unsigned a1 = cA + (unsigned)(t + 1) * kstep;
            const unsigned a2 = last ? nA : cA + (unsigned)(t + 2) * kstep, b2 = last ? nB : cB + (unsigned)(t + 2) * kstep;
            const unsigned a3 = a2 + kstep, b3 = b2 + kstep;
            PG8_LDB(B0, 0, 0); PG8_LDB(B1, 0, 1); PG8_SCHED; PG8_LDA(At, 0, 0); PG8_STAGE(PG8_SA(1, 1), rsA, a1 + hstepA, voffA);
            PG8_WAIT_V(8); PG8_WAIT_L(0); PG8_BAR; PG8_MMA(0, 0, At, B0); PG8_MMA(0, 1, At, B1); PG8_BAR; PG8_SCHED;
            PG8_LDA(At, 0, 1); PG8_STAGE(PG8_SB(0, 0), rsB, b2, voffB); PG8_STAGE(PG8_SB(0, 1), rsB, b2 + hstepB, voffB); PG8_STAGE(PG8_SA(0, 0), rsA, a2, voffA);
            PG8_WAIT_V(8); PG8_WAIT_L(0); PG8_BAR; if (cur.nai == 2) { PG8_MMA(1, 0, At, B0); PG8_MMA(1, 1, At, B1); } PG8_BAR; PG8_SCHED;
            PG8_LDB(B0, 1, 0); PG8_LDB(B1, 1, 1); PG8_SCHED; PG8_LDA(At, 1, 0); PG8_STAGE(PG8_SA(0, 1), rsA, a2 + hstepA, voffA);
            PG8_WAIT_V(8); PG8_WAIT_L(0); PG8_BAR; PG8_MMA(0, 0, At, B0); PG8_MMA(0, 1, At, B1); PG8_BAR; PG8_SCHED;
            PG8_LDA(At, 1, 1); PG8_STAGE(PG8_SB(1, 0), rsB, b3, voffB); PG8_STAGE(PG8_SB(1, 1), rsB, b3 + hstepB, voffB); PG8_STAGE(PG8_SA(1, 0), rsA, a3, voffA);
            PG8_WAIT_V(8); PG8_WAIT_L(0); PG8_BAR; if (cur.nai == 2) { PG8_MMA(1, 0, At, B0); PG8_MMA(1, 1, At, B1); } PG8_BAR; PG8_SCHED;
        }
        if (wr == 0) PG8_BAR;
        { int lnE = lane_id(); asm volatile("" : "+v"(lnE)); int frE = lnE & 15, fqE = lnE >> 4, wrE = wr, wcE = wc; asm volatile("" : "+s"(wrE), "+s"(wcE));
          E(acc, cur, wrE, wcE, frE, fqE); }
        if (!has_next) break;
#pragma unroll
        for (int a = 0; a < 2; ++a)
#pragma unroll
            for (int b = 0; b < 2; ++b)
#pragma unroll
                for (int m = 0; m < 4; ++m)
#pragma unroll
                    for (int n = 0; n < 2; ++n) acc[a][b][m][n] = (f32x4){0.f, 0.f, 0.f, 0.f};
        cur = nxt; cA = nA; cB = nB; ++ui;
        if (wr == 1) PG8_BAR;
    }
    PG8_WAIT_V(0);
    PG8_BAR;
#undef PG8_UA
#undef PG8_UB
#undef PG8_SA
#undef PG8_SB
#undef PG8_STAGE
#undef PG8_LDA
#undef PG8_LDB
#undef PG8_MMA
#undef PG8_WAIT_V
#undef PG8_WAIT_L
#undef PG8_BAR
#undef PG8_SCHED
}
}

typedef f32x4 Acc[2][2][4][2];

__device__ __forceinline__ void load_rstd(float (&rs)[2][4], const float* ssp, int row0, int fr, int fq) {
#pragma unroll
    for (int ai = 0; ai < 2; ++ai)
#pragma unroll
        for (int m = 0; m < 4; ++m) {
            const f32x4 p = *(const f32x4*)(ssp + (size_t)(row0 + ai * 128 + m * 16) * 16 + fq * 4);
            float s = (p.x + p.y) + (p.z + p.w);
            s = add_x16(s); s = add_x32(s, XL32(fr, fq));
            rs[ai][m] = __builtin_amdgcn_rsqf(s * (1.0f / D) + EPS);
        }
}

struct EpiA1 {
    bf16_t* UPRE; bf16_t* G; const float* bias; const float* ssp;
    __device__ __forceinline__ void operator()(const Acc& acc, const pg8::Unit& u, int wr, int wc, int fr, int fq) const {
        const int row0 = u.pm * 256 + wr * 64 + fr;
        float rs[2][4]; load_rstd(rs, ssp, row0, fr, fq);
        const bool isg = u.pn >= 4; bf16_t* out = isg ? G : UPRE;
        const int oc0 = (u.pn & 3) * 256 + wc * 32 + 8 * fq, bc0 = u.pn * 256 + wc * 32 + 8 * fq;
        f32x4 bv[2][2];
#pragma unroll
        for (int bj = 0; bj < 2; ++bj)
#pragma unroll
            for (int n = 0; n < 2; ++n) bv[bj][n] = *(const f32x4*)(bias + bc0 + bj * 128 + 4 * n);
#pragma unroll
        for (int ai = 0; ai < 2; ++ai)
#pragma unroll
            for (int m = 0; m < 4; ++m) { bf16_t* rowp = out + (size_t)(row0 + ai * 128 + m * 16) * D + oc0; const float r = rs[ai][m];
#pragma unroll
                for (int bj = 0; bj < 2; ++bj) { f32x4 v0 = acc[ai][bj][m][0] * r + bv[bj][0], v1 = acc[ai][bj][m][1] * r + bv[bj][1];
                    if (isg) { v0 = (f32x4){gelu_t(v0[0]), gelu_t(v0[1]), gelu_t(v0[2]), gelu_t(v0[3])}; v1 = (f32x4){gelu_t(v1[0]), gelu_t(v1[1]), gelu_t(v1[2]), gelu_t(v1[3])}; }
                    u32x4 w; w.x = cvt_pk_bf16(v0[0], v0[1]); w.y = cvt_pk_bf16(v0[2], v0[3]); w.z = cvt_pk_bf16(v1[0], v1[1]); w.w = cvt_pk_bf16(v1[2], v1[3]);
                    if (isg) __builtin_nontemporal_store(w, (u32x4*)(rowp + bj * 128)); else *(u32x4*)(rowp + bj * 128) = w; } }
    }
};

__device__ __forceinline__ void swap_rows16(float x, float& lo, float& hi) { unsigned a = __float_as_uint(x), b = a; asm volatile("v_nop\n\tv_nop\n\tv_permlane16_swap_b32 %0, %1" : "+v"(a), "+v"(b)); lo = __uint_as_float(a); hi = __uint_as_float(b); }
__device__ __forceinline__ void swap_half32(float x, float& lo, float& hi) { unsigned a = __float_as_uint(x), b = a; asm volatile("v_nop\n\tv_nop\n\tv_permlane32_swap_b32 %0, %1" : "+v"(a), "+v"(b)); lo = __uint_as_float(a); hi = __uint_as_float(b); }
struct EpiA2 {
    const bf16_t* U; h16* EB; const float* br; const float* bi; const float* la8; float* agg32; float* aggt; LAS unsigned char* lds;
    __device__ __forceinline__ void operator()(const Acc& acc, const pg8::Unit& u, int wr, int wc, int fr, int fq) const {
        const int row0 = u.pm * 256 + wr * 64 + fr, d = u.pn >> 3, q = u.pn & 7, c0 = q * 128 + wc * 32 + 4 * fq;
        h16* Ed = EB + (size_t)d * T * D * 2;
        u32x2 uw[2][4][2];
#pragma unroll
        for (int ai = 0; ai < 2; ++ai)
#pragma unroll
            for (int m = 0; m < 4; ++m)
#pragma unroll
                for (int n = 0; n < 2; ++n) uw[ai][m][n] = *(const u32x2*)(U + (size_t)(row0 + ai * 128 + m * 16) * D + c0 + 16 * n);
        f32x4 brv2[2], biv2[2], lav2[2];
#pragma unroll
        for (int n = 0; n < 2; ++n) { brv2[n] = *(const f32x4*)(br + d * D + c0 + 16 * n); biv2[n] = *(const f32x4*)(bi + d * D + c0 + 16 * n); lav2[n] = *(const f32x4*)(la8 + d * D + c0 + 16 * n); }
        const int lane = fq * 16 + fr, cl = lane & 15, qt = lane >> 4;
        LAS unsigned char* blk = lds + A2_BLK_OFF + (wr * 4 + wc) * A2_BLK_BYTES;
        const int rr = d ? 15 - fr : fr;
        LAS unsigned char* wp = blk + ((rr >> 2) * 80 + (rr & 3) * 16 + 4 * fq) * 4;
        const LAS unsigned char* rp = blk + (qt * 80 + cl) * 4;
        float SP[2][2][2], SQ[2][2][2];
#pragma unroll
        for (int ai = 0; ai < 2; ++ai) {
            float BP[2] = {1.f, 1.f}, BQ[2] = {0.f, 0.f};
#pragma unroll
            for (int m = 0; m < 4; ++m) {
#pragma unroll
                for (int n = 0; n < 2; ++n) { const size_t off = (size_t)(row0 + ai * 128 + m * 16) * D + c0 + 16 * n;
                    const f32x4 uu = bf4_to_f4(uw[ai][m][n]); const f32x4 brv = brv2[n], biv = biv2[n], lav = lav2[n];
                    unsigned w[4];
#pragma unroll
                    for (int j = 0; j < 4; ++j) { const float r = sigm(acc[ai][0][m][n][j] + brv[j]), ig = sigm(acc[ai][1][m][n][j] + biv[j]);
                        const float a = __builtin_amdgcn_exp2f(r * lav[j]), e = 1.0f - a; w[j] = pk_h2(e, __builtin_amdgcn_sqrtf(e * (1.0f + a)) * ig * uu[j]); }
                    const u32x4 wv = (u32x4){w[0], w[1], w[2], w[3]};
                    *(u32x4*)(Ed + off * 2) = wv;
                    *(LAS u32x4*)wp = wv;
                    unsigned v[4];
#pragma unroll
                    for (int k = 0; k < 4; ++k) v[k] = *(const LAS unsigned*)(rp + k * 64);
                    float P = 1.f, Q = 0.f;
#pragma unroll
                    for (int k = 0; k < 4; ++k) { const h16x2 hh = __builtin_bit_cast(h16x2, v[k]); const float a = 1.0f - (float)hh[0], b = (float)hh[1]; P *= a; Q = a * Q + b; }
                    { float p0, p1, q0, q1; swap_rows16(P, p0, p1); swap_rows16(Q, q0, q1); P = p1 * p0; Q = p1 * q0 + q1; }
                    { float p0, p1, q0, q1; swap_half32(P, p0, p1); swap_half32(Q, q0, q1); P = p1 * p0; Q = p1 * q0 + q1; }
                    if (m & 1) { const float fP = d ? P : BP[n], fQ = d ? Q : BQ[n], sP = d ? BP[n] : P, sQ = d ? BQ[n] : Q;
                        SP[ai][m >> 1][n] = sP * fP; SQ[ai][m >> 1][n] = sP * fQ + sQ; }
                    else { BP[n] = P; BQ[n] = Q; } }
            }
        }
        if (lane < 16) {
#pragma unroll
            for (int ai = 0; ai < 2; ++ai)
#pragma unroll
                for (int mm = 0; mm < 2; ++mm)
#pragma unroll
                    for (int n = 0; n < 2; ++n) { const int sc = ai * 4 + wr * 2 + mm; const f32x2 pq = (f32x2){SP[ai][mm][n], SQ[ai][mm][n]};
                        *(f32x2*)(agg32 + (((size_t)d * 512 + u.pm * 8 + sc) * D + q * 128 + wc * 32 + 16 * n + cl) * 2) = pq;
                        *(LAS f32x2*)(blk + ((((ai * 2 + mm) * 2 + n) * 16 + cl) * 8)) = pq; }
        }
        asm volatile("" ::: "memory");
        unsigned old = 0u; if (lane == 0) old = __hip_atomic_fetch_add((LAS unsigned*)(lds + A2_CNT_OFF) + wc, 1u, __ATOMIC_RELAXED, __HIP_MEMORY_SCOPE_WORKGROUP);
        old = (unsigned)__builtin_amdgcn_readfirstlane((int)old);
        asm volatile("" ::: "memory");
        if (old & 1u) { float P = 1.f, Q = 0.f; const int l32 = lane & 31;
#pragma unroll
            for (int k = 0; k < 8; ++k) { const int sc = d ? 7 - k : k;
                const f32x2 pq = *(const LAS f32x2*)(lds + A2_BLK_OFF + (((sc >> 1) & 1) * 4 + wc) * A2_BLK_BYTES + ((((sc >> 2) * 2 + (sc & 1)) * 32 + l32) * 8)); Q = pq.x * Q + pq.y; P *= pq.x; }
            if (lane < 32) *(f32x2*)(aggt + (((size_t)d * 64 + u.pm) * D + q * 128 + wc * 32 + l32) * 2) = (f32x2){P, Q}; }
    }
};

struct EpiRes {
    bf16_t* xres; bf16_t* xb; const float* gate; const float* ng; const float* sc; float* sspo;
    __device__ __forceinline__ void operator()(const Acc& acc, const pg8::Unit& u, int wr, int wc, int fr, int fq) const {
        const int row0 = u.pm * 256 + wr * 64 + fr, c0 = u.pn * 256 + wc * 32 + 8 * fq;
        f32x4 gv[2][2], gs[2][2];
#pragma unroll
        for (int bj = 0; bj < 2; ++bj)
#pragma unroll
            for (int n = 0; n < 2; ++n) { gv[bj][n] = *(const f32x4*)(gate + c0 + bj * 128 + 4 * n);
                if (ng) { const f32x4 a = *(const f32x4*)(ng + c0 + bj * 128 + 4 * n), b = *(const f32x4*)(sc + c0 + bj * 128 + 4 * n); gs[bj][n] = a * (b + 1.0f); } else gs[bj][n] = (f32x4){0.f, 0.f, 0.f, 0.f}; }
#pragma unroll
        for (int ai = 0; ai < 2; ++ai) {
            u32x4 xo[1][4][2];
#pragma unroll
            for (int m = 0; m < 4; ++m)
#pragma unroll
                for (int bj = 0; bj < 2; ++bj) xo[0][m][bj] = *(const u32x4*)(xres + (size_t)(row0 + ai * 128 + m * 16) * D + c0 + bj * 128);
#pragma unroll
            for (int m = 0; m < 4; ++m) { const int row = row0 + ai * 128 + m * 16; const size_t off = (size_t)row * D + c0; float ss = 0.f;
#pragma unroll
                for (int bj = 0; bj < 2; ++bj) { const u32x4 w0 = xo[0][m][bj];
                    const f32x4 o0 = (f32x4){bf2f(w0.x & 0xffffu), bf2f(w0.x >> 16), bf2f(w0.y & 0xffffu), bf2f(w0.y >> 16)}, o1 = (f32x4){bf2f(w0.z & 0xffffu), bf2f(w0.z >> 16), bf2f(w0.w & 0xffffu), bf2f(w0.w >> 16)};
                    const f32x4 x0 = o0 + gv[bj][0] * acc[ai][bj][m][0], x1 = o1 + gv[bj][1] * acc[ai][bj][m][1];
                    u32x4 wx; wx.x = cvt_pk_bf16(x0[0], x0[1]); wx.y = cvt_pk_bf16(x0[2], x0[3]); wx.z = cvt_pk_bf16(x1[0], x1[1]); wx.w = cvt_pk_bf16(x1[2], x1[3]);
                    *(u32x4*)(xres + off + bj * 128) = wx;
                    ss += (x0[0] * x0[0] + x0[1] * x0[1]) + (x0[2] * x0[2] + x0[3] * x0[3]) + (x1[0] * x1[0] + x1[1] * x1[1]) + (x1[2] * x1[2] + x1[3] * x1[3]);
                    if (ng) { const f32x4 y0 = x0 * gs[bj][0], y1 = x1 * gs[bj][1]; u32x4 w; w.x = cvt_pk_bf16(y0[0], y0[1]); w.y = cvt_pk_bf16(y0[2], y0[3]); w.z = cvt_pk_bf16(y1[0], y1[1]); w.w = cvt_pk_bf16(y1[2], y1[3]);
                        *(u32x4*)(xb + off + bj * 128) = w; } }
                ss = add_x16(ss); ss = add_x32(ss, XL32(fr, fq));
                if (fq == 0) sspo[(size_t)row * 16 + u.pn * 4 + wc] = ss; }
        }
    }
};

struct EpiB1 {
    bf16_t* GB; bf16_t* Z; const float* bias; const float* ssp;
    __device__ __forceinline__ void operator()(const Acc& acc, const pg8::Unit& u, int wr, int wc, int fr, int fq) const {
        const int row0 = u.pm * 256 + wr * 64 + fr;
        float rs[2][4]; load_rstd(rs, ssp, row0, fr, fq);
        const int bc0 = u.pn * 256 + wc * 32 + 8 * fq;
        f32x4 bv[2][2];
#pragma unroll
        for (int bj = 0; bj < 2; ++bj)
#pragma unroll
            for (int n = 0; n < 2; ++n) bv[bj][n] = *(const f32x4*)(bias + bc0 + bj * 128 + 4 * n);
        if (u.pn < 4) {
#pragma unroll
            for (int ai = 0; ai < 2; ++ai)
#pragma unroll
                for (int m = 0; m < 4; ++m) { bf16_t* rowp = GB + (size_t)(row0 + ai * 128 + m * 16) * D + bc0; const float r = rs[ai][m];
#pragma unroll
                    for (int bj = 0; bj < 2; ++bj) { const f32x4 v0 = acc[ai][bj][m][0] * r + bv[bj][0], v1 = acc[ai][bj][m][1] * r + bv[bj][1];
                        u32x4 w; w.x = cvt_pk_bf16(v0[0], v0[1]); w.y = cvt_pk_bf16(v0[2], v0[3]); w.z = cvt_pk_bf16(v1[0], v1[1]); w.w = cvt_pk_bf16(v1[2], v1[3]);
                        *(u32x4*)(rowp + bj * 128) = w; } }
        } else {
            const int c0 = (u.pn - 4) * 128 + wc * 32 + 8 * fq;
#pragma unroll
            for (int ai = 0; ai < 2; ++ai)
#pragma unroll
                for (int m = 0; m < 4; ++m) { const float r = rs[ai][m];
                    const f32x4 z0 = (acc[ai][0][m][0] * r + bv[0][0]) * (acc[ai][1][m][0] * r + bv[1][0]), z1 = (acc[ai][0][m][1] * r + bv[0][1]) * (acc[ai][1][m][1] * r + bv[1][1]);
                    u32x4 w; w.x = cvt_pk_bf16(z0[0], z0[1]); w.y = cvt_pk_bf16(z0[2], z0[3]); w.z = cvt_pk_bf16(z1[0], z1[1]); w.w = cvt_pk_bf16(z1[2], z1[3]);
                    *(u32x4*)(Z + (size_t)(row0 + ai * 128 + m * 16) * D + c0) = w; }
        }
    }
};

struct EpiF1 {
    bf16_t* Y; LAS const unsigned char* lds;
    __device__ __forceinline__ void operator()(const Acc& acc, const pg8::Unit& u, int wr, int wc, int fr, int fq) const {
        const int row0 = u.pm * 256 + u.hrow + wr * 64 + 4 * fr;
        const int c0 = u.pn * 128 + wc * 32 + 8 * fq;
        const LAS float* cv = (const LAS float*)(lds + F1_CV_OFF + u.idx * F1_CV_BYTES) + wc * 32 + 8 * fq;
        const LAS float* rsp = (const LAS float*)(lds + F1_RS_OFF + u.idx * 1024) + u.hrow + wr * 64 + 4 * fr;
        f32x4 bg[2], bvv[2], w0[2], w1[2], w2[2], cbv[2];
#pragma unroll
        for (int n = 0; n < 2; ++n) { bg[n] = *(const LAS f32x4*)(cv + 4 * n); bvv[n] = *(const LAS f32x4*)(cv + 128 + 4 * n);
            w0[n] = *(const LAS f32x4*)(cv + 256 + 4 * n); w1[n] = *(const LAS f32x4*)(cv + 384 + 4 * n); w2[n] = *(const LAS f32x4*)(cv + 512 + 4 * n); cbv[n] = *(const LAS f32x4*)(cv + 640 + 4 * n); }
        float rs[2][4];
#pragma unroll
        for (int ai = 0; ai < 2; ++ai)
#pragma unroll
            for (int m = 0; m < 4; ++m) rs[ai][m] = rsp[ai * 128 + m];
#pragma unroll
        for (int ai = 0; ai < 2; ++ai) {
            if (ai >= u.nai) break;
            unsigned pk0[4][2];
#pragma unroll
            for (int n = 0; n < 2; ++n) {
                f32x4 gq[4];
#pragma unroll
                for (int m = 0; m < 4; ++m) gq[m] = acc[ai][0][m][n] * rs[ai][m] + bg[n];
                f32x4 lfe, rte;
#pragma unroll
                for (int j = 0; j < 4; ++j) { lfe[j] = dpp_shr1z(gq[3][j]); rte[j] = dpp_shl1z(gq[0][j]); }
#pragma unroll
                for (int m = 0; m < 4; ++m) {
                    const f32x4 lf = m == 0 ? lfe : gq[m > 0 ? m - 1 : 0], rt = m == 3 ? rte : gq[m < 3 ? m + 1 : 3];
                    const f32x4 gc = cbv[n] + w0[n] * lf + w1[n] * gq[m] + w2[n] * rt;
                    const f32x4 vv = acc[ai][1][m][n] * rs[ai][m] + bvv[n];
                    const f32x4 y = (f32x4){silu_f(gc[0]) * vv[0], silu_f(gc[1]) * vv[1], silu_f(gc[2]) * vv[2], silu_f(gc[3]) * vv[3]};
                    const unsigned p0 = cvt_pk_bf16(y[0], y[1]), p1 = cvt_pk_bf16(y[2], y[3]);
                    if (n == 0) { pk0[m][0] = p0; pk0[m][1] = p1; }
                    else *(u32x4*)(Y + (size_t)(row0 + ai * 128 + m) * DFF + c0) = (u32x4){pk0[m][0], pk0[m][1], p0, p1}; }
            }
        }
    }
};

#define XB_TMO      128
#define XB_XCNT(j)  (256  + 64 * (j))
#define XB_XSUB(j)  (1280 + 64 * (j))
#define XB_XGEN(j)  (2304 + 64 * (j))
#define XB_TOP      3328
#define XB_TOPGEN   3392
#define XCD_BAR_WORDS 3456
#define XB_SPIN_CAP (1u << 18)
__device__ __forceinline__ unsigned xb_ld(unsigned* p)              { return __hip_atomic_load(p, __ATOMIC_RELAXED, __HIP_MEMORY_SCOPE_AGENT); }
__device__ __forceinline__ unsigned xb_add(unsigned* p, unsigned v) { return __hip_atomic_fetch_add(p, v, __ATOMIC_RELAXED, __HIP_MEMORY_SCOPE_AGENT); }
__device__ __forceinline__ unsigned xb_xcc_id() { return (unsigned)__builtin_amdgcn_s_getreg((3 << 11) | 20) & 0xFu; }
#define XB_SPIN(cond, bar) do { unsigned _sp = 0; while (cond) { __builtin_amdgcn_s_sleep(1); \
    if ((++_sp & 255u) == 0u) { if (xb_ld(&(bar)[XB_TMO])) break; if (_sp > XB_SPIN_CAP) { atomicAdd(&(bar)[XB_TMO], 1u); break; } } } } while (0)
struct XcdBarrier { unsigned* bar; unsigned x; volatile LAS unsigned* st; };
__device__ __forceinline__ XcdBarrier xcd_barrier_post(unsigned* bar, volatile LAS unsigned* st) {
    XcdBarrier b; b.bar = bar; b.x = xb_xcc_id(); b.st = st;
    if (threadIdx.x == 0) (void)xb_add(&bar[XB_XCNT(b.x)], 1u);
    return b;
}
__device__ __forceinline__ void xcd_barrier_complete(unsigned* bar, unsigned x, unsigned& nloc, unsigned& nx) {
    const unsigned G = gridDim.x * gridDim.y * gridDim.z;
    unsigned sum, cnt, mine, sp = 0u;
    for (;;) {
        sum = 0u; cnt = 0u; mine = 0u;
#pragma unroll
        for (unsigned j = 0; j < 16; ++j) { const unsigned c = xb_ld(&bar[XB_XCNT(j)]); sum += c; cnt += (c > 0u) ? 1u : 0u; mine = (j == x) ? c : mine; }
        if (sum == G) break;
        __builtin_amdgcn_s_sleep(1);
        if ((++sp & 255u) == 0u) { if (xb_ld(&bar[XB_TMO])) break; if (sp > XB_SPIN_CAP) { atomicAdd(&bar[XB_TMO], 1u); break; } }
    }
    nloc = mine > 0u ? mine : 1u; nx = cnt > 0u ? cnt : 1u;
}
__device__ __forceinline__ void xcd_barrier(const XcdBarrier& b) {
    asm volatile("s_waitcnt vmcnt(0)" ::: "memory");
    __syncthreads();
    if (threadIdx.x == 0) {
        unsigned* bar = b.bar;
        __builtin_amdgcn_s_waitcnt(0);
        unsigned nloc = b.st[0], nx = b.st[1];
        if (nloc == 0u) { xcd_barrier_complete(bar, b.x, nloc, nx); b.st[0] = nloc; b.st[1] = nx; }
        const unsigned old = xb_add(&bar[XB_XSUB(b.x)], 1u);
        const unsigned gen = old / nloc;
        asm volatile("buffer_inv sc1" ::: "memory");
        if (old + 1u == (gen + 1u) * nloc) {
            __builtin_amdgcn_fence(__ATOMIC_RELEASE, "agent");
            asm volatile("s_waitcnt vmcnt(0)" ::: "memory");
            const unsigned og = xb_add(&bar[XB_TOP], 1u);
            const unsigned tg = og / nx;
            if (og + 1u == (tg + 1u) * nx) {
#pragma unroll
                for (unsigned j = 0; j < 16; ++j) (void)xb_add(&bar[XB_XGEN(j)], 1u);
            } else XB_SPIN(xb_ld(&bar[XB_XGEN(b.x)]) == gen, bar);
        } else {
            XB_SPIN(xb_ld(&bar[XB_XGEN(b.x)]) == gen, bar);
        }
        asm volatile("s_waitcnt vmcnt(0)" ::: "memory");
    }
    __syncthreads();
}

struct Args { const float* in[N_IN]; float* out; unsigned char* ws; int ph_lo, ph_hi; };
struct Ctx {
    const float* const* in; float* out; unsigned char* ws; LAS unsigned char* lds;
    int tid, lane, wave, G, bid;
};
#define WSP(type, off) ((type*)(C.ws + (off)))
#define INP(i) (C.in[i])
#define LDS_WAIT() asm volatile("s_waitcnt lgkmcnt(0)" ::: "memory")

__device__ __forceinline__ void p0_adaln(const Ctx& C, int item) {
    LAS float* sv = (LAS float*)C.lds;
    LAS float* red = (LAS float*)(C.lds + 8192);
    const int l = item / 48, cbk = item % 48;
    for (int i = C.tid; i < 2048; i += 512) { const float v = i < 1024 ? INP(IX_C)[i] : INP(IX_CCTX)[i - 1024]; sv[i] = silu_f(v); }
    __syncthreads();
    const float* W = INP(IX_ADAW) + (size_t)l * D * NMOD + cbk * 128 + 2 * C.lane;
    const int k0 = C.wave * 128;
    f32x2 a0 = {0.f, 0.f}, a1 = {0.f, 0.f};
#pragma unroll 16
    for (int k = 0; k < 128; ++k) { const f32x2 w = __builtin_nontemporal_load((const f32x2*)(W + (size_t)(k0 + k) * NMOD)); const float s0 = sv[k0 + k], s1 = sv[1024 + k0 + k]; a0 += w * s0; a1 += w * s1; }
    red[(C.wave * 2 + 0) * 128 + 2 * C.lane] = a0.x; red[(C.wave * 2 + 0) * 128 + 2 * C.lane + 1] = a0.y;
    red[(C.wave * 2 + 1) * 128 + 2 * C.lane] = a1.x; red[(C.wave * 2 + 1) * 128 + 2 * C.lane + 1] = a1.y;
    __syncthreads();
    if (C.tid < 256) { const int s = C.tid >> 7, c = C.tid & 127; float v = INP(IX_ADAB)[l * NMOD + cbk * 128 + c];
#pragma unroll
        for (int w = 0; w < 8; ++w) v += red[(w * 2 + s) * 128 + c];
        WSP(float, WS_MODS)[(size_t)(l * 2 + s) * NMOD + cbk * 128 + c] = v; }
    __syncthreads();
}
struct WBlk { const float* src; int ld, c0, K; bf16_t* dst; };
__device__ __forceinline__ WBlk get_wblk(const Ctx& C, int cls, int vb) {
    WBlk w;
    if (cls == 0) {
        w.K = 1024;
        if (vb < 48) { const int j = vb / 24, r = vb % 24;
            if (r < 16) { w.src = (r < 8 ? INP(IX_AWX) : INP(IX_AWG)) + (size_t)j * D * D; w.ld = D; w.c0 = (r & 7) * 128; w.dst = WSP(bf16_t, W_A1 + j * SZ_A1) + (size_t)r * 128 * 1024; }
            else { const int rr = r - 16; w.src = INP(IX_AWO) + (size_t)j * D * D; w.ld = D; w.c0 = rr * 128; w.dst = WSP(bf16_t, W_A3 + j * SZ_A3) + (size_t)rr * 128 * 1024; }
        } else if (vb < 112) { const int bb = vb - 48, j = bb / 32, r = bb % 32;
            if (r < 24) { int c0; if (r < 8) c0 = r * 128; else { const int rr = r - 8; c0 = 1024 + (rr & 1) * 1024 + (rr >> 1) * 128; }
                w.src = INP(IX_BWIN) + (size_t)j * D * 3072; w.ld = 3072; w.c0 = c0; w.dst = WSP(bf16_t, W_B1 + j * SZ_B1) + (size_t)r * 128 * 1024; }
            else { const int rr = r - 24; w.src = INP(IX_BWO) + (size_t)j * D * D; w.ld = D; w.c0 = rr * 128; w.dst = WSP(bf16_t, W_B2 + j * SZ_B2) + (size_t)rr * 128 * 1024; }
        } else { const int bb = vb - 112, l = bb / 44, r = bb % 44;
            w.src = INP(IX_FWU) + (size_t)l * D * 2 * DFF; w.ld = 2 * DFF; w.c0 = (r & 1) * DFF + (r >> 1) * 128; w.dst = WSP(bf16_t, W_F1 + l * SZ_F1) + (size_t)r * 128 * 1024; }
    } else if (cls == 1) {
        const int j = vb / 32, rr = vb % 32, pn = rr >> 1, mem = rr & 1, d = pn >> 3, q = pn & 7, h = q >> 1, half = q & 1;
        w.K = 256; w.src = (mem ? INP(IX_AWI) : INP(IX_AWR)) + (size_t)(((j * 2 + d) * 4 + h)) * 65536; w.ld = 256; w.c0 = half * 128;
        w.dst = WSP(bf16_t, W_A2 + j * SZ_A2) + (size_t)(pn * 256 + mem * 128) * 256;
    } else {
        const int l = vb / 8, rr = vb % 8;
        w.K = DFF; w.src = INP(IX_FWD) + (size_t)l * DFF * D; w.ld = D; w.c0 = rr * 128; w.dst = WSP(bf16_t, W_F2 + l * SZ_F2) + (size_t)rr * 128 * DFF;
    }
    return w;
}
__device__ __forceinline__ void p0_transpose4(const WBlk& w, int rg, int kc, LAS float* scr, int lane) {
    const int n0 = 32 * rg, r8 = lane >> 3, c4 = lane & 7;
    f32x4 v[4][8];
#pragma unroll
    for (int t = 0; t < 4; ++t)
#pragma unroll
        for (int i = 0; i < 8; ++i) v[t][i] = __builtin_nontemporal_load((const f32x4*)(w.src + (size_t)(64 * (4 * kc + t) + 8 * i + r8) * w.ld + w.c0 + n0 + 4 * c4));
#pragma unroll
    for (int t = 0; t < 4; ++t) { const int k0 = 64 * (4 * kc + t);
#pragma unroll
        for (int i = 0; i < 8; ++i) { LAS float* d = scr + (8 * i + r8) * 33 + 4 * c4; d[0] = v[t][i].x; d[1] = v[t][i].y; d[2] = v[t][i].z; d[3] = v[t][i].w; }
        LDS_WAIT(); asm volatile("" ::: "memory");
        const int c = lane & 7;
#pragma unroll
        for (int j = 0; j < 4; ++j) { const int n = (lane >> 3) + 8 * j; const LAS float* sp = scr + (8 * c) * 33 + n;
            u32x4 o; o.x = cvt_pk_bf16(sp[0 * 33], sp[1 * 33]); o.y = cvt_pk_bf16(sp[2 * 33], sp[3 * 33]); o.z = cvt_pk_bf16(sp[4 * 33], sp[5 * 33]); o.w = cvt_pk_bf16(sp[6 * 33], sp[7 * 33]);
            __builtin_nontemporal_store(o, (u32x4*)(w.dst + (size_t)(n0 + n) * w.K + k0 + 8 * c)); }
        LDS_WAIT(); asm volatile("" ::: "memory"); }
}
__device__ __forceinline__ void phase_p0(const Ctx& C) {
    for (int it = C.bid; it < 192; it += C.G) p0_adaln(C, it);
    LAS float* scr = (LAS float*)(C.lds + C.wave * 16384);
    const int gw = C.bid * 8 + C.wave, NGW = C.G * 8;
    constexpr int N0 = 288 * 16, N1 = 64 * 4, N2 = 32 * 44;
    for (int it = gw; it < N0 + N1 + N2; it += NGW) {
        int cls, vb, rg, kc;
        if (it < N0) { cls = 0; vb = it >> 4; rg = (it >> 2) & 3; kc = it & 3; }
        else if (it < N0 + N1) { const int r = it - N0; cls = 1; vb = r >> 2; rg = r & 3; kc = 0; }
        else { const int r = it - N0 - N1; cls = 2; vb = r / 44; const int rem = r % 44; rg = rem / 11; kc = rem % 11; }
        const WBlk w = get_wblk(C, cls, vb);
        p0_transpose4(w, rg, kc, scr, C.lane);
    }
}

__device__ __forceinline__ size_t cf_off(int t, int c, int K) { return ((size_t)((t >> 4) * (K >> 5) + (c >> 5)) << 9) + (size_t)((((c >> 3) & 3) << 4) + (t & 15)) * 8 + (c & 7); }
__device__ __forceinline__ void p1_rows4(const float* __restrict__ xbase, bf16_t* __restrict__ obase, bf16_t* __restrict__ rbase, float* __restrict__ ssbase, int nss, const f32x4 (&gs)[4], int r0, int lane, bool frag) {
    f32x4 v[4][4];
#pragma unroll
    for (int q = 0; q < 4; ++q)
#pragma unroll
        for (int j = 0; j < 4; ++j) v[q][j] = __builtin_nontemporal_load((const f32x4*)(xbase + (size_t)(r0 + q) * D) + lane + 64 * j);
#pragma unroll
    for (int q = 0; q < 4; ++q) { float s = 0.f;
#pragma unroll
        for (int j = 0; j < 4; ++j) s += (v[q][j].x * v[q][j].x + v[q][j].y * v[q][j].y) + (v[q][j].z * v[q][j].z + v[q][j].w * v[q][j].w);
        s = wave_sum(s);
        if (lane < nss) ssbase[(size_t)(r0 + q) * nss + lane] = lane == 0 ? s : 0.f;
#pragma unroll
        for (int j = 0; j < 4; ++j) { const f32x4 y = v[q][j] * gs[j]; u32x2 w; w.x = cvt_pk_bf16(y.x, y.y); w.y = cvt_pk_bf16(y.z, y.w); *(u32x2*)(obase + (frag ? cf_off(r0 + q, 4 * lane + 256 * j, D) : (size_t)(r0 + q) * D + 4 * lane + 256 * j)) = w;
            if (rbase) { u32x2 r; r.x = cvt_pk_bf16(v[q][j].x, v[q][j].y); r.y = cvt_pk_bf16(v[q][j].z, v[q][j].w); __builtin_nontemporal_store(r, (u32x2*)(rbase + (size_t)(r0 + q) * D) + lane + 64 * j); } } }
}
__device__ __forceinline__ void phase_p1(const Ctx& C) {
    const int gw = C.bid * 8 + C.wave, NGW = C.G * 8;
    const float* __restrict__ mods = WSP(float, WS_MODS);
    for (int s = 0; s < 2; ++s) {
        f32x4 gs[4];
#pragma unroll
        for (int j = 0; j < 4; ++j) gs[j] = *((const f32x4*)INP(IX_NMG) + C.lane + 64 * j) * (*((const f32x4*)(mods + (size_t)s * NMOD + 1024) + C.lane + 64 * j) + 1.0f);
        const int nrow = s ? CT : T;
        for (int r0 = gw * 4; r0 < nrow; r0 += NGW * 4)
            p1_rows4(s ? INP(IX_CTX) : INP(IX_X), s ? WSP(bf16_t, CX_XB) : WSP(bf16_t, WS_SLOT), s ? nullptr : WSP(bf16_t, WS_XRES), s ? WSP(float, CX_SSP) : WSP(float, WS_SSP), s ? 64 : 16, gs, r0, C.lane, s != 0);
    }
    for (int rb = gw; rb < 2048; rb += NGW) {
        const int r = rb * 16; const bf16_t* __restrict__ bt; int l, shoff; float* __restrict__ outp; int ostride;
        if (r < 4096) { const int j = r / 2048, n = r % 2048; bt = WSP(bf16_t, W_A1 + j * SZ_A1) + (size_t)n * 1024; l = 2 * j; shoff = 0; outp = WSP(float, WS_BIASM) + (size_t)(l * 2) * 3072 + n; ostride = 3072; }
        else if (r < 10240) { const int rr = r - 4096, j = rr / 3072, n = rr % 3072; bt = WSP(bf16_t, W_B1 + j * SZ_B1) + (size_t)n * 1024; l = 2 * j + 1; shoff = 0; outp = WSP(float, WS_BIASM) + (size_t)(l * 2) * 3072 + n; ostride = 3072; }
        else { const int rr = r - 10240; l = rr / 5632; const int n = rr % 5632; bt = WSP(bf16_t, W_F1 + l * SZ_F1) + (size_t)n * 1024; shoff = 3072; outp = WSP(float, WS_BIASF) + (size_t)(l * 2) * 5632 + n; ostride = 5632; }
        f32x4 sh[2][2][2];
#pragma unroll
        for (int st = 0; st < 2; ++st)
#pragma unroll
            for (int h = 0; h < 2; ++h) { const float* p = mods + (size_t)(l * 2 + st) * NMOD + shoff + h * 512 + 8 * C.lane; sh[st][h][0] = *(const f32x4*)p; sh[st][h][1] = *(const f32x4*)(p + 4); }
#pragma unroll 1
        for (int b4 = 0; b4 < 4; ++b4) {
            u32x4 wv[4][2];
#pragma unroll
            for (int q = 0; q < 4; ++q)
#pragma unroll
                for (int h = 0; h < 2; ++h) wv[q][h] = __builtin_nontemporal_load((const u32x4*)(bt + (size_t)(b4 * 4 + q) * 1024 + h * 512 + 8 * C.lane));
#pragma unroll
            for (int q = 0; q < 4; ++q) { float a0 = 0.f, a1 = 0.f;
#pragma unroll
                for (int h = 0; h < 2; ++h) { const u32x4 w = wv[q][h];
                    const f32x4 lo = (f32x4){bf2f(w.x & 0xffffu), bf2f(w.x >> 16), bf2f(w.y & 0xffffu), bf2f(w.y >> 16)}, hi = (f32x4){bf2f(w.z & 0xffffu), bf2f(w.z >> 16), bf2f(w.w & 0xffffu), bf2f(w.w >> 16)};
                    const f32x4 p0 = lo * sh[0][h][0] + hi * sh[0][h][1], p1 = lo * sh[1][h][0] + hi * sh[1][h][1];
                    a0 += (p0.x + p0.y) + (p0.z + p0.w); a1 += (p1.x + p1.y) + (p1.z + p1.w); }
                a0 = wave_sum(a0); a1 = wave_sum(a1);
                if (C.lane == 0) { outp[b4 * 4 + q] = a0; outp[ostride + b4 * 4 + q] = a1; } }
        }
    }
    for (int i = C.bid * 512 + C.tid; i < 4096; i += C.G * 512) { const float x = INP(IX_ALAM)[i]; const float ls = fminf(x, 0.f) - log1pf(expf(-fabsf(x))); WSP(float, WS_LA8)[i] = 8.0f * 1.4426950409f * ls; }
}

__device__ __forceinline__ void phase_conv4(const Ctx& C, const bf16_t* __restrict__ UPRE, bf16_t* __restrict__ U, const float* __restrict__ cw, const float* __restrict__ cb) {
    const int cg = C.tid & 127, sub = C.tid >> 7, c0 = cg * 8;
    float w[4][8], b[8];
#pragma unroll
    for (int k = 0; k < 4; ++k)
#pragma unroll
        for (int e = 0; e < 8; ++e) w[k][e] = cw[k * D + c0 + e];
#pragma unroll
    for (int e = 0; e < 8; ++e) b[e] = cb[c0 + e];
    for (int it = C.bid; it < T / 64; it += C.G) {
        const int t0 = it * 64 + sub * 16;
        float win[3][8];
#pragma unroll
        for (int r = 0; r < 3; ++r) { const int t = t0 - 2 + r; u32x4 v = *(const u32x4*)(UPRE + (size_t)(t >= 0 ? t : 0) * D + c0); if (t < 0) v = (u32x4){0u, 0u, 0u, 0u};
            win[r][0] = bf2f(v.x & 0xffffu); win[r][1] = bf2f(v.x >> 16); win[r][2] = bf2f(v.y & 0xffffu); win[r][3] = bf2f(v.y >> 16); win[r][4] = bf2f(v.z & 0xffffu); win[r][5] = bf2f(v.z >> 16); win[r][6] = bf2f(v.w & 0xffffu); win[r][7] = bf2f(v.w >> 16); }
#pragma unroll
        for (int i = 0; i < 16; ++i) { const int t = t0 + i; u32x4 v = *(const u32x4*)(UPRE + (size_t)(t + 1 < T ? t + 1 : T - 1) * D + c0); if (t + 1 >= T) v = (u32x4){0u, 0u, 0u, 0u};
            const float nx[8] = {bf2f(v.x & 0xffffu), bf2f(v.x >> 16), bf2f(v.y & 0xffffu), bf2f(v.y >> 16), bf2f(v.z & 0xffffu), bf2f(v.z >> 16), bf2f(v.w & 0xffffu), bf2f(v.w >> 16)};
            float o[8];
#pragma unroll
            for (int e = 0; e < 8; ++e) { o[e] = b[e] + w[0][e] * win[0][e] + w[1][e] * win[1][e] + w[2][e] * win[2][e] + w[3][e] * nx[e]; win[0][e] = win[1][e]; win[1][e] = win[2][e]; win[2][e] = nx[e]; }
            u32x4 ow; ow.x = cvt_pk_bf16(o[0], o[1]); ow.y = cvt_pk_bf16(o[2], o[3]); ow.z = cvt_pk_bf16(o[4], o[5]); ow.w = cvt_pk_bf16(o[6], o[7]);
            *(u32x4*)(U + (size_t)t * D + c0) = ow; }
    }
}
__device__ __forceinline__ void phase_vconv(const Ctx& C, const bf16_t* __restrict__ GB, const bf16_t* __restrict__ Z, bf16_t* __restrict__ Q, const float* __restrict__ cw, const float* __restrict__ cb) {
    const int cg = C.tid & 127, sub = C.tid >> 7, c0 = cg * 8;
    float w[3][8], b[8];
#pragma unroll
    for (int k = 0; k < 3; ++k)
#pragma unroll
        for (int e = 0; e < 8; ++e) w[k][e] = cw[k * D + c0 + e];
#pragma unroll
    for (int e = 0; e < 8; ++e) b[e] = cb[c0 + e];
    const int vb = (C.G & 7) == 0 ? (C.bid & 7) * (C.G >> 3) + (C.bid >> 3) : C.bid;
    for (int it = vb; it < T / 64; it += C.G) {
        const int t0 = it * 64 + sub * 16;
        const bool lo_ok = it > 0, hi_ok = it < T / 64 - 1;
        const long om = lo_ok ? -(long)64 * D : 0, op = hi_ok ? (long)64 * D : 0; const float ml = lo_ok ? 1.f : 0.f, mh = hi_ok ? 1.f : 0.f;
#pragma unroll 8
        for (int i = 0; i < 16; ++i) { const int t = t0 + i; const size_t off = (size_t)t * D + c0;
            const u32x4 g = *(const u32x4*)(GB + off), z1 = *(const u32x4*)(Z + off);
            const u32x4 z0 = *(const u32x4*)(Z + (long)off + om), z2 = *(const u32x4*)(Z + (long)off + op);
            const unsigned gw[4] = {g.x, g.y, g.z, g.w}, a0[4] = {z0.x, z0.y, z0.z, z0.w}, a1[4] = {z1.x, z1.y, z1.z, z1.w}, a2[4] = {z2.x, z2.y, z2.z, z2.w};
            unsigned ow[4];
#pragma unroll
            for (int p = 0; p < 4; ++p) {
                const float lo = bf2f(gw[p] & 0xffffu) * (b[2 * p] + ml * w[0][2 * p] * bf2f(a0[p] & 0xffffu) + w[1][2 * p] * bf2f(a1[p] & 0xffffu) + mh * w[2][2 * p] * bf2f(a2[p] & 0xffffu));
                const float hi = bf2f(gw[p] >> 16) * (b[2 * p + 1] + ml * w[0][2 * p + 1] * bf2f(a0[p] >> 16) + w[1][2 * p + 1] * bf2f(a1[p] >> 16) + mh * w[2][2 * p + 1] * bf2f(a2[p] >> 16));
                ow[p] = cvt_pk_bf16(lo, hi); }
            *(u32x4*)(Q + off) = (u32x4){ow[0], ow[1], ow[2], ow[3]}; }
    }
}

typedef _Float16 h16x8 __attribute__((ext_vector_type(8)));
__device__ __forceinline__ void eb_unpack(u32x4 w, f32x4& a, f32x4& b) {
    const h16x8 h = __builtin_bit_cast(h16x8, w);
    a = (f32x4){1.0f - (float)h[0], 1.0f - (float)h[2], 1.0f - (float)h[4], 1.0f - (float)h[6]}; b = (f32x4){(float)h[1], (float)h[3], (float)h[5], (float)h[7]};
}
__device__ __forceinline__ void phase_scan1(const Ctx& C, const h16* __restrict__ EB) {
    LAS float* lagg = (LAS float*)C.lds;
    for (int task = C.bid; task < 256; task += C.G) {
        const int j = task >> 2, cbk = task & 3, ch = cbk * 256 + 4 * C.lane, r0 = j * 256 + 32 * C.wave;
#pragma unroll
        for (int d = 0; d < 2; ++d) {
            const h16* e = EB + (((size_t)d * T + r0) * D + ch) * 2;
            f32x4 P = {1.f, 1.f, 1.f, 1.f}, Q = {0.f, 0.f, 0.f, 0.f};
            u32x4 ev[32];
#pragma unroll
            for (int i = 0; i < 32; ++i) ev[i] = *(const u32x4*)(e + (size_t)i * D * 2);
#pragma unroll
            for (int i = 0; i < 32; ++i) { const int ii = d ? 31 - i : i; f32x4 a, bb; eb_unpack(ev[ii], a, bb); P = P * a; Q = a * Q + bb; }
            float* ag = WSP(float, WS_AGG32) + (((size_t)d * 512 + j * 8 + C.wave) * D + ch) * 2;
            *(f32x4*)ag = (f32x4){P[0], Q[0], P[1], Q[1]}; *(f32x4*)(ag + 4) = (f32x4){P[2], Q[2], P[3], Q[3]};
            LAS float* la = lagg + ((d * 8 + C.wave) * 256 + 4 * C.lane) * 2;
            *(LAS f32x4*)la = (f32x4){P[0], Q[0], P[1], Q[1]}; *(LAS f32x4*)(la + 4) = (f32x4){P[2], Q[2], P[3], Q[3]};
        }
        __syncthreads();
        { const int d = C.tid >> 8, c = C.tid & 255; float P = 1.f, Q = 0.f;
#pragma unroll
            for (int i = 0; i < 8; ++i) { const int w = d ? 7 - i : i; const f32x2 pq = *(const LAS f32x2*)(lagg + ((d * 8 + w) * 256 + c) * 2); Q = pq.x * Q + pq.y; P *= pq.x; }
            *(f32x2*)(WSP(float, WS_AGGT) + (((size_t)d * 64 + j) * D + cbk * 256 + c) * 2) = (f32x2){P, Q}; }
        __syncthreads();
    }
}
__device__ __forceinline__ void phase_scan2(const Ctx& C, const h16* __restrict__ EB, const bf16_t* __restrict__ Gt, bf16_t* __restrict__ GS, const float* __restrict__ h0) {
    LAS float* cin = (LAS float*)(C.lds + RING_BYTES + 1024);
    LAS unsigned char* hbw = C.lds + C.wave * 16384 + 8 * C.lane;
    for (int task = C.bid; task < 256; task += C.G) {
        const int j = task >> 2, cbk = task & 3;
        const int ch = cbk * 256 + 4 * C.lane, r0 = j * 256 + 32 * C.wave;
        f32x4 sq[2][7][2];
#pragma unroll
        for (int d = 0; d < 2; ++d) { const int n = d ? 7 - C.wave : C.wave;
#pragma unroll
            for (int u = 0; u < 7; ++u) { const int im = u < n ? u : (n > 0 ? n - 1 : 0); const int w = d ? 7 - im : im; const float* ag = WSP(float, WS_AGG32) + (((size_t)d * 512 + j * 8 + w) * D + ch) * 2; sq[d][u][0] = *(const f32x4*)ag; sq[d][u][1] = *(const f32x4*)(ag + 4); } }
        { int tid_ = C.tid; asm volatile("" : "+v"(tid_));
            const int d = tid_ >> 8, c = tid_ & 255, chn = cbk * 256 + c; float h = h0[d * D + chn];
            const int n = d ? 63 - j : j; const float* base = WSP(float, WS_AGGT) + ((size_t)d * 64 * D + chn) * 2;
            for (int i = 0; i < n; i += 32) { f32x2 pq[32];
#pragma unroll
                for (int u = 0; u < 32; ++u) { const int ii = i + u; const int im = ii < n ? ii : n - 1; const int jj = d ? 63 - im : im; pq[u] = *(const f32x2*)(base + (size_t)jj * D * 2); if (ii >= n) pq[u] = (f32x2){1.f, 0.f}; }
#pragma unroll
                for (int u = 0; u < 32; ++u) h = pq[u].x * h + pq[u].y; }
            cin[d * 256 + c] = h; }
        __syncthreads();
        f32x4 hc[2];
#pragma unroll
        for (int d = 0; d < 2; ++d) { f32x4 h = *(const LAS f32x4*)(cin + d * 256 + 4 * C.lane); const int n = d ? 7 - C.wave : C.wave;
#pragma unroll
            for (int u = 0; u < 7; ++u) if (u < n) { h[0] = sq[d][u][0][0] * h[0] + sq[d][u][0][1]; h[1] = sq[d][u][0][2] * h[1] + sq[d][u][0][3]; h[2] = sq[d][u][1][0] * h[2] + sq[d][u][1][1]; h[3] = sq[d][u][1][2] * h[3] + sq[d][u][1][3]; }
            hc[d] = h; }
        u32x4 ev[32];
        { const h16* e = EB + (((size_t)T + r0) * D + ch) * 2;
#pragma unroll
            for (int i = 0; i < 32; ++i) ev[i] = __builtin_nontemporal_load((const u32x4*)(e + (size_t)i * D * 2)); }
        { f32x4 h = hc[1];
#pragma unroll
            for (int i = 31; i >= 0; --i) { f32x4 a, bb; eb_unpack(ev[i], a, bb); h = a * h + bb;
                u32x2 w; w.x = cvt_pk_bf16(h[0], h[1]); w.y = cvt_pk_bf16(h[2], h[3]); *(LAS u32x2*)(hbw + i * 512) = w; } }
        { f32x4 h = hc[0]; const h16* e = EB + ((size_t)r0 * D + ch) * 2;
#pragma unroll
            for (int hb2 = 0; hb2 < 2; ++hb2) { u32x2 gv[16];
#pragma unroll
                for (int i = 0; i < 16; ++i) { ev[i] = __builtin_nontemporal_load((const u32x4*)(e + (size_t)(16 * hb2 + i) * D * 2)); gv[i] = __builtin_nontemporal_load((const u32x2*)(Gt + (size_t)(r0 + 16 * hb2 + i) * D + ch)); }
#pragma unroll
                for (int i = 0; i < 16; ++i) { f32x4 a, bb; eb_unpack(ev[i], a, bb); h = a * h + bb;
                    const f32x4 hb = bf4_to_f4(*(const LAS u32x2*)(hbw + (16 * hb2 + i) * 512)); const f32x4 o = bf4_to_f4(gv[i]) * (h + hb);
                    u32x2 w; w.x = cvt_pk_bf16(o[0], o[1]); w.y = cvt_pk_bf16(o[2], o[3]); *(u32x2*)(GS + (size_t)(r0 + 16 * hb2 + i) * D + ch) = w; } } }
        __syncthreads();
    }
}
__device__ __forceinline__ void phase_final(const Ctx& C, const float* __restrict__ ssp) {
    const int gw = C.bid * 8 + C.wave, NGW = C.G * 8;
    const bf16_t* __restrict__ xres = WSP(bf16_t, WS_XRES); float* __restrict__ out = C.out; const float* __restrict__ fg = INP(IX_FG);
    f32x4 g[4];
#pragma unroll
    for (int j = 0; j < 4; ++j) g[j] = *((const f32x4*)fg + C.lane + 64 * j);
    for (int r0 = gw * 4; r0 < T; r0 += NGW * 4) {
        u32x2 xv[4][4]; float sv[4];
#pragma unroll
        for (int q = 0; q < 4; ++q) { { const float v_ = ssp[(size_t)(r0 + q) * 16 + (C.lane & 15)]; sv[q] = C.lane < 16 ? v_ : 0.f; }
#pragma unroll
            for (int j = 0; j < 4; ++j) xv[q][j] = __builtin_nontemporal_load((const u32x2*)(xres + (size_t)(r0 + q) * D) + C.lane + 64 * j); }
#pragma unroll
        for (int q = 0; q < 4; ++q) { const float rstd = 1.0f / sqrtf(wave_sum(sv[q]) * (1.0f / D) + EPS); f32x4* orow = (f32x4*)(out + (size_t)(r0 + q) * D) + C.lane;
#pragma unroll
            for (int j = 0; j < 4; ++j) __builtin_nontemporal_store(bf4_to_f4(xv[q][j]) * rstd * g[j], orow + 64 * j); }
    }
}
template <int NB, int UNR, int K>
__device__ __forceinline__ void ctx_mm(f32x4 (&acc)[2][NB], const bf16_t* A, int lda, const bf16_t* const (&Bp)[NB], int wave, int lane, int tid, LAS unsigned char* lds) {
    const int fr = lane & 15, fq = lane >> 4;
    constexpr int ROWB = K * 2 + 16, PPT = K / 256, NK = K / 32;
    const bf16_t* a0 = A + (size_t)(2 * wave) * lda * 16 + lane * 8; const bf16_t* a1 = a0 + (size_t)lda * 16;
    bf16x8 af[UNR][2];
    {   u32x4 stg[NB][PPT];
#pragma unroll
        for (int nb = 0; nb < NB; ++nb)
#pragma unroll
            for (int q = 0; q < PPT; ++q) { const int p = tid + 512 * q, r = p / (K / 8), kc = p % (K / 8); stg[nb][q] = *(const u32x4*)(Bp[nb] + (size_t)r * K + kc * 8); }
        __builtin_amdgcn_sched_barrier(0);
#pragma unroll
        for (int u = 0; u < UNR; ++u) { af[u][0] = *(const bf16x8*)(a0 + u * 512); af[u][1] = *(const bf16x8*)(a1 + u * 512); }
        __builtin_amdgcn_sched_barrier(0);
#pragma unroll
        for (int nb = 0; nb < NB; ++nb)
#pragma unroll
            for (int q = 0; q < PPT; ++q) { const int p = tid + 512 * q, r = p / (K / 8), kc = p % (K / 8); *(LAS u32x4*)(lds + (nb * 16 + r) * ROWB + kc * 16) = stg[nb][q]; } }
#pragma unroll
    for (int nb = 0; nb < NB; ++nb) { acc[0][nb] = (f32x4){0.f, 0.f, 0.f, 0.f}; acc[1][nb] = (f32x4){0.f, 0.f, 0.f, 0.f}; }
    __syncthreads();
    const LAS unsigned char* bl = lds + fr * ROWB + fq * 16;
#pragma unroll
    for (int kk = 0; kk < NK; ++kk) { constexpr int dummy = 0; (void)dummy; const int u = kk % UNR;
#pragma unroll
        for (int nb = 0; nb < NB; ++nb) { const bf16x8 bf = *(const LAS bf16x8*)(bl + nb * 16 * ROWB + kk * 64);
            acc[0][nb] = __builtin_amdgcn_mfma_f32_16x16x32_bf16(bf, af[u][0], acc[0][nb], 0, 0, 0); acc[1][nb] = __builtin_amdgcn_mfma_f32_16x16x32_bf16(bf, af[u][1], acc[1][nb], 0, 0, 0); }
        __builtin_amdgcn_sched_barrier(0);
        if (kk + UNR < NK) { af[u][0] = *(const bf16x8*)(a0 + (kk + UNR) * 512); af[u][1] = *(const bf16x8*)(a1 + (kk + UNR) * 512); }
        __builtin_amdgcn_sched_barrier(0);
    }
    __syncthreads();
}
template <int UNR, int K>
__device__ __forceinline__ void ctx_mm1(f32x4& acc, const bf16_t* A, int lda, const bf16_t* Bp, int row0, int lane, int tid, LAS unsigned char* lds) {
    const int fr = lane & 15, fq = lane >> 4;
    constexpr int ROWB = K * 2 + 16, PPT = K / 256, NK = K / 32;
    const bf16_t* a0 = A + (size_t)(row0 >> 4) * lda * 16 + lane * 8;
    bf16x8 af[UNR];
    {   u32x4 stg[PPT];
#pragma unroll
        for (int q = 0; q < PPT; ++q) { const int p = tid + 512 * q, r = p / (K / 8), kc = p % (K / 8); stg[q] = *(const u32x4*)(Bp + (size_t)r * K + kc * 8); }
        __builtin_amdgcn_sched_barrier(0);
#pragma unroll
        for (int u = 0; u < UNR; ++u) af[u] = *(const bf16x8*)(a0 + u * 512);
        __builtin_amdgcn_sched_barrier(0);
#pragma unroll
        for (int q = 0; q < PPT; ++q) { const int p = tid + 512 * q, r = p / (K / 8), kc = p % (K / 8); *(LAS u32x4*)(lds + r * ROWB + kc * 16) = stg[q]; } }
    acc = (f32x4){0.f, 0.f, 0.f, 0.f};
    __syncthreads();
    const LAS unsigned char* bl = lds + fr * ROWB + fq * 16;
#pragma unroll
    for (int kk = 0; kk < NK; ++kk) { const int u = kk % UNR;
        { const bf16x8 bf = *(const LAS bf16x8*)(bl + kk * 64); acc = __builtin_amdgcn_mfma_f32_16x16x32_bf16(bf, af[u], acc, 0, 0, 0); }
        __builtin_amdgcn_sched_barrier(0);
        if (kk + UNR < NK) af[u] = *(const bf16x8*)(a0 + (kk + UNR) * 512);
        __builtin_amdgcn_sched_barrier(0);
    }
    __syncthreads();
}
struct CtxSS { f32x4 a, b, c, d; };
__device__ __forceinline__ CtxSS ctx_ss_load(const float* sspc, int row, int fq) { const float* p = sspc + (size_t)row * 64 + fq * 16; CtxSS r; r.a = *(const f32x4*)p; r.b = *(const f32x4*)(p + 4); r.c = *(const f32x4*)(p + 8); r.d = *(const f32x4*)(p + 12); return r; }
__device__ __forceinline__ float ctx_rstd_fin(const CtxSS& v, int fr, int fq) {
    float s = ((v.a.x + v.a.y) + (v.a.z + v.a.w)) + ((v.b.x + v.b.y) + (v.b.z + v.b.w)) + ((v.c.x + v.c.y) + (v.c.z + v.c.w)) + ((v.d.x + v.d.y) + (v.d.z + v.d.w));
    s = add_x16(s); s = add_x32(s, XL32(fr, fq));
    return 1.0f / sqrtf(s * (1.0f / D) + EPS);
}
struct CtxP {
    int kind;
    const bf16_t* A; int lda, K; const bf16_t* Bt; const float* sspi; const float* bias;
    const float* hin; float* hout; bf16_t* xbo; const float* gate; const float* ng; const float* sc; float* sspo;
    bf16_t* o1; bf16_t* o2;
    const float* cw; const float* cb; const float* br; const float* bi; const float* la8; float* h0;
};
template <int KW> struct CtxCW { f32x4 w[KW][2]; f32x4 b[2]; };
template <int KW>
__device__ __forceinline__ CtxCW<KW> ctx_cw_load(const float* cw, int cstride, const float* cb, int c) {
    CtxCW<KW> r;
#pragma unroll
    for (int k = 0; k < KW; ++k) { r.w[k][0] = *(const f32x4*)(cw + (size_t)k * cstride + c); r.w[k][1] = *(const f32x4*)(cw + (size_t)k * cstride + c + 4); }
    r.b[0] = *(const f32x4*)(cb + c); r.b[1] = *(const f32x4*)(cb + c + 4);
    return r;
}
template <int KW, int PAD>
__device__ __forceinline__ void ctx_conv_rows(float (&o)[8], const LAS float* tile, int t, int hh, const CtxCW<KW>& cwv) {
    f32x4 o0 = cwv.b[0], o1 = cwv.b[1];
#pragma unroll
    for (int k = 0; k < KW; ++k) { const int tt = t + k - PAD; if (tt >= 0 && tt < CT) {
        const f32x4 a = *(const LAS f32x4*)(tile + tt * 16 + 8 * hh), b = *(const LAS f32x4*)(tile + tt * 16 + 8 * hh + 4);
        o0 += cwv.w[k][0] * a; o1 += cwv.w[k][1] * b; } }
    o[0] = o0[0]; o[1] = o0[1]; o[2] = o0[2]; o[3] = o0[3]; o[4] = o1[0]; o[5] = o1[1]; o[6] = o1[2]; o[7] = o1[3];
}
__device__ __forceinline__ void ctx_item(const Ctx& C0, const CtxP& P, int item) {
    Ctx C = C0; asm volatile("" : "+v"(C.lane)); C.tid = C.wave * 64 + C.lane;
    const int fr = C.lane & 15, fq = C.lane >> 4, c0 = 16 * item;
    LAS float* t0 = (LAS float*)C.lds; LAS float* t1 = t0 + 4096; LAS float* t2 = t1 + 4096; LAS float* t3 = t2 + 4096; LAS float* tagg = t3 + 4096;
    const int tt = C.tid >> 1, hh = C.tid & 1;
    if (P.kind == 1) {
        f32x4 acc[2][2]; const bf16_t* const Bp[2] = {P.Bt + (size_t)c0 * P.K, P.Bt + (size_t)(1024 + c0) * P.K};
        const f32x4 b0 = *(const f32x4*)(P.bias + c0 + 4 * fq), b1 = *(const f32x4*)(P.bias + 1024 + c0 + 4 * fq);
        const CtxSS ssv[2] = {ctx_ss_load(P.sspi, 32 * C.wave + fr, fq), ctx_ss_load(P.sspi, 32 * C.wave + 16 + fr, fq)};
        ctx_mm<2, 16, 1024>(acc, P.A, P.lda, Bp, C.wave, C.lane, C.tid, C.lds);
        const CtxCW<4> cwv = ctx_cw_load<4>(P.cw, D, P.cb, c0 + 8 * hh);
#pragma unroll
        for (int g = 0; g < 2; ++g) { const int t = 32 * C.wave + 16 * g + fr; const float rs = ctx_rstd_fin(ssv[g], fr, fq);
            *(LAS f32x4*)(t0 + t * 16 + 4 * fq) = acc[g][0] * rs + b0;
            const f32x4 gp = acc[g][1] * rs + b1; u32x2 w; w.x = cvt_pk_bf16(gelu_t(gp[0]), gelu_t(gp[1])); w.y = cvt_pk_bf16(gelu_t(gp[2]), gelu_t(gp[3]));
            *(u32x2*)(P.o2 + (size_t)t * D + c0 + 4 * fq) = w; }
        __syncthreads();
        float o[8]; ctx_conv_rows<4, 2>(o, t0, tt, hh, cwv);
        u32x4 w; w.x = cvt_pk_bf16(o[0], o[1]); w.y = cvt_pk_bf16(o[2], o[3]); w.z = cvt_pk_bf16(o[4], o[5]); w.w = cvt_pk_bf16(o[6], o[7]);
        *(u32x4*)(P.o1 + cf_off(tt, c0 + 8 * hh, D)) = w;
        __syncthreads();
    } else if (P.kind == 2) {
        f32x4 acc[2][4]; const int q = c0 >> 7, cl = c0 & 127, h = c0 >> 8;
        const bf16_t* const Bp[4] = {P.Bt + (size_t)((0 * 8 + q) * 256 + cl) * 256, P.Bt + (size_t)((0 * 8 + q) * 256 + 128 + cl) * 256, P.Bt + (size_t)((1 * 8 + q) * 256 + cl) * 256, P.Bt + (size_t)((1 * 8 + q) * 256 + 128 + cl) * 256};
        const u32x2 uw2[2] = {*(const u32x2*)(P.A + cf_off(32 * C.wave + fr, c0 + 4 * fq, D)), *(const u32x2*)(P.A + cf_off(32 * C.wave + 16 + fr, c0 + 4 * fq, D))};
        f32x4 brv2[2], biv2[2], lav2[2];
#pragma unroll
        for (int d = 0; d < 2; ++d) { brv2[d] = *(const f32x4*)(P.br + d * D + c0 + 4 * fq); biv2[d] = *(const f32x4*)(P.bi + d * D + c0 + 4 * fq); lav2[d] = *(const f32x4*)(P.la8 + d * D + c0 + 4 * fq); }
        ctx_mm<4, 8, 256>(acc, P.A + h * 256 * 16, P.lda, Bp, C.wave, C.lane, C.tid, C.lds);
#pragma unroll
        for (int g = 0; g < 2; ++g) { const int t = 32 * C.wave + 16 * g + fr; const f32x4 uu = bf4_to_f4(uw2[g]);
#pragma unroll
            for (int d = 0; d < 2; ++d) { const f32x4 brv = brv2[d], biv = biv2[d], lav = lav2[d];
                f32x4 av, bv;
#pragma unroll
                for (int j = 0; j < 4; ++j) { const float r = sigm(acc[g][2 * d][j] + brv[j]), ig = sigm(acc[g][2 * d + 1][j] + biv[j]); const float a = __builtin_amdgcn_exp2f(r * lav[j]), e = 1.0f - a; av[j] = a; bv[j] = __builtin_amdgcn_sqrtf(e * (1.0f + a)) * ig * uu[j]; }
                *(LAS f32x4*)((d ? t2 : t0) + t * 16 + 4 * fq) = av; *(LAS f32x4*)((d ? t3 : t1) + t * 16 + 4 * fq) = bv; } }
        __syncthreads();
        { const int c = C.tid & 15, d = (C.tid >> 4) & 1, chk = C.tid >> 5; const LAS float* ta = d ? t2 : t0; LAS float* tb = d ? t3 : t1;
            float Pp = 1.f, Qq = 0.f;
#pragma unroll
            for (int i = 0; i < 16; ++i) { const int t = 16 * chk + (d ? 15 - i : i); const float a = ta[t * 16 + c], b = tb[t * 16 + c]; Qq = a * Qq + b; Pp *= a; }
            tagg[((d * 16 + chk) * 16 + c) * 2] = Pp; tagg[((d * 16 + chk) * 16 + c) * 2 + 1] = Qq;
            __syncthreads();
            float hcar = 0.f; const int n = d ? 15 - chk : chk;
            for (int i = 0; i < n; ++i) { const int cc = d ? 15 - i : i; hcar = tagg[((d * 16 + cc) * 16 + c) * 2] * hcar + tagg[((d * 16 + cc) * 16 + c) * 2 + 1]; }
#pragma unroll
            for (int i = 0; i < 16; ++i) { const int t = 16 * chk + (d ? 15 - i : i); hcar = ta[t * 16 + c] * hcar + tb[t * 16 + c]; tb[t * 16 + c] = hcar; }
            if ((d == 0 && chk == 15) || (d == 1 && chk == 0)) P.h0[d * D + c0 + c] = hcar; }
        __syncthreads();
        if (P.o1) { const f32x4 f0 = *(const LAS f32x4*)(t1 + tt * 16 + 8 * hh), f1 = *(const LAS f32x4*)(t1 + tt * 16 + 8 * hh + 4), r0 = *(const LAS f32x4*)(t3 + tt * 16 + 8 * hh), r1 = *(const LAS f32x4*)(t3 + tt * 16 + 8 * hh + 4);
            const u32x4 gw = *(const u32x4*)(P.o2 + (size_t)tt * D + c0 + 8 * hh);
            const f32x4 s0 = f0 + r0, s1 = f1 + r1;
            u32x4 w; w.x = cvt_pk_bf16(bf2f(gw.x & 0xffffu) * s0[0], bf2f(gw.x >> 16) * s0[1]); w.y = cvt_pk_bf16(bf2f(gw.y & 0xffffu) * s0[2], bf2f(gw.y >> 16) * s0[3]);
            w.z = cvt_pk_bf16(bf2f(gw.z & 0xffffu) * s1[0], bf2f(gw.z >> 16) * s1[1]); w.w = cvt_pk_bf16(bf2f(gw.w & 0xffffu) * s1[2], bf2f(gw.w >> 16) * s1[3]);
            *(u32x4*)(P.o1 + cf_off(tt, c0 + 8 * hh, D)) = w; }
        __syncthreads();
    } else if (P.kind == 4) {
        const int cg = item & 63, c4 = 16 * cg, t = 128 * (item >> 6) + 16 * C.wave + fr; const size_t off = (size_t)t * D + c4 + 4 * fq;
        const f32x4 gv = *(const f32x4*)(P.gate + c4 + 4 * fq); const f32x4 gs = *(const f32x4*)(P.ng + c4 + 4 * fq) * (*(const f32x4*)(P.sc + c4 + 4 * fq) + 1.0f);
        const f32x4 hold = *(const f32x4*)(P.hin + off);
        f32x4 acc;
        if (P.K == D) ctx_mm1<32, 1024>(acc, P.A, P.lda, P.Bt + (size_t)c4 * 1024, 128 * (item >> 6) + 16 * C.wave, C.lane, C.tid, C.lds);
        else ctx_mm1<22, 2816>(acc, P.A, P.lda, P.Bt + (size_t)c4 * 2816, 128 * (item >> 6) + 16 * C.wave, C.lane, C.tid, C.lds);
        const f32x4 hn = hold + gv * acc;
        *(f32x4*)(P.hout + off) = hn;
        float ss = (hn[0] * hn[0] + hn[1] * hn[1]) + (hn[2] * hn[2] + hn[3] * hn[3]); ss = add_x16(ss); ss = add_x32(ss, XL32(fr, fq));
        if (fq == 0) P.sspo[(size_t)t * 64 + cg] = ss;
        const f32x4 y = hn * gs; u32x2 w; w.x = cvt_pk_bf16(y[0], y[1]); w.y = cvt_pk_bf16(y[2], y[3]); *(u32x2*)(P.xbo + cf_off(t, c4 + 4 * fq, D)) = w;
    } else if (P.kind == 5) {
        f32x4 acc[2][2]; const int q = c0 >> 7, cl = c0 & 127, nb0 = q * 256 + cl;
        const bf16_t* const Bp[2] = {P.Bt + (size_t)nb0 * P.K, P.Bt + (size_t)(nb0 + 128) * P.K};
        const f32x4 b0 = *(const f32x4*)(P.bias + nb0 + 4 * fq), b1 = *(const f32x4*)(P.bias + nb0 + 128 + 4 * fq);
        const CtxSS ssv[2] = {ctx_ss_load(P.sspi, 32 * C.wave + fr, fq), ctx_ss_load(P.sspi, 32 * C.wave + 16 + fr, fq)};
        ctx_mm<2, 16, 1024>(acc, P.A, P.lda, Bp, C.wave, C.lane, C.tid, C.lds);
        const CtxCW<3> cwv = ctx_cw_load<3>(P.cw, DFF, P.cb, c0 + 8 * hh);
#pragma unroll
        for (int g = 0; g < 2; ++g) { const int t = 32 * C.wave + 16 * g + fr; const float rs = ctx_rstd_fin(ssv[g], fr, fq);
            *(LAS f32x4*)(t0 + t * 16 + 4 * fq) = acc[g][0] * rs + b0; *(LAS f32x4*)(t1 + t * 16 + 4 * fq) = acc[g][1] * rs + b1; }
        __syncthreads();
        float o[8]; ctx_conv_rows<3, 1>(o, t0, tt, hh, cwv);
        const f32x4 v0 = *(const LAS f32x4*)(t1 + tt * 16 + 8 * hh), v1 = *(const LAS f32x4*)(t1 + tt * 16 + 8 * hh + 4);
        u32x4 w; w.x = cvt_pk_bf16(silu_f(o[0]) * v0[0], silu_f(o[1]) * v0[1]); w.y = cvt_pk_bf16(silu_f(o[2]) * v0[2], silu_f(o[3]) * v0[3]);
        w.z = cvt_pk_bf16(silu_f(o[4]) * v1[0], silu_f(o[5]) * v1[1]); w.w = cvt_pk_bf16(silu_f(o[6]) * v1[2], silu_f(o[7]) * v1[3]);
        *(u32x4*)(P.o1 + cf_off(tt, c0 + 8 * hh, DFF)) = w;
        __syncthreads();
    } else {
        f32x4 acc[2][3]; const int q = c0 >> 7, cl = c0 & 127, nb1 = 1024 + q * 256 + cl;
        const bf16_t* const Bp[3] = {P.Bt + (size_t)c0 * P.K, P.Bt + (size_t)nb1 * P.K, P.Bt + (size_t)(nb1 + 128) * P.K};
        const f32x4 b0 = *(const f32x4*)(P.bias + c0 + 4 * fq), b1 = *(const f32x4*)(P.bias + nb1 + 4 * fq), b2 = *(const f32x4*)(P.bias + nb1 + 128 + 4 * fq);
        const CtxSS ssv[2] = {ctx_ss_load(P.sspi, 32 * C.wave + fr, fq), ctx_ss_load(P.sspi, 32 * C.wave + 16 + fr, fq)};
        ctx_mm<3, 8, 1024>(acc, P.A, P.lda, Bp, C.wave, C.lane, C.tid, C.lds);
        const CtxCW<3> cwv = ctx_cw_load<3>(P.cw, D, P.cb, c0 + 8 * hh);
#pragma unroll
        for (int g = 0; g < 2; ++g) { const int t = 32 * C.wave + 16 * g + fr; const float rs = ctx_rstd_fin(ssv[g], fr, fq);
            *(LAS f32x4*)(t0 + t * 16 + 4 * fq) = (acc[g][1] * rs + b1) * (acc[g][2] * rs + b2); *(LAS f32x4*)(t1 + t * 16 + 4 * fq) = acc[g][0] * rs + b0; }
        __syncthreads();
        float o[8]; ctx_conv_rows<3, 1>(o, t0, tt, hh, cwv);
        const f32x4 v0 = *(const LAS f32x4*)(t1 + tt * 16 + 8 * hh), v1 = *(const LAS f32x4*)(t1 + tt * 16 + 8 * hh + 4);
        u32x4 w; w.x = cvt_pk_bf16(o[0] * v0[0], o[1] * v0[1]); w.y = cvt_pk_bf16(o[2] * v0[2], o[3] * v0[3]); w.z = cvt_pk_bf16(o[4] * v1[0], o[5] * v1[1]); w.w = cvt_pk_bf16(o[6] * v1[2], o[7] * v1[3]);
        *(u32x4*)(P.o1 + cf_off(tt, c0 + 8 * hh, D)) = w;
        __syncthreads();
    }
}
__device__ __forceinline__ int ctx_step(const Ctx& C, int ph, CtxP& P) {
    const float* mods = WSP(float, WS_MODS);
#define CMOD(l, chunk) (mods + (size_t)((l) * 2 + 1) * NMOD + (chunk) * 1024)
#define CXB(i) (WSP(bf16_t, CX_XB) + (size_t)(i) * CT * D)
#define CSSP(i) (WSP(float, CX_SSP) + (size_t)(i) * CT * 64)
    P.kind = 0; P.A = nullptr; P.lda = D; P.K = D; P.Bt = nullptr; P.sspi = nullptr; P.bias = nullptr; P.hin = nullptr; P.hout = nullptr; P.xbo = nullptr; P.gate = nullptr; P.ng = nullptr; P.sc = nullptr; P.sspo = nullptr;
    P.o1 = nullptr; P.o2 = nullptr; P.cw = nullptr; P.cb = nullptr; P.br = nullptr; P.bi = nullptr; P.la8 = nullptr; P.h0 = nullptr;
    int sid; switch (ph) { case 2: sid = 2; break; case 3: sid = 3; break; case 4: sid = 4; break; case 6: sid = 5; break; case 8: sid = 6; break; case 9: sid = 7; break; case 10: sid = 8; break;
                           case 11: sid = 9; break; case 13: sid = 10; break; case 14: sid = 11; break; case 15: sid = 12; break; default: sid = 0; }
    switch (sid) {
    case 2: case 11: { const int j = sid == 2 ? 0 : 1, l = 2 * j, xi = sid == 2 ? 0 : 4;
        P.kind = 1; P.A = CXB(xi); P.lda = D; P.K = D; P.Bt = WSP(bf16_t, W_A1 + j * SZ_A1); P.sspi = CSSP(xi); P.bias = WSP(float, WS_BIASM) + (size_t)(l * 2 + 1) * 3072;
        P.o1 = WSP(bf16_t, CX_U) + (size_t)j * CT * D; P.o2 = WSP(bf16_t, CX_G); P.cw = INP(IX_ACW) + (size_t)j * 4 * D; P.cb = INP(IX_ACB) + (size_t)j * D; return 64; }
    case 3: case 12: { const int j = sid == 3 ? 0 : 1;
        P.kind = 2; P.A = WSP(bf16_t, CX_U) + (size_t)j * CT * D; P.lda = D; P.K = 256; P.Bt = WSP(bf16_t, W_A2 + j * SZ_A2);
        P.br = INP(IX_ABR) + (size_t)j * 2 * D; P.bi = INP(IX_ABI) + (size_t)j * 2 * D; P.la8 = WSP(float, WS_LA8) + (size_t)j * 2 * D; P.h0 = WSP(float, WS_H0) + (size_t)j * 2 * D;
        P.o1 = j == 0 ? WSP(bf16_t, CX_GS) : nullptr; P.o2 = WSP(bf16_t, CX_G); return 64; }
    case 4: P.kind = 4; P.A = WSP(bf16_t, CX_GS); P.lda = D; P.K = D; P.Bt = WSP(bf16_t, W_A3); P.hin = INP(IX_CTX); P.hout = WSP(float, CX_H); P.xbo = CXB(1); P.gate = CMOD(0, 2); P.ng = INP(IX_NFG); P.sc = CMOD(0, 4); P.sspo = CSSP(1); return 128;
    case 5: case 9: { const int l = sid == 5 ? 0 : 1, xi = sid == 5 ? 1 : 3;
        P.kind = 5; P.A = CXB(xi); P.lda = D; P.K = D; P.Bt = WSP(bf16_t, W_F1 + l * SZ_F1); P.sspi = CSSP(xi); P.bias = WSP(float, WS_BIASF) + (size_t)(l * 2 + 1) * 5632;
        P.o1 = WSP(bf16_t, CX_Y + l * 1536 * KiB); P.cw = INP(IX_FCW) + (size_t)l * 3 * DFF; P.cb = INP(IX_FCB) + (size_t)l * DFF; return 176; }
    case 6: case 10: { const int l = sid == 6 ? 0 : 1, xo = sid == 6 ? 2 : 4;
        P.kind = 4; P.A = WSP(bf16_t, CX_Y + l * 1536 * KiB); P.lda = DFF; P.K = DFF; P.Bt = WSP(bf16_t, W_F2 + l * SZ_F2); P.hin = WSP(float, CX_H); P.hout = WSP(float, CX_H); P.xbo = CXB(xo);
        P.gate = CMOD(l, 5); P.ng = INP(IX_NMG) + (size_t)(l + 1) * D; P.sc = CMOD(l + 1, 1); P.sspo = CSSP(xo); return 128; }
    case 7: P.kind = 7; P.A = CXB(2); P.lda = D; P.K = D; P.Bt = WSP(bf16_t, W_B1); P.sspi = CSSP(2); P.bias = WSP(float, WS_BIASM) + (size_t)(1 * 2 + 1) * 3072;
        P.o1 = WSP(bf16_t, CX_Q); P.cw = INP(IX_BCW); P.cb = INP(IX_BCB); return 64;
    case 8: P.kind = 4; P.A = WSP(bf16_t, CX_Q); P.lda = D; P.K = D; P.Bt = WSP(bf16_t, W_B2); P.hin = WSP(float, CX_H); P.hout = WSP(float, CX_H); P.xbo = CXB(3); P.gate = CMOD(1, 2); P.ng = INP(IX_NFG) + D; P.sc = CMOD(1, 4); P.sspo = CSSP(3); return 128;
    default: return 0;
    }
#undef CMOD
#undef CXB
#undef CSSP
}

__device__ __forceinline__ void f1_prepare(const Ctx& C, const pg8::StaticOrder& S, const float* __restrict__ ssp, const float* __restrict__ bias, const float* __restrict__ cw, const float* __restrict__ cb) {
    f32x4 sp[F1_SLOTS][4]; float cvv[F1_SLOTS][2]; bool ok[F1_SLOTS];
    const int t = C.tid, trow = t & 255, idx0 = t, idx1 = t + 512;
#pragma unroll
    for (int i = 0; i < F1_SLOTS; ++i) { pg8::Unit u; ok[i] = S.next(i, u); const int pm = ok[i] ? u.pm : 0, pn = ok[i] ? u.pn : 0;
        const float* p = ssp + (size_t)(pm * 256 + trow) * 16;
#pragma unroll
        for (int q = 0; q < 4; ++q) sp[i][q] = *(const f32x4*)(p + 4 * q);
#pragma unroll
        for (int q = 0; q < 2; ++q) { const int ix = q ? idx1 : idx0; const int ixc = ix < 768 ? ix : 0; const int seg = ixc >> 7, c = ixc & 127;
            const float* src = seg == 0 ? bias + pn * 256 + c : seg == 1 ? bias + pn * 256 + 128 + c : seg < 5 ? cw + (size_t)(seg - 2) * DFF + pn * 128 + c : cb + pn * 128 + c;
            cvv[i][q] = *src; } }
#pragma unroll
    for (int i = 0; i < F1_SLOTS; ++i) if (ok[i]) {
        float sacc = 0.f;
#pragma unroll
        for (int q = 0; q < 4; ++q) sacc += (sp[i][q].x + sp[i][q].y) + (sp[i][q].z + sp[i][q].w);
        if (t < 256) ((LAS float*)(C.lds + F1_RS_OFF + i * 1024))[trow] = __builtin_amdgcn_rsqf(sacc * (1.0f / D) + EPS);
        ((LAS float*)(C.lds + F1_CV_OFF + i * F1_CV_BYTES))[idx0] = cvv[i][0];
        if (idx1 < 768) ((LAS float*)(C.lds + F1_CV_OFF + i * F1_CV_BYTES))[idx1] = cvv[i][1]; }
    __syncthreads();
}

__global__ void __launch_bounds__(512, 2) mega_fwd(Args args) {
    extern __shared__ __attribute__((aligned(16))) unsigned char lds_raw[];
    Ctx C;
    C.in = args.in; C.out = args.out; C.ws = args.ws; C.lds = (LAS unsigned char*)lds_raw;
    C.tid = threadIdx.x; C.lane = C.tid & 63; C.wave = __builtin_amdgcn_readfirstlane(C.tid >> 6); C.G = gridDim.x; C.bid = blockIdx.x;
    volatile LAS unsigned* MISC = (volatile LAS unsigned*)(C.lds + MISC_OFF);
    for (int u = C.tid; u < (LDS_BYTES - LDSCTL_OFF) / 4; u += 512) ((LAS unsigned*)(C.lds + LDSCTL_OFF))[u] = 0u;
    __syncthreads();
    XcdBarrier bar; bar.bar = (unsigned*)(C.ws + WS_CTL) + 4096; bar.x = 0; bar.st = nullptr;
#if !MK_PER_PHASE
    bar = xcd_barrier_post((unsigned*)(C.ws + WS_CTL) + 4096, MISC + 8);
#endif
    const int lo = args.ph_lo, hi = args.ph_hi;
#define REFRESH_LANE() do { C.lane = lane_id(); asm volatile("" : "+v"(C.lane)); C.tid = C.wave * 64 + C.lane; } while (0)
#define IN(k) (lo <= (k) && (k) < hi)
#ifndef MK_BAR_REPS
#define MK_BAR_REPS 1
#endif
#define SEAM(k) do { if (IN(k) && IN((k) + 1)) { for (int br_ = 0; br_ < MK_BAR_REPS; ++br_) xcd_barrier(bar); } } while (0)
    const float* mods = WSP(float, WS_MODS);
#define LMOD(l, chunk) (mods + (size_t)((l) * 2) * NMOD + (chunk) * 1024)
#define SLOTP(type, i) WSP(type, WS_SLOT + (size_t)(i) * SLOT)
#define SSPA(i) (WSP(float, WS_SSP) + (size_t)(i) * T * 16)
    int ph = 0;
    if (IN(ph)) { REFRESH_LANE(); phase_p0(C); }
    SEAM(ph); ++ph;
    if (IN(ph)) { REFRESH_LANE(); phase_p1(C); }
    SEAM(ph); ++ph;
    for (ph = 2; ph < 28; ++ph) {
        if (ph == 5 || ph == 18) continue;
        if (IN(ph)) {
            asm volatile("" : "+s"(C.wave), "+s"(C.bid), "+s"(C.G));
            { size_t zz = 0; asm volatile("" : "+s"(zz)); C.ws = args.ws + zz; C.out = args.out + zz; }
            REFRESH_LANE();
            { CtxP cp; const int nci = ctx_step(C, ph, cp); const int coff = (ph == 8 || ph == 13) ? (C.G >> 1) : 0;
              for (int it = C.bid - coff; it < nci; it += C.G) if (it >= 0) ctx_item(C, cp, it); }
            int p = ph - 2, l = 0;
            if (p >= 13) { p -= 13; l = 2; }
            int kind;
            if (p < 8) kind = p; else { l += 1; p -= 8; kind = p == 0 ? 8 : p == 1 ? 9 : p + 3; }
            const int j = l >> 1;
            if (kind == 0) {
                pg8::Gemm g{SLOTP(bf16_t, 0), WSP(bf16_t, W_A1 + j * SZ_A1), D, D, 64, 8, 0, 0}; pg8::StaticOrder S; S.init(64, 8, C.G, C.bid);
                EpiA1 E{SLOTP(bf16_t, 1), SLOTP(bf16_t, 4), WSP(float, WS_BIASM) + (size_t)(l * 2) * 3072, SSPA(2 * l)};
                pg8::gemm_phase(C.lds, g, S, E, C.wave);
            } else if (kind == 1) {
                REFRESH_LANE();
                phase_conv4(C, SLOTP(bf16_t, 1), SLOTP(bf16_t, 5), INP(IX_ACW) + (size_t)j * 4 * D, INP(IX_ACB) + (size_t)j * D);
            } else if (kind == 2) {
                int kk = 256; asm volatile("" : "+s"(kk));
                pg8::Gemm g{SLOTP(bf16_t, 5), WSP(bf16_t, W_A2 + j * SZ_A2), D, kk, 64, 16, 1, 3}; pg8::StaticOrder S; S.init(64, 16, C.G, C.bid);
                EpiA2 E{SLOTP(bf16_t, 5), SLOTP(h16, 0), INP(IX_ABR) + (size_t)j * 2 * D, INP(IX_ABI) + (size_t)j * 2 * D, WSP(float, WS_LA8) + (size_t)j * 2 * D, WSP(float, WS_AGG32), WSP(float, WS_AGGT), C.lds};
                pg8::gemm_phase<EpiA2, false>(C.lds, g, S, E, C.wave);
            } else if (kind == 3) {
                REFRESH_LANE();
                phase_scan1(C, SLOTP(h16, 0));
            } else if (kind == 4) {
                REFRESH_LANE();
                phase_scan2(C, SLOTP(h16, 0), SLOTP(bf16_t, 4), SLOTP(bf16_t, 5), WSP(float, WS_H0) + (size_t)j * 2 * D);
            } else if (kind == 5) {
                const bf16_t* bt = (l & 1) ? WSP(bf16_t, W_B2 + j * SZ_B2) : WSP(bf16_t, W_A3 + j * SZ_A3);
                pg8::Gemm g{(l & 1) ? SLOTP(bf16_t, 3) : SLOTP(bf16_t, 5), bt, D, D, 64, 4, 0, 0}; pg8::StaticOrder S; S.init(64, 4, C.G, C.bid);
                EpiRes E{WSP(bf16_t, WS_XRES), SLOTP(bf16_t, 0), LMOD(l, 2), INP(IX_NFG) + (size_t)l * D, LMOD(l, 4), SSPA(2 * l + 1)};
                pg8::gemm_phase(C.lds, g, S, E, C.wave);
            } else if (kind == 6) {
                pg8::Gemm g{SLOTP(bf16_t, 0), WSP(bf16_t, W_F1 + l * SZ_F1), D, D, 64, 22, 0, 0}; pg8::StaticOrder S; S.init(64, 22, C.G, C.bid, ph > 13);
                EpiF1 E{SLOTP(bf16_t, 1), C.lds};
                S.cap = F1_SLOTS;
                for (;; S.base += F1_SLOTS) { pg8::Unit u0; if (!S.next(0, u0)) break;
                    REFRESH_LANE();
                    f1_prepare(C, S, SSPA(2 * l + 1), WSP(float, WS_BIASF) + (size_t)(l * 2) * 5632, INP(IX_FCW) + (size_t)l * 3 * DFF, INP(IX_FCB) + (size_t)l * DFF);
                    pg8::gemm_phase<EpiF1, true, true>(C.lds, g, S, E, C.wave); }
            } else if (kind == 7) {
                pg8::Gemm g{SLOTP(bf16_t, 1), WSP(bf16_t, W_F2 + l * SZ_F2), DFF, DFF, 64, 4, 0, 0}; pg8::StaticOrder S; S.init(64, 4, C.G, C.bid);
                EpiRes E{WSP(bf16_t, WS_XRES), SLOTP(bf16_t, 0), LMOD(l, 5), l < 3 ? INP(IX_NMG) + (size_t)(l + 1) * D : nullptr, l < 3 ? LMOD(l + 1, 1) : nullptr, SSPA(2 * l + 2)};
                pg8::gemm_phase(C.lds, g, S, E, C.wave);
            } else if (kind == 8) {
                pg8::Gemm g{SLOTP(bf16_t, 0), WSP(bf16_t, W_B1 + j * SZ_B1), D, D, 64, 12, 0, 0}; pg8::StaticOrder S; S.init(64, 12, C.G, C.bid);
                EpiB1 E{SLOTP(bf16_t, 1), SLOTP(bf16_t, 2), WSP(float, WS_BIASM) + (size_t)(l * 2) * 3072, SSPA(2 * l)};
                pg8::gemm_phase(C.lds, g, S, E, C.wave);
            } else {
                REFRESH_LANE();
                phase_vconv(C, SLOTP(bf16_t, 1), SLOTP(bf16_t, 2), SLOTP(bf16_t, 3), INP(IX_BCW) + (size_t)j * 3 * D, INP(IX_BCB) + (size_t)j * D);
            }
        }
        SEAM(ph);
    }
    if (IN(ph)) { REFRESH_LANE(); phase_final(C, SSPA(8)); }
}
constexpr int N_PHASES = 29;

extern "C" void kernel_launch(void* const* d_in, const int* in_sizes, int n_in, void* d_out, int out_size, void* d_ws, size_t ws_size, hipStream_t stream) {
    static int grid = 0;
    if (grid == 0) {
        if (n_in != N_IN || in_sizes[0] != T * D || out_size != T * D || ws_size < WS_END) { fprintf(stderr, "kernel_launch: unexpected problem shape (n_in %d, in0 %d, out %d, ws %zu < %zu)\n", n_in, n_in > 0 ? in_sizes[0] : -1, out_size, ws_size, (size_t)WS_END); grid = -1; return; }
        int dev = 0, cus = 0, per_cu = 0;
        if (hipGetDevice(&dev) != hipSuccess || hipDeviceGetAttribute(&cus, hipDeviceAttributeMultiprocessorCount, dev) != hipSuccess) { grid = -1; return; }
        if (hipFuncSetAttribute((const void*)mega_fwd, hipFuncAttributeMaxDynamicSharedMemorySize, LDS_BYTES) != hipSuccess) { fprintf(stderr, "kernel_launch: hipFuncSetAttribute failed\n"); grid = -1; return; }
        if (hipOccupancyMaxActiveBlocksPerMultiprocessor(&per_cu, (const void*)mega_fwd, 512, LDS_BYTES) != hipSuccess || per_cu < 1) fprintf(stderr, "kernel_launch: occupancy query reports %d\n", per_cu);
        (void)hipGetLastError();
        grid = cus;
    }
    if (grid < 0) return;
    (void)hipMemsetAsync((char*)d_ws + WS_CTL, 0, CTL_ZERO_BYTES, stream);
    Args a{};
    for (int i = 0; i < N_IN; ++i) a.in[i] = (const float*)d_in[i];
    a.out = (float*)d_out; a.ws = (unsigned char*)d_ws;
#if MK_PER_PHASE
    for (int p = 0; p < N_PHASES; ++p) {
        const bool dup = (MK_DUP_MASK >> p) & 1u;
        bool inplace = false;
        if (p >= 2 && p < 28) { int q = p - 2, l = 0; if (q >= 13) { q -= 13; l = 2; } int kind; if (q < 8) kind = q; else { l += 1; q -= 8; kind = q == 0 ? 8 : q == 1 ? 9 : q + 3; } inplace = kind == 5 || kind == 7; }
        const bool cin = (p == 6 || p == 8 || p == 10);
        char* xbk = (char*)d_ws + WS_SLOT + 4 * SLOT; char* cbk = (char*)d_ws + WS_END;
        if (dup && inplace) (void)hipMemcpyAsync(xbk, (char*)d_ws + WS_XRES, (size_t)T * D * 2, hipMemcpyDeviceToDevice, stream);
        if (dup && cin) (void)hipMemcpyAsync(cbk, (char*)d_ws + CX_H, (size_t)CT * D * 4, hipMemcpyDeviceToDevice, stream);
        a.ph_lo = p; a.ph_hi = p + 1; hipLaunchKernelGGL(mega_fwd, dim3(grid), dim3(512), LDS_BYTES, stream, a);
        if (dup) {
            if (inplace) (void)hipMemcpyAsync((char*)d_ws + WS_XRES, xbk, (size_t)T * D * 2, hipMemcpyDeviceToDevice, stream);
            if (cin) (void)hipMemcpyAsync((char*)d_ws + CX_H, cbk, (size_t)CT * D * 4, hipMemcpyDeviceToDevice, stream);
            hipLaunchKernelGGL(mega_fwd, dim3(grid), dim3(512), LDS_BYTES, stream, a);
        }
    }
#else
    a.ph_lo = 0; a.ph_hi = N_PHASES;
    hipLaunchKernelGGL(mega_fwd, dim3(grid), dim3(512), LDS_BYTES, stream, a);
#endif
}
```
